# Optimizing an MI355X kernel written in HIP

```python
import math
import jax, jax.numpy as jnp
from jax import lax
import numpy as np

D_MODEL = 1024
BATCH = 4
SEQ = 4096
DEPTH = 1

CHUNK = 64
MIX_WIDTH = D_MODEL
HG_WIDTH = MIX_WIDTH // 2
HG_HEAD_DIM = 128
HG_HEADS = HG_WIDTH // HG_HEAD_DIM
S5_WIDTH = MIX_WIDTH - HG_WIDTH
S5_GROUP = 16
S5_GROUPS = S5_WIDTH // S5_GROUP
S5_STATE = 64
IN_WIDTH = 4 * HG_WIDTH + S5_WIDTH
D_FF = ((8 * D_MODEL // 3) + 127) // 128 * 128
CONV_WIDTH = 3
EPS = 1e-6
DT_MIN = 1e-3
DT_MAX = 1e-1

kernel_name = "hgrn2_s5_parallel_hybrid_block"


def rmsnorm(x, g):
    xf = x.astype(jnp.float32)
    y = xf * lax.rsqrt(jnp.mean(xf * xf, axis=-1, keepdims=True) + EPS)
    return (y * g.astype(jnp.float32)).astype(x.dtype)


def hgrn2_mix(q, fz, v, gz, lb, norm_g):
    bsz, seq_len, _ = q.shape
    n_chunks = seq_len // CHUNK

    def heads(t):
        return t.astype(jnp.float32).reshape(bsz, n_chunks, CHUNK, HG_HEADS, HG_HEAD_DIM).transpose(0, 3, 1, 2, 4)

    f = lb + (1.0 - lb) * jax.nn.sigmoid(fz.astype(jnp.float32))
    logf = heads(jnp.log(f))
    k = heads(1.0 - f)
    qh = heads(q)
    vh = heads(v)

    b = jnp.cumsum(logf, axis=3)
    b_last = b[:, :, :, -1:, :]
    q_dec = qh * jnp.exp(b)
    k_dec = k * jnp.exp(-b)

    mask = jnp.tril(jnp.ones((CHUNK, CHUNK), dtype=bool))
    att = jnp.einsum('bhnck,bhnsk->bhncs', q_dec, k_dec)
    att = jnp.where(mask, att, 0.0)
    o_intra = jnp.einsum('bhncs,bhnsv->bhncv', att, vh)

    k_tail = k * jnp.exp(b_last - b)
    d_state = jnp.einsum('bhnck,bhncv->nbhkv', k_tail, vh)
    decay = jnp.exp(b_last[:, :, :, 0, :]).transpose(2, 0, 1, 3)

    def step(state, inp):
        dec, ds = inp
        return dec[..., None] * state + ds, state

    s0 = jnp.zeros((bsz, HG_HEADS, HG_HEAD_DIM, HG_HEAD_DIM), jnp.float32)
    _, s_start = lax.scan(step, s0, (decay, d_state))
    o_inter = jnp.einsum('bhnck,nbhkv->bhncv', q_dec, s_start)

    o = (o_intra + o_inter).transpose(0, 2, 3, 1, 4).reshape(bsz, seq_len, HG_HEADS, HG_HEAD_DIM)
    o = o * lax.rsqrt(jnp.mean(o * o, axis=-1, keepdims=True) + EPS)
    o = o.reshape(bsz, seq_len, HG_WIDTH) * norm_g.astype(jnp.float32) * jax.nn.silu(gz.astype(jnp.float32))
    return o.astype(q.dtype)


def s5_mix(u, a_re, a_im, log_dt, b_re, b_im, c_re, c_im, d_skip, w_glu, b_glu):
    bsz, seq_len, _ = u.shape
    uf = u.astype(jnp.float32).reshape(bsz, seq_len, S5_GROUPS, S5_GROUP)
    dt = jnp.exp(log_dt.astype(jnp.float32))[:, None]
    ar = a_re.astype(jnp.float32)
    ai = a_im.astype(jnp.float32)
    mag = jnp.exp(dt * ar)
    abar_re = mag * jnp.cos(dt * ai)
    abar_im = mag * jnp.sin(dt * ai)
    num_re = abar_re - 1.0
    num_im = abar_im
    den = ar * ar + ai * ai
    z_re = (num_re * ar + num_im * ai) / den
    z_im = (num_im * ar - num_re * ai) / den
    br = b_re.astype(jnp.float32)
    bi = b_im.astype(jnp.float32)
    bbar_re = z_re[..., None] * br - z_im[..., None] * bi
    bbar_im = z_re[..., None] * bi + z_im[..., None] * br

    bu_re = jnp.einsum('blgp,gnp->blgn', uf, bbar_re)
    bu_im = jnp.einsum('blgp,gnp->blgn', uf, bbar_im)
    a_re_t = jnp.broadcast_to(abar_re, bu_re.shape)
    a_im_t = jnp.broadcast_to(abar_im, bu_im.shape)

    def combine(e1, e2):
        a1r, a1i, x1r, x1i = e1
        a2r, a2i, x2r, x2i = e2
        return (a2r * a1r - a2i * a1i,
                a2r * a1i + a2i * a1r,
                a2r * x1r - a2i * x1i + x2r,
                a2r * x1i + a2i * x1r + x2i)

    _, _, x_re, x_im = lax.associative_scan(combine, (a_re_t, a_im_t, bu_re, bu_im), axis=1)
    y = (jnp.einsum('gpn,blgn->blgp', c_re.astype(jnp.float32), x_re)
         - jnp.einsum('gpn,blgn->blgp', c_im.astype(jnp.float32), x_im))
    y = y + d_skip.astype(jnp.float32).reshape(S5_GROUPS, S5_GROUP) * uf
    y = jax.nn.gelu(y.reshape(bsz, seq_len, S5_WIDTH))
    y = y * jax.nn.sigmoid(y @ w_glu.astype(jnp.float32) + b_glu.astype(jnp.float32))
    return y.astype(u.dtype)


def conv_ffn(x, w_up, conv_w, conv_b, w_down):
    seq_len = x.shape[1]
    hid = x @ w_up
    pad = jnp.pad(hid, ((0, 0), (CONV_WIDTH - 1, 0), (0, 0)))
    hid = conv_b + sum(pad[:, j:j + seq_len] * conv_w[j] for j in range(CONV_WIDTH))
    gate, val = jnp.split(hid, 2, axis=-1)
    return (jax.nn.silu(gate) * val) @ w_down


def setup_inputs(seed: int = 0) -> dict:
    key = jax.random.key(seed)
    ks = jax.random.split(key, 24)
    f32 = jnp.float32

    def nrm(k, shape, s):
        return jax.random.normal(k, shape, f32) * s

    def gain(k, shape):
        return 1.0 + 0.02 * jax.random.normal(k, shape, f32)

    a_im = jnp.broadcast_to(jnp.pi * jnp.arange(S5_STATE, dtype=f32), (DEPTH, S5_GROUPS, S5_STATE))
    return {
        "x": nrm(ks[0], (BATCH, SEQ, D_MODEL), 1.0),
        "in_norm_g": gain(ks[1], (DEPTH, D_MODEL)),
        "w_in": nrm(ks[2], (DEPTH, D_MODEL, IN_WIDTH), D_MODEL ** -0.5),
        "hg_lb": nrm(ks[3], (DEPTH + 1, HG_WIDTH), 0.1),
        "hg_norm_g": gain(ks[4], (DEPTH, HG_WIDTH)),
        "s5_a_re": -0.5 * jnp.exp(nrm(ks[5], (DEPTH, S5_GROUPS, S5_STATE), 0.02)),
        "s5_a_im": jnp.array(a_im),
        "s5_log_dt": jax.random.uniform(ks[6], (DEPTH, S5_GROUPS), f32, math.log(DT_MIN), math.log(DT_MAX)),
        "s5_b_re": nrm(ks[7], (DEPTH, S5_GROUPS, S5_STATE, S5_GROUP), (2 * S5_GROUP) ** -0.5),
        "s5_b_im": nrm(ks[8], (DEPTH, S5_GROUPS, S5_STATE, S5_GROUP), (2 * S5_GROUP) ** -0.5),
        "s5_c_re": nrm(ks[9], (DEPTH, S5_GROUPS, S5_GROUP, S5_STATE), S5_STATE ** -0.5),
        "s5_c_im": nrm(ks[10], (DEPTH, S5_GROUPS, S5_GROUP, S5_STATE), S5_STATE ** -0.5),
        "s5_d": nrm(ks[11], (DEPTH, S5_WIDTH), 1.0),
        "s5_w_glu": nrm(ks[12], (DEPTH, S5_WIDTH, S5_WIDTH), S5_WIDTH ** -0.5),
        "s5_b_glu": nrm(ks[13], (DEPTH, S5_WIDTH), 0.01),
        "w_out": nrm(ks[14], (DEPTH, MIX_WIDTH, D_MODEL), MIX_WIDTH ** -0.5),
        "ffn_norm_g": gain(ks[15], (DEPTH, D_MODEL)),
        "w_up": nrm(ks[16], (DEPTH, D_MODEL, 2 * D_FF), D_MODEL ** -0.5),
        "conv_w": nrm(ks[17], (DEPTH, CONV_WIDTH, 2 * D_FF), CONV_WIDTH ** -0.5),
        "conv_b": nrm(ks[18], (DEPTH, 2 * D_FF), 0.01),
        "w_down": nrm(ks[19], (DEPTH, D_FF, D_MODEL), D_FF ** -0.5),
        "final_norm_g": gain(ks[20], (D_MODEL,)),
    }


def reference(x, in_norm_g, w_in, hg_lb, hg_norm_g, s5_a_re, s5_a_im, s5_log_dt, s5_b_re, s5_b_im,
              s5_c_re, s5_c_im, s5_d, s5_w_glu, s5_b_glu, w_out, ffn_norm_g, w_up, conv_w, conv_b,
              w_down, final_norm_g):
    h = x
    lb_all = jnp.cumsum(jax.nn.softmax(hg_lb.astype(jnp.float32), axis=0), axis=0)
    for layer in range(DEPTH):
        xn = rmsnorm(h, in_norm_g[layer])
        proj = xn @ w_in[layer]
        q, fz, v, gz, u = jnp.split(proj, [HG_WIDTH, 2 * HG_WIDTH, 3 * HG_WIDTH, 4 * HG_WIDTH], axis=-1)
        o_hg = hgrn2_mix(q, fz, v, gz, lb_all[layer], hg_norm_g[layer])
        o_s5 = s5_mix(u, s5_a_re[layer], s5_a_im[layer], s5_log_dt[layer], s5_b_re[layer], s5_b_im[layer],
                      s5_c_re[layer], s5_c_im[layer], s5_d[layer], s5_w_glu[layer], s5_b_glu[layer])
        h = h + jnp.concatenate([o_hg, o_s5], axis=-1) @ w_out[layer]
        hn = rmsnorm(h, ffn_norm_g[layer])
        h = h + conv_ffn(hn, w_up[layer], conv_w[layer], conv_b[layer], w_down[layer])
    return rmsnorm(h, final_norm_g)
```

```cpp
#include <hip/hip_runtime.h>
#include <hip/hip_cooperative_groups.h>
#include <stdint.h>
#include <cstdio>
namespace cg = cooperative_groups;

#ifndef MK_FUSED
#define MK_FUSED 0
#endif

typedef unsigned short bf16_t;
typedef short bf16x8 __attribute__((ext_vector_type(8)));
typedef float f32x4 __attribute__((ext_vector_type(4)));

constexpr int T = 16384;
constexpr int NTHR = 512;
constexpr int LDS_BYTES = 128 * 1024;

struct Params {
  const float *x, *in_norm_g, *w_in, *hg_lb, *hg_norm_g, *a_re, *a_im, *log_dt, *b_re, *b_im, *c_re, *c_im, *s5_d,
      *w_glu, *b_glu, *w_out, *ffn_norm_g, *w_up, *conv_w, *conv_b, *w_down, *final_g;
  float* out;
  bf16_t *Wt_in, *Wt_glu, *Wt_out, *Wt_up, *Wt_down, *xn, *proj, *sstart, *Xs, *mix, *ybuf, *hb, *hid, *act, *Ktab, *Etab, *Ftab;
  float *logf, *dstate, *decay, *Xend, *rsq1, *rsq2;
  float2 *Pw, *Bbar;
};

__device__ __forceinline__ bf16_t f2bf(float f) { unsigned u = __float_as_uint(f); u += 0x7fffu + ((u >> 16) & 1u); return (bf16_t)(u >> 16); }
__device__ __forceinline__ float bf2f(bf16_t h) { return __uint_as_float(((unsigned)h) << 16); }
__device__ __forceinline__ unsigned pack2(float a, float b) { return (unsigned)f2bf(a) | ((unsigned)f2bf(b) << 16); }
__device__ __forceinline__ float lo2f(unsigned w) { return __uint_as_float(w << 16); }
__device__ __forceinline__ float hi2f(unsigned w) { return __uint_as_float(w & 0xffff0000u); }
__device__ __forceinline__ float sigm(float x) { return 1.f / (1.f + __expf(-x)); }
__device__ __forceinline__ float gelu_tanh(float y) {
  float u = 0.7978845608028654f * (y + 0.044715f * y * y * y);
  return y * sigm(2.f * u);
}

__device__ double exp_d(double x) {
  double k = rint(x * 1.4426950408889634);
  double r = fma(-k, 0.6931471805599453, x);
  r = fma(-k, 2.3190468138462996e-17, r);
  double p = 1.0;
#pragma unroll
  for (int i = 16; i >= 1; --i) p = 1.0 + r * p / (double)i;
  return ldexp(p, (int)k);
}
__device__ void sincos_d(double x, double& s, double& c) {
  double q = rint(x * 0.6366197723675814);
  double r = fma(-q, 1.5707963267948966, x);
  r = fma(-q, 6.123233995736766e-17, r);
  int iq = ((int)q) & 3;
  double r2 = r * r;
  double sp = 1.0, cp = 1.0;
#pragma unroll
  for (int i = 9; i >= 1; --i) sp = 1.0 - r2 * sp / (double)((2 * i) * (2 * i + 1));
  sp *= r;
#pragma unroll
  for (int i = 10; i >= 1; --i) cp = 1.0 - r2 * cp / (double)((2 * i - 1) * (2 * i));
  if (iq == 0) { s = sp; c = cp; }
  else if (iq == 1) { s = cp; c = -sp; }
  else if (iq == 2) { s = -sp; c = -cp; }
  else { s = -cp; c = sp; }
}

__device__ void transpose_tile(const float* __restrict__ src, bf16_t* __restrict__ dst, int K, int N, int tk, int tn,
                               const float* __restrict__ rowscale, float* tile) {
  const int tid = threadIdx.x;
  const int k0 = tk * 64, n0 = tn * 64;
#pragma unroll
  for (int i = 0; i < 2; ++i) {
    int idx = tid + i * 512; int r = idx >> 4, c4 = (idx & 15) * 4;
    float4 v = *(const float4*)(src + (size_t)(k0 + r) * N + n0 + c4);
    float s = rowscale ? rowscale[k0 + r] : 1.f;
    tile[r * 65 + c4 + 0] = v.x * s; tile[r * 65 + c4 + 1] = v.y * s; tile[r * 65 + c4 + 2] = v.z * s; tile[r * 65 + c4 + 3] = v.w * s;
  }
  __syncthreads();
  int n = tid >> 3, kc = (tid & 7) * 8;
  uint4 o;
  o.x = pack2(tile[(kc + 0) * 65 + n], tile[(kc + 1) * 65 + n]);
  o.y = pack2(tile[(kc + 2) * 65 + n], tile[(kc + 3) * 65 + n]);
  o.z = pack2(tile[(kc + 4) * 65 + n], tile[(kc + 5) * 65 + n]);
  o.w = pack2(tile[(kc + 6) * 65 + n], tile[(kc + 7) * 65 + n]);
  *(uint4*)(dst + (size_t)(n0 + n) * K + k0 + kc) = o;
  __syncthreads();
}

__device__ void phase_prep(const Params& p, char* smem) {
  float* tile = (float*)smem;
  const int tid = threadIdx.x, lane = tid & 63, wid = tid >> 6;
  for (int t = blockIdx.x; t < 3072; t += gridDim.x) {
    if (t < 640) transpose_tile(p.w_in, p.Wt_in, 1024, 2560, t / 40, t % 40, nullptr, tile);
    else if (t < 704) { int u = t - 640; transpose_tile(p.w_glu, p.Wt_glu, 512, 512, u / 8, u % 8, nullptr, tile); }
    else if (t < 960) { int u = t - 704; transpose_tile(p.w_out, p.Wt_out, 1024, 1024, u / 16, u % 16, nullptr, tile); }
    else if (t < 2368) { int u = t - 960; transpose_tile(p.w_up, p.Wt_up, 1024, 5632, u / 88, u % 88, p.ffn_norm_g, tile); }
    else { int u = t - 2368; transpose_tile(p.w_down, p.Wt_down, 2816, 1024, u / 16, u % 16, nullptr, tile); }
  }
  for (int row = blockIdx.x * 8 + wid; row < T; row += gridDim.x * 8) {
    const float4* xr = (const float4*)(p.x + (size_t)row * 1024);
    float4 v[4]; float ss = 0.f;
#pragma unroll
    for (int i = 0; i < 4; ++i) { v[i] = xr[lane + 64 * i]; ss += v[i].x * v[i].x + v[i].y * v[i].y + v[i].z * v[i].z + v[i].w * v[i].w; }
#pragma unroll
    for (int o = 32; o >= 1; o >>= 1) ss += __shfl_xor(ss, o);
    float rstd = rsqrtf(ss * (1.f / 1024.f) + 1e-6f);
#pragma unroll
    for (int i = 0; i < 4; ++i) {
      float4 g = ((const float4*)p.in_norm_g)[lane + 64 * i];
      uint2 o; o.x = pack2(v[i].x * rstd * g.x, v[i].y * rstd * g.y); o.y = pack2(v[i].z * rstd * g.z, v[i].w * rstd * g.w);
      *(uint2*)(p.xn + (size_t)row * 1024 + (lane + 64 * i) * 4) = o;
    }
  }
  const int gtid = blockIdx.x * NTHR + tid, gthr = gridDim.x * NTHR;
  for (int idx = gtid; idx < 32 * 17 * 64; idx += gthr) {
    int g = idx / (17 * 64), j = (idx / 64) % 17, n = idx % 64;
    double dt = exp_d((double)p.log_dt[g]);
    double ar = (double)p.a_re[g * 64 + n], ai = (double)p.a_im[g * 64 + n];
    double mag = exp_d((double)j * dt * ar), s, c;
    sincos_d((double)j * dt * ai, s, c);
    p.Pw[idx] = make_float2((float)(mag * c), (float)(mag * s));
  }
  for (int idx = gtid; idx < 32 * 64 * 16; idx += gthr) {
    int g = idx / 1024, n = (idx / 16) % 64;
    double dt = exp_d((double)p.log_dt[g]);
    double ar = (double)p.a_re[g * 64 + n], ai = (double)p.a_im[g * 64 + n];
    double mag = exp_d(dt * ar), s, c;
    sincos_d(dt * ai, s, c);
    double nr = mag * c - 1.0, ni = mag * s, den = ar * ar + ai * ai;
    double zr = (nr * ar + ni * ai) / den, zi = (ni * ar - nr * ai) / den;
    double br = (double)p.b_re[idx], bi = (double)p.b_im[idx];
    p.Bbar[idx] = make_float2((float)(zr * br - zi * bi), (float)(zr * bi + zi * br));
  }
}

__device__ void s5_tables(const Params& p) {
  const int gtid = blockIdx.x * NTHR + threadIdx.x, gthr = gridDim.x * NTHR;
  for (int idx = gtid; idx < 32 * 128 * 256; idx += gthr) {
    int g = idx >> 15, np = (idx >> 8) & 127, kk = idx & 255;
    int n = np & 63, part = np >> 6, s = kk >> 4, pp = kk & 15;
    float2 pw = p.Pw[(g * 17 + (15 - s)) * 64 + n];
    float2 bb = p.Bbar[(g * 64 + n) * 16 + pp];
    float v = part ? (pw.x * bb.y + pw.y * bb.x) : (pw.x * bb.x - pw.y * bb.y);
    p.Ftab[idx] = f2bf(v);
  }
  for (int idx = gtid; idx < 32 * 256 * 128; idx += gthr) {
    int g = idx >> 15, tp = (idx >> 7) & 255, np = idx & 127;
    int n = np & 63, part = np >> 6, t = tp >> 4, pp = tp & 15;
    float2 pw = p.Pw[(g * 17 + (t + 1)) * 64 + n];
    float cr = p.c_re[(g * 16 + pp) * 64 + n], ci = p.c_im[(g * 16 + pp) * 64 + n];
    float v = part ? -(cr * pw.y + ci * pw.x) : (cr * pw.x - ci * pw.y);
    p.Etab[idx] = f2bf(v);
  }
  for (int idx = gtid; idx < 32 * 16 * 256; idx += gthr) {
    int g = idx >> 12, tau = (idx >> 8) & 15, pp = (idx >> 4) & 15, pq = idx & 15;
    float acc = 0.f;
    for (int n = 0; n < 64; ++n) {
      float2 pw = p.Pw[(g * 17 + tau) * 64 + n];
      float2 bb = p.Bbar[(g * 64 + n) * 16 + pq];
      float cr = p.c_re[(g * 16 + pp) * 64 + n], ci = p.c_im[(g * 16 + pp) * 64 + n];
      float mr = pw.x * bb.x - pw.y * bb.y, mi = pw.x * bb.y + pw.y * bb.x;
      acc += cr * mr - ci * mi;
    }
    p.Ktab[idx] = f2bf(acc);
  }
}

struct TileMap {
  int nM, nN, nwg;
  __device__ void init(int M, int N) { nM = M / 256; nN = N / 256; nwg = nM * nN; }
  __device__ void get(int L, int& pm, int& pn) const {
    int wgid = L;
    { const int q = nwg / 8, r = nwg % 8, xcd = wgid % 8, off = wgid / 8; wgid = (xcd < r ? xcd * (q + 1) : r * (q + 1) + (xcd - r) * q) + off; }
    const int nig = 8 * nN, gid = wgid / nig, fm = gid * 8, gsz = (nM - fm) < 8 ? (nM - fm) : 8;
    pm = fm + ((wgid % nig) % gsz); pn = (wgid % nig) / gsz;
  }
};

#define LAS __attribute__((address_space(3)))
constexpr int G_BK = 64, G_HALF = 128, G_HTB = G_HALF * G_BK * 2;
__device__ __forceinline__ int lds_byte(int r, int c) {
  const int st = (r >> 4) * 2 + (c >> 5), rr = r & 15, cc = c & 31, ob = rr * 64 + cc * 2;
  return st * 1024 + (ob ^ (((ob >> 9) & 1) << 5));
}
__device__ __forceinline__ void stage_rc(int b, int& R, int& C) {
  const int st = b / 1024, sb = b % 1024, swz = sb ^ (((sb >> 9) & 1) << 5);
  R = (st >> 1) * 16 + swz / 64; C = (st & 1) * 32 + (swz % 64) / 2;
}

template <class Epi>
__device__ __forceinline__ void gemm_phase(const bf16_t* __restrict__ A, const bf16_t* __restrict__ Bt, int M, int N, int K,
                                           const Epi& E, char* smem) {
  LAS unsigned char* lds = (LAS unsigned char*)smem;
  const int tid = threadIdx.x, wid = __builtin_amdgcn_readfirstlane(tid >> 6), lane = tid & 63, wr = wid >> 2, wc = wid & 3, fr = lane & 15, fq = lane >> 4;
  const int nt = K / G_BK;
  TileMap tm; tm.init(M, N);
  if ((int)blockIdx.x >= tm.nwg) return;
  unsigned voffA[2], voffB[2];
#pragma unroll
  for (int i = 0; i < 2; ++i) { int R, C; stage_rc(tid * 16 + i * 8192, R, C); voffA[i] = (unsigned)(R * K + C) * 2u; voffB[i] = voffA[i]; }
  const size_t kstep = (size_t)(G_BK * 2);
  const size_t hstep = (size_t)G_HALF * K * 2;
  const size_t tstep = 2 * hstep;
  const unsigned ldsw = (unsigned)wid * 1024u;
  const int aoff = lds_byte(wr * 64 + fr, fq * 8), boff = lds_byte(wc * 32 + fr, fq * 8);
#define PG8_SA(b, h) (((b) * 2 + (h)) * G_HTB)
#define PG8_SB(b, h) ((4 + (b) * 2 + (h)) * G_HTB)
#define PG8_STAGE(bufoff, gbase, voff) do { _Pragma("unroll") for (int _i = 0; _i < 2; ++_i) \
    __builtin_amdgcn_global_load_lds((const unsigned*)((const char*)(gbase) + (voff)[_i]), (LAS unsigned*)(lds + (bufoff) + ldsw + _i * 8192), 16, 0, 0); } while (0)
#define PG8_LDA(dst, b, h) do { _Pragma("unroll") for (int m = 0; m < 4; ++m) _Pragma("unroll") for (int k = 0; k < 2; ++k) dst[m][k] = *(const LAS bf16x8*)(lds + PG8_SA(b, h) + aoff + m * 2048 + k * 1024); } while (0)
#define PG8_LDB(dst, b, h) do { _Pragma("unroll") for (int n = 0; n < 2; ++n) _Pragma("unroll") for (int k = 0; k < 2; ++k) dst[n][k] = *(const LAS bf16x8*)(lds + PG8_SB(b, h) + boff + n * 2048 + k * 1024); } while (0)
#define PG8_MMA(ai, bj, At_, Bt_) do { __builtin_amdgcn_s_setprio(1); _Pragma("unroll") for (int m = 0; m < 4; ++m) _Pragma("unroll") for (int n = 0; n < 2; ++n) _Pragma("unroll") for (int k = 0; k < 2; ++k) \
    acc[ai][bj][m][n] = __builtin_amdgcn_mfma_f32_16x16x32_bf16(Bt_[n][k], At_[m][k], acc[ai][bj][m][n], 0, 0, 0); __builtin_amdgcn_s_setprio(0); } while (0)
#define PG8_WAIT_V(n) asm volatile("s_waitcnt vmcnt(" #n ")" ::: "memory")
#define PG8_WAIT_L(n) asm volatile("s_waitcnt lgkmcnt(" #n ")" ::: "memory")
#define PG8_BAR __builtin_amdgcn_s_barrier()
#define PG8_SCHED __builtin_amdgcn_sched_barrier(0)
  int pm, pn, npm = 0, npn = 0, ui = 0;
  tm.get((int)blockIdx.x, pm, pn);
  f32x4 acc[2][2][4][2];
#pragma unroll
  for (int a = 0; a < 2; ++a)
#pragma unroll
    for (int b = 0; b < 2; ++b)
#pragma unroll
      for (int m = 0; m < 4; ++m)
#pragma unroll
        for (int n = 0; n < 2; ++n) acc[a][b][m][n] = (f32x4){0.f, 0.f, 0.f, 0.f};
  bf16x8 At[4][2], B0[2][2], B1[2][2];
  const char* cA = (const char*)A + (size_t)pm * tstep; const char* cB = (const char*)Bt + (size_t)pn * tstep;
  PG8_WAIT_V(0); __syncthreads();
  PG8_STAGE(PG8_SB(0, 0), cB, voffB); PG8_STAGE(PG8_SA(0, 0), cA, voffA); PG8_STAGE(PG8_SB(0, 1), cB + hstep, voffB); PG8_STAGE(PG8_SA(0, 1), cA + hstep, voffA);
  if (wr == 1) PG8_BAR;
  PG8_WAIT_V(4); PG8_BAR;
  PG8_STAGE(PG8_SB(1, 0), cB + kstep, voffB); PG8_STAGE(PG8_SA(1, 0), cA + kstep, voffA); PG8_STAGE(PG8_SB(1, 1), cB + hstep + kstep, voffB);
  PG8_WAIT_V(6); PG8_BAR;
  for (;;) {
    const int Ln = (ui + 1) * (int)gridDim.x + (int)blockIdx.x;
    const bool has_next = Ln < tm.nwg;
    if (has_next) tm.get(Ln, npm, npn);
    const char* nA = has_next ? (const char*)A + (size_t)npm * tstep : cA; const char* nB = has_next ? (const char*)Bt + (size_t)npn * tstep : cB;
    for (int t = 0; t < nt; t += 2) {
      const bool last = (t == nt - 2);
      const char* a1 = cA + (size_t)(t + 1) * kstep;
      const char* a2 = last ? nA : cA + (size_t)(t + 2) * kstep; const char* b2 = last ? nB : cB + (size_t)(t + 2) * kstep;
      const char* a3 = a2 + kstep; const char* b3 = b2 + kstep;
      PG8_LDB(B0, 0, 0); PG8_SCHED; PG8_LDA(At, 0, 0); PG8_STAGE(PG8_SA(1, 1), a1 + hstep, voffA);
      PG8_WAIT_L(8); PG8_BAR; PG8_WAIT_L(0); PG8_MMA(0, 0, At, B0); PG8_BAR; PG8_SCHED;
      PG8_LDB(B1, 0, 1); PG8_STAGE(PG8_SB(0, 0), b2, voffB);
      PG8_BAR; PG8_WAIT_L(0); PG8_MMA(0, 1, At, B1); PG8_BAR;
      PG8_LDA(At, 0, 1); PG8_STAGE(PG8_SA(0, 0), a2, voffA);
      PG8_BAR; PG8_WAIT_L(0); PG8_MMA(1, 0, At, B0); PG8_BAR; PG8_SCHED;
      PG8_STAGE(PG8_SB(0, 1), b2 + hstep, voffB);
      PG8_WAIT_V(6); PG8_BAR; PG8_MMA(1, 1, At, B1); PG8_BAR;
      PG8_LDB(B0, 1, 0); PG8_SCHED; PG8_LDA(At, 1, 0); PG8_STAGE(PG8_SA(0, 1), a2 + hstep, voffA);
      PG8_WAIT_L(8); PG8_BAR; PG8_WAIT_L(0); PG8_MMA(0, 0, At, B0); PG8_BAR; PG8_SCHED;
      PG8_LDB(B1, 1, 1); PG8_STAGE(PG8_SB(1, 0), b3, voffB);
      PG8_BAR; PG8_WAIT_L(0); PG8_MMA(0, 1, At, B1); PG8_BAR;
      PG8_LDA(At, 1, 1); PG8_STAGE(PG8_SA(1, 0), a3, voffA);
      PG8_BAR; PG8_WAIT_L(0); PG8_MMA(1, 0, At, B0); PG8_BAR; PG8_SCHED;
      PG8_STAGE(PG8_SB(1, 1), b3 + hstep, voffB);
      PG8_WAIT_V(6); PG8_BAR; PG8_MMA(1, 1, At, B1); PG8_BAR;
    }
    E(acc, pm, pn, wr, wc, fr, fq);
    if (!has_next) break;
#pragma unroll
    for (int a = 0; a < 2; ++a)
#pragma unroll
      for (int b = 0; b < 2; ++b)
#pragma unroll
        for (int m = 0; m < 4; ++m)
#pragma unroll
          for (int n = 0; n < 2; ++n) acc[a][b][m][n] = (f32x4){0.f, 0.f, 0.f, 0.f};
    pm = npm; pn = npn; cA = nA; cB = nB; ++ui;
  }
  PG8_WAIT_V(0);
  if (wr == 0) PG8_BAR;
  PG8_BAR;
#undef PG8_SA
#undef PG8_SB
#undef PG8_STAGE
#undef PG8_LDA
#undef PG8_LDB
#undef PG8_MMA
#undef PG8_WAIT_V
#undef PG8_WAIT_L
#undef PG8_BAR
#undef PG8_SCHED
}

struct EpiProj {
  bf16_t* proj; float* lgf; const float* hg_lb;
  __device__ __forceinline__ void operator()(const f32x4 (&acc)[2][2][4][2], int pm, int pn, int wr, int wc, int fr, int fq) const {
    const int sec = pn >> 1;
    if (sec == 1) {
#pragma unroll
      for (int b = 0; b < 2; ++b)
#pragma unroll
        for (int n = 0; n < 2; ++n) {
          const int col = 256 * pn + 128 * b + 32 * wc + 16 * n + 4 * fq;
          const float4 h0 = *(const float4*)(hg_lb + (col - 512)), h1 = *(const float4*)(hg_lb + col);
          float lb[4];
          lb[0] = 1.f / (1.f + __expf(h1.x - h0.x)); lb[1] = 1.f / (1.f + __expf(h1.y - h0.y));
          lb[2] = 1.f / (1.f + __expf(h1.z - h0.z)); lb[3] = 1.f / (1.f + __expf(h1.w - h0.w));
#pragma unroll
          for (int a = 0; a < 2; ++a)
#pragma unroll
            for (int m = 0; m < 4; ++m) {
              const int row = 256 * pm + 128 * a + 64 * wr + 16 * m + fr;
              f32x4 v = acc[a][b][m][n]; f32x4 lf; float kk[4];
#pragma unroll
              for (int r = 0; r < 4; ++r) {
                float l = lb[r];
                float sg = 1.f / (1.f + __expf(-v[r]));
                lf[r] = __logf(l + (1.f - l) * sg);
                kk[r] = (1.f - l) / (1.f + __expf(v[r]));
              }
              *(f32x4*)(lgf + (size_t)row * 512 + (col - 512)) = lf;
              uint2 o; o.x = pack2(kk[0], kk[1]); o.y = pack2(kk[2], kk[3]);
              *(uint2*)(proj + (size_t)row * 2560 + col) = o;
            }
        }
    } else {
#pragma unroll
      for (int a = 0; a < 2; ++a)
#pragma unroll
        for (int m = 0; m < 4; ++m) {
          const int row = 256 * pm + 128 * a + 64 * wr + 16 * m + fr;
#pragma unroll
          for (int b = 0; b < 2; ++b)
#pragma unroll
            for (int n = 0; n < 2; ++n) {
              const int col = 256 * pn + 128 * b + 32 * wc + 16 * n + 4 * fq;
              f32x4 v = acc[a][b][m][n];
              uint2 o; o.x = pack2(v[0], v[1]); o.y = pack2(v[2], v[3]);
              *(uint2*)(proj + (size_t)row * 2560 + col) = o;
            }
        }
    }
  }
};

struct EpiGlu {
  const bf16_t* ybuf; const float* b_glu; bf16_t* mix;
  __device__ __forceinline__ void operator()(const f32x4 (&acc)[2][2][4][2], int pm, int pn, int wr, int wc, int fr, int fq) const {
#pragma unroll
    for (int a = 0; a < 2; ++a)
#pragma unroll
      for (int m = 0; m < 4; ++m) {
        const int row = 256 * pm + 128 * a + 64 * wr + 16 * m + fr;
#pragma unroll
        for (int b = 0; b < 2; ++b)
#pragma unroll
          for (int n = 0; n < 2; ++n) {
            const int col = 256 * pn + 128 * b + 32 * wc + 16 * n + 4 * fq;
            f32x4 v = acc[a][b][m][n];
            float4 bg = *(const float4*)(b_glu + col);
            uint2 yw = *(const uint2*)(ybuf + (size_t)row * 512 + col);
            float o0 = lo2f(yw.x) * sigm(v[0] + bg.x), o1 = hi2f(yw.x) * sigm(v[1] + bg.y);
            float o2 = lo2f(yw.y) * sigm(v[2] + bg.z), o3 = hi2f(yw.y) * sigm(v[3] + bg.w);
            uint2 o; o.x = pack2(o0, o1); o.y = pack2(o2, o3);
            *(uint2*)(mix + (size_t)row * 1024 + 512 + col) = o;
          }
      }
  }
};

struct EpiOut {
  const float* x; float* hout; bf16_t* hb; float* rsq;
  __device__ __forceinline__ void operator()(const f32x4 (&acc)[2][2][4][2], int pm, int pn, int wr, int wc, int fr, int fq) const {
#pragma unroll
    for (int a = 0; a < 2; ++a)
#pragma unroll
      for (int m = 0; m < 4; ++m) {
        const int row = 256 * pm + 128 * a + 64 * wr + 16 * m + fr;
        float ss = 0.f;
#pragma unroll
        for (int b = 0; b < 2; ++b)
#pragma unroll
          for (int n = 0; n < 2; ++n) {
            const int col = 256 * pn + 128 * b + 32 * wc + 16 * n + 4 * fq;
            f32x4 v = acc[a][b][m][n];
            float4 xv = *(const float4*)(x + (size_t)row * 1024 + col);
            float4 hv = make_float4(xv.x + v[0], xv.y + v[1], xv.z + v[2], xv.w + v[3]);
            *(float4*)(hout + (size_t)row * 1024 + col) = hv;
            uint2 o; o.x = pack2(hv.x, hv.y); o.y = pack2(hv.z, hv.w);
            *(uint2*)(hb + (size_t)row * 1024 + col) = o;
            ss += hv.x * hv.x + hv.y * hv.y + hv.z * hv.z + hv.w * hv.w;
          }
        ss += __shfl_xor(ss, 16); ss += __shfl_xor(ss, 32);
        if (fq == 0) rsq[(size_t)row * 16 + pn * 4 + wc] = ss;
      }
  }
};

struct EpiUp {
  bf16_t* hid; const float* rsq; int row_off;
  __device__ __forceinline__ void operator()(const f32x4 (&acc)[2][2][4][2], int pm, int pn, int wr, int wc, int fr, int fq) const {
#pragma unroll
    for (int a = 0; a < 2; ++a)
#pragma unroll
      for (int m = 0; m < 4; ++m) {
        const int row = 256 * pm + 128 * a + 64 * wr + 16 * m + fr;
        const float4* rp = (const float4*)(rsq + (size_t)(row + row_off) * 16);
        float4 r0 = rp[0], r1 = rp[1], r2 = rp[2], r3 = rp[3];
        float ss = (r0.x + r0.y + r0.z + r0.w) + (r1.x + r1.y + r1.z + r1.w) + (r2.x + r2.y + r2.z + r2.w) + (r3.x + r3.y + r3.z + r3.w);
        float rstd = rsqrtf(ss * (1.f / 1024.f) + 1e-6f);
#pragma unroll
        for (int b = 0; b < 2; ++b)
#pragma unroll
          for (int n = 0; n < 2; ++n) {
            const int col = 256 * pn + 128 * b + 32 * wc + 16 * n + 4 * fq;
            f32x4 v = acc[a][b][m][n];
            uint2 o; o.x = pack2(v[0] * rstd, v[1] * rstd); o.y = pack2(v[2] * rstd, v[3] * rstd);
            *(uint2*)(hid + (size_t)row * 5632 + col) = o;
          }
      }
  }
};

struct EpiDown {
  float* out; float* rsq;
  __device__ __forceinline__ void operator()(const f32x4 (&acc)[2][2][4][2], int pm, int pn, int wr, int wc, int fr, int fq) const {
#pragma unroll
    for (int a = 0; a < 2; ++a)
#pragma unroll
      for (int m = 0; m < 4; ++m) {
        const int row = 256 * pm + 128 * a + 64 * wr + 16 * m + fr;
        float ss = 0.f;
#pragma unroll
        for (int b = 0; b < 2; ++b)
#pragma unroll
          for (int n = 0; n < 2; ++n) {
            const int col = 256 * pn + 128 * b + 32 * wc + 16 * n + 4 * fq;
            f32x4 v = acc[a][b][m][n];
            float4 xv = *(const float4*)(out + (size_t)row * 1024 + col);
            float4 hv = make_float4(xv.x + v[0], xv.y + v[1], xv.z + v[2], xv.w + v[3]);
            *(float4*)(out + (size_t)row * 1024 + col) = hv;
            ss += hv.x * hv.x + hv.y * hv.y + hv.z * hv.z + hv.w * hv.w;
          }
        ss += __shfl_xor(ss, 16); ss += __shfl_xor(ss, 32);
        if (fq == 0) rsq[(size_t)row * 16 + pn * 4 + wc] = ss;
      }
  }
};

__device__ void hg_a_item(const Params& p, int item, char* smem) {
  bf16_t* kT = (bf16_t*)smem;
  bf16_t* vT = kT + 128 * 72;
  float* tot = (float*)(vT + 128 * 72);
  const int tid = threadIdx.x, lane = tid & 63, wid = tid >> 6, fr = lane & 15, fq = lane >> 4;
  const int b = item >> 8, h = (item >> 6) & 3, n = item & 63;
  const int t0 = b * 4096 + n * 64;
  const int k = tid & 127, seg = tid >> 7;
  float bc[16];
  {
    const float* lp = p.logf + (size_t)(t0 + seg * 16) * 512 + h * 128 + k;
    float a = 0.f;
#pragma unroll
    for (int i = 0; i < 16; ++i) { a += lp[(size_t)i * 512]; bc[i] = a; }
    tot[seg * 128 + k] = a;
  }
  __syncthreads();
  float pre = 0.f, all = 0.f;
#pragma unroll
  for (int s4 = 0; s4 < 4; ++s4) { float tv = tot[s4 * 128 + k]; if (s4 < seg) pre += tv; all += tv; }
  const bf16_t* kp = p.proj + (size_t)(t0 + seg * 16) * 2560 + 512 + h * 128 + k;
  const bf16_t* vp = kp + 512;
  unsigned kw[8], vw[8];
#pragma unroll
  for (int i = 0; i < 8; ++i) {
    float k0 = bf2f(kp[(size_t)(2 * i) * 2560]) * __expf(all - (bc[2 * i] + pre));
    float k1 = bf2f(kp[(size_t)(2 * i + 1) * 2560]) * __expf(all - (bc[2 * i + 1] + pre));
    kw[i] = pack2(k0, k1);
    vw[i] = (unsigned)vp[(size_t)(2 * i) * 2560] | ((unsigned)vp[(size_t)(2 * i + 1) * 2560] << 16);
  }
  *(uint4*)(kT + k * 72 + seg * 16) = make_uint4(kw[0], kw[1], kw[2], kw[3]);
  *(uint4*)(kT + k * 72 + seg * 16 + 8) = make_uint4(kw[4], kw[5], kw[6], kw[7]);
  *(uint4*)(vT + k * 72 + seg * 16) = make_uint4(vw[0], vw[1], vw[2], vw[3]);
  *(uint4*)(vT + k * 72 + seg * 16 + 8) = make_uint4(vw[4], vw[5], vw[6], vw[7]);
  if (seg == 0) p.decay[(size_t)item * 128 + k] = __expf(all);
  __syncthreads();
  bf16x8 af[2];
#pragma unroll
  for (int ks = 0; ks < 2; ++ks) af[ks] = *(const bf16x8*)(kT + (16 * wid + fr) * 72 + 32 * ks + 8 * fq);
#pragma unroll
  for (int j = 0; j < 8; ++j) {
    f32x4 acc = (f32x4){0.f, 0.f, 0.f, 0.f};
#pragma unroll
    for (int ks = 0; ks < 2; ++ks) {
      bf16x8 bfr = *(const bf16x8*)(vT + (16 * j + fr) * 72 + 32 * ks + 8 * fq);
      acc = __builtin_amdgcn_mfma_f32_16x16x32_bf16(af[ks], bfr, acc, 0, 0, 0);
    }
    *(f32x4*)(p.dstate + (size_t)item * 16384 + (16 * j + fr) * 128 + 16 * wid + 4 * fq) = acc;
  }
  __syncthreads();
}

__device__ void hg_c_item(const Params& p, int item, char* smem) {
  bf16_t* qd = (bf16_t*)smem;
  bf16_t* kd = qd + 64 * 136;
  bf16_t* vT = kd + 64 * 136;
  bf16_t* att = vT + 128 * 72;
  float* tot = (float*)(att + 64 * 72);
  float* ssq = tot + 512;
  const int tid = threadIdx.x, lane = tid & 63, wid = tid >> 6, fr = lane & 15, fq = lane >> 4;
  const int b = item >> 8, h = (item >> 6) & 3, n = item & 63;
  const int t0 = b * 4096 + n * 64;
  const int k = tid & 127, seg = tid >> 7;
  float bc[16];
  {
    const float* lp = p.logf + (size_t)(t0 + seg * 16) * 512 + h * 128 + k;
    float a = 0.f;
#pragma unroll
    for (int i = 0; i < 16; ++i) { a += lp[(size_t)i * 512]; bc[i] = a; }
    tot[seg * 128 + k] = a;
  }
  __syncthreads();
  float pre = 0.f;
#pragma unroll
  for (int s4 = 0; s4 < 4; ++s4) { float tv = tot[s4 * 128 + k]; if (s4 < seg) pre += tv; }
  const bf16_t* qp = p.proj + (size_t)(t0 + seg * 16) * 2560 + h * 128 + k;
  unsigned vw[8];
#pragma unroll
  for (int i = 0; i < 16; ++i) {
    float bb = bc[i] + pre;
    float qv = bf2f(qp[(size_t)i * 2560]) * __expf(bb);
    float kv = bf2f(qp[(size_t)i * 2560 + 512]) * __expf(-bb);
    qd[(seg * 16 + i) * 136 + k] = f2bf(qv);
    kd[(seg * 16 + i) * 136 + k] = f2bf(kv);
    unsigned vv = (unsigned)qp[(size_t)i * 2560 + 1024];
    if (i & 1) vw[i >> 1] |= vv << 16; else vw[i >> 1] = vv;
  }
  *(uint4*)(vT + k * 72 + seg * 16) = make_uint4(vw[0], vw[1], vw[2], vw[3]);
  *(uint4*)(vT + k * 72 + seg * 16 + 8) = make_uint4(vw[4], vw[5], vw[6], vw[7]);
  __syncthreads();
  const int rt = wid & 3, hh = wid >> 2;
#pragma unroll
  for (int st2 = 0; st2 < 2; ++st2) {
    const int st = 2 * hh + st2;
    f32x4 acc = (f32x4){0.f, 0.f, 0.f, 0.f};
#pragma unroll
    for (int ks = 0; ks < 4; ++ks) {
      bf16x8 a = *(const bf16x8*)(kd + (16 * st + fr) * 136 + 32 * ks + 8 * fq);
      bf16x8 bq = *(const bf16x8*)(qd + (16 * rt + fr) * 136 + 32 * ks + 8 * fq);
      acc = __builtin_amdgcn_mfma_f32_16x16x32_bf16(a, bq, acc, 0, 0, 0);
    }
    const int c = 16 * rt + fr, s0 = 16 * st + 4 * fq;
    float v0 = (s0 + 0 <= c) ? acc[0] : 0.f, v1 = (s0 + 1 <= c) ? acc[1] : 0.f, v2 = (s0 + 2 <= c) ? acc[2] : 0.f, v3 = (s0 + 3 <= c) ? acc[3] : 0.f;
    uint2 o; o.x = pack2(v0, v1); o.y = pack2(v2, v3);
    *(uint2*)(att + c * 72 + s0) = o;
  }
  __syncthreads();
  f32x4 o[4];
#pragma unroll
  for (int j = 0; j < 4; ++j) o[j] = (f32x4){0.f, 0.f, 0.f, 0.f};
#pragma unroll
  for (int ks = 0; ks < 2; ++ks) {
    bf16x8 bq = *(const bf16x8*)(att + (16 * rt + fr) * 72 + 32 * ks + 8 * fq);
#pragma unroll
    for (int j = 0; j < 4; ++j) {
      bf16x8 a = *(const bf16x8*)(vT + (16 * (4 * hh + j) + fr) * 72 + 32 * ks + 8 * fq);
      o[j] = __builtin_amdgcn_mfma_f32_16x16x32_bf16(a, bq, o[j], 0, 0, 0);
    }
  }
  const bf16_t* sp = p.sstart + (size_t)item * 16384;
#pragma unroll
  for (int ks = 0; ks < 4; ++ks) {
    bf16x8 bq = *(const bf16x8*)(qd + (16 * rt + fr) * 136 + 32 * ks + 8 * fq);
#pragma unroll
    for (int j = 0; j < 4; ++j) {
      bf16x8 a = *(const bf16x8*)(sp + (16 * (4 * hh + j) + fr) * 128 + 32 * ks + 8 * fq);
      o[j] = __builtin_amdgcn_mfma_f32_16x16x32_bf16(a, bq, o[j], 0, 0, 0);
    }
  }
  float ss = 0.f;
#pragma unroll
  for (int j = 0; j < 4; ++j) ss += o[j][0] * o[j][0] + o[j][1] * o[j][1] + o[j][2] * o[j][2] + o[j][3] * o[j][3];
  ss += __shfl_xor(ss, 16); ss += __shfl_xor(ss, 32);
  if (fq == 0) ssq[hh * 64 + 16 * rt + fr] = ss;
  __syncthreads();
  const float tss = ssq[16 * rt + fr] + ssq[64 + 16 * rt + fr];
  const float rstd = rsqrtf(tss * (1.f / 128.f) + 1e-6f);
  const int token = t0 + 16 * rt + fr;
#pragma unroll
  for (int j = 0; j < 4; ++j) {
    const int col = h * 128 + 16 * (4 * hh + j) + 4 * fq;
    uint2 gw = *(const uint2*)(p.proj + (size_t)token * 2560 + 1536 + col);
    float4 g4 = *(const float4*)(p.hg_norm_g + col);
    float z0 = lo2f(gw.x), z1 = hi2f(gw.x), z2 = lo2f(gw.y), z3 = hi2f(gw.y);
    float r0 = o[j][0] * rstd * g4.x * z0 * sigm(z0), r1 = o[j][1] * rstd * g4.y * z1 * sigm(z1);
    float r2 = o[j][2] * rstd * g4.z * z2 * sigm(z2), r3 = o[j][3] * rstd * g4.w * z3 * sigm(z3);
    uint2 ow; ow.x = pack2(r0, r1); ow.y = pack2(r2, r3);
    *(uint2*)(p.mix + (size_t)token * 1024 + col) = ow;
  }
  __syncthreads();
}

__device__ void s5_a_wave(const Params& p, int tt, int g, int lane) {
  const int fr = lane & 15, fq = lane >> 4;
  bf16x8 U[8];
#pragma unroll
  for (int ks = 0; ks < 8; ++ks) {
    const int tok = tt * 256 + 16 * fr + 2 * ks + (fq >> 1);
    U[ks] = *(const bf16x8*)(p.proj + (size_t)tok * 2560 + 2048 + g * 16 + 8 * (fq & 1));
  }
#pragma unroll
  for (int rt = 0; rt < 8; ++rt) {
    f32x4 acc = (f32x4){0.f, 0.f, 0.f, 0.f};
#pragma unroll
    for (int ks = 0; ks < 8; ++ks) {
      bf16x8 a = *(const bf16x8*)(p.Ftab + (size_t)(g * 128 + 16 * rt + fr) * 256 + 32 * ks + 8 * fq);
      acc = __builtin_amdgcn_mfma_f32_16x16x32_bf16(a, U[ks], acc, 0, 0, 0);
    }
    *(f32x4*)(p.Xend + ((size_t)(tt * 16 + fr) * 32 + g) * 128 + 16 * rt + 4 * fq) = acc;
  }
}

__device__ void s5_c_wave(const Params& p, int tt, int g, int lane) {
  const int fr = lane & 15, fq = lane >> 4;
  bf16x8 U[8], Kf[16], Xf[4];
#pragma unroll
  for (int ks = 0; ks < 8; ++ks) {
    const int tok = tt * 256 + 16 * fr + 2 * ks + (fq >> 1);
    U[ks] = *(const bf16x8*)(p.proj + (size_t)tok * 2560 + 2048 + g * 16 + 8 * (fq & 1));
  }
#pragma unroll
  for (int d = 0; d < 16; ++d) {
    const int tau = d - (fq >> 1);
    bf16x8 z = (bf16x8){0, 0, 0, 0, 0, 0, 0, 0};
    if (tau >= 0) z = *(const bf16x8*)(p.Ktab + (size_t)((g * 16 + tau) * 16 + fr) * 16 + 8 * (fq & 1));
    Kf[d] = z;
  }
#pragma unroll
  for (int ks = 0; ks < 4; ++ks) Xf[ks] = *(const bf16x8*)(p.Xs + ((size_t)(tt * 16 + fr) * 32 + g) * 128 + 32 * ks + 8 * fq);
  const int c0 = g * 16 + 4 * fq;
  const float4 dsk = *(const float4*)(p.s5_d + c0);
#pragma unroll
  for (int t = 0; t < 16; ++t) {
    f32x4 acc = (f32x4){0.f, 0.f, 0.f, 0.f};
#pragma unroll
    for (int ks = 0; ks <= t / 2; ++ks) acc = __builtin_amdgcn_mfma_f32_16x16x32_bf16(Kf[t - 2 * ks], U[ks], acc, 0, 0, 0);
#pragma unroll
    for (int ks = 0; ks < 4; ++ks) {
      bf16x8 a = *(const bf16x8*)(p.Etab + (size_t)(g * 256 + t * 16 + fr) * 128 + 32 * ks + 8 * fq);
      acc = __builtin_amdgcn_mfma_f32_16x16x32_bf16(a, Xf[ks], acc, 0, 0, 0);
    }
    const int token = tt * 256 + 16 * fr + t;
    uint2 uw = *(const uint2*)(p.proj + (size_t)token * 2560 + 2048 + c0);
    float y0 = acc[0] + dsk.x * lo2f(uw.x), y1 = acc[1] + dsk.y * hi2f(uw.x), y2 = acc[2] + dsk.z * lo2f(uw.y), y3 = acc[3] + dsk.w * hi2f(uw.y);
    uint2 ow; ow.x = pack2(gelu_tanh(y0), gelu_tanh(y1)); ow.y = pack2(gelu_tanh(y2), gelu_tanh(y3));
    *(uint2*)(p.ybuf + (size_t)token * 512 + c0) = ow;
  }
}

__device__ void phase_mix_a(const Params& p, char* smem) {
  for (int it = blockIdx.x; it < 1024 + 256; it += gridDim.x) {
    if (it < 1024) hg_a_item(p, it, smem);
    else { int u = it - 1024; s5_a_wave(p, u >> 2, (u & 3) * 8 + (threadIdx.x >> 6), threadIdx.x & 63); }
  }
}

__device__ void phase_scan(const Params& p) {
  const int tid = threadIdx.x;
  if (tid < 32) {
    for (int it = blockIdx.x * 32 + tid; it < 8192; it += gridDim.x * 32) {
      const int bt = it >> 11, g = (it >> 6) & 31, n = it & 63;
      const float2 a16 = p.Pw[(g * 17 + 16) * 64 + n];
      float xr = 0.f, xi = 0.f;
#pragma unroll 8
      for (int jj = 0; jj < 256; ++jj) {
        const size_t base = ((size_t)(bt * 256 + jj) * 32 + g) * 128;
        p.Xs[base + n] = f2bf(xr); p.Xs[base + 64 + n] = f2bf(xi);
        const float er = p.Xend[base + n], ei = p.Xend[base + 64 + n];
        const float nr = a16.x * xr - a16.y * xi + er, ni = a16.x * xi + a16.y * xr + ei;
        xr = nr; xi = ni;
      }
    }
  }
  const int gtid = blockIdx.x * NTHR + tid, gthr = gridDim.x * NTHR;
  for (int e2 = gtid; e2 < 16 * 8192; e2 += gthr) {
    const int bh = e2 >> 13, e = (e2 & 8191) * 2, k = e & 127;
    float sx = 0.f, sy = 0.f;
#pragma unroll 8
    for (int n = 0; n < 64; ++n) {
      const int item = bh * 64 + n;
      const float2 ds = *(const float2*)(p.dstate + (size_t)item * 16384 + e);
      const float2 dc = *(const float2*)(p.decay + (size_t)item * 128 + k);
      *(unsigned*)(p.sstart + (size_t)item * 16384 + e) = pack2(sx, sy);
      sx = dc.x * sx + ds.x; sy = dc.y * sy + ds.y;
    }
  }
}

__device__ void phase_mix_c(const Params& p, char* smem) {
  for (int it = blockIdx.x; it < 1024 + 256; it += gridDim.x) {
    if (it < 1024) hg_c_item(p, it, smem);
    else { int u = it - 1024; s5_c_wave(p, u >> 2, (u & 3) * 8 + (threadIdx.x >> 6), threadIdx.x & 63); }
  }
}

__device__ void phase_conv(const Params& p, int half) {
  const int gtid = blockIdx.x * NTHR + threadIdx.x, gthr = gridDim.x * NTHR;
  for (int it = gtid; it < 512 * 352; it += gthr) {
    const int tg = it / 352, c = (it % 352) * 8;
    float wg[3][8], wv[3][8], bg[8], bv[8];
#pragma unroll
    for (int j = 0; j < 3; ++j) {
      float4 a0 = *(const float4*)(p.conv_w + j * 5632 + c), a1 = *(const float4*)(p.conv_w + j * 5632 + c + 4);
      float4 b0 = *(const float4*)(p.conv_w + j * 5632 + 2816 + c), b1 = *(const float4*)(p.conv_w + j * 5632 + 2816 + c + 4);
      wg[j][0] = a0.x; wg[j][1] = a0.y; wg[j][2] = a0.z; wg[j][3] = a0.w; wg[j][4] = a1.x; wg[j][5] = a1.y; wg[j][6] = a1.z; wg[j][7] = a1.w;
      wv[j][0] = b0.x; wv[j][1] = b0.y; wv[j][2] = b0.z; wv[j][3] = b0.w; wv[j][4] = b1.x; wv[j][5] = b1.y; wv[j][6] = b1.z; wv[j][7] = b1.w;
    }
    {
      float4 a0 = *(const float4*)(p.conv_b + c), a1 = *(const float4*)(p.conv_b + c + 4);
      float4 b0 = *(const float4*)(p.conv_b + 2816 + c), b1 = *(const float4*)(p.conv_b + 2816 + c + 4);
      bg[0] = a0.x; bg[1] = a0.y; bg[2] = a0.z; bg[3] = a0.w; bg[4] = a1.x; bg[5] = a1.y; bg[6] = a1.z; bg[7] = a1.w;
      bv[0] = b0.x; bv[1] = b0.y; bv[2] = b0.z; bv[3] = b0.w; bv[4] = b1.x; bv[5] = b1.y; bv[6] = b1.z; bv[7] = b1.w;
    }
    const int lr0 = tg * 16;
    const int l0 = lr0 & 4095;
    uint4 g2 = make_uint4(0, 0, 0, 0), g1 = g2, v2 = g2, v1 = g2;
    if (l0 >= 2) {
      g2 = *(const uint4*)(p.hid + (size_t)(lr0 - 2) * 5632 + c); v2 = *(const uint4*)(p.hid + (size_t)(lr0 - 2) * 5632 + 2816 + c);
      g1 = *(const uint4*)(p.hid + (size_t)(lr0 - 1) * 5632 + c); v1 = *(const uint4*)(p.hid + (size_t)(lr0 - 1) * 5632 + 2816 + c);
    }
#pragma unroll 4
    for (int i = 0; i < 16; ++i) {
      const uint4 g0 = *(const uint4*)(p.hid + (size_t)(lr0 + i) * 5632 + c);
      const uint4 v0 = *(const uint4*)(p.hid + (size_t)(lr0 + i) * 5632 + 2816 + c);
      const unsigned G2[4] = {g2.x, g2.y, g2.z, g2.w}, G1[4] = {g1.x, g1.y, g1.z, g1.w}, G0[4] = {g0.x, g0.y, g0.z, g0.w};
      const unsigned V2[4] = {v2.x, v2.y, v2.z, v2.w}, V1[4] = {v1.x, v1.y, v1.z, v1.w}, V0[4] = {v0.x, v0.y, v0.z, v0.w};
      unsigned ow[4];
#pragma unroll
      for (int q = 0; q < 4; ++q) {
        float ga = bg[2 * q] + wg[0][2 * q] * lo2f(G2[q]) + wg[1][2 * q] * lo2f(G1[q]) + wg[2][2 * q] * lo2f(G0[q]);
        float gb = bg[2 * q + 1] + wg[0][2 * q + 1] * hi2f(G2[q]) + wg[1][2 * q + 1] * hi2f(G1[q]) + wg[2][2 * q + 1] * hi2f(G0[q]);
        float va = bv[2 * q] + wv[0][2 * q] * lo2f(V2[q]) + wv[1][2 * q] * lo2f(V1[q]) + wv[2][2 * q] * lo2f(V0[q]);
        float vb = bv[2 * q + 1] + wv[0][2 * q + 1] * hi2f(V2[q]) + wv[1][2 * q + 1] * hi2f(V1[q]) + wv[2][2 * q + 1] * hi2f(V0[q]);
        ow[q] = pack2(ga * sigm(ga) * va, gb * sigm(gb) * vb);
      }
      *(uint4*)(p.act + (size_t)(half * 8192 + lr0 + i) * 2816 + c) = make_uint4(ow[0], ow[1], ow[2], ow[3]);
      g2 = g1; g1 = g0; v2 = v1; v1 = v0;
    }
  }
}

__device__ void phase_final(const Params& p) {
  const int lane = threadIdx.x & 63, wid = threadIdx.x >> 6;
  for (int row = blockIdx.x * 8 + wid; row < T; row += gridDim.x * 8) {
    const float4* rp = (const float4*)(p.rsq2 + (size_t)row * 16);
    float4 r0 = rp[0], r1 = rp[1], r2 = rp[2], r3 = rp[3];
    float ss = (r0.x + r0.y + r0.z + r0.w) + (r1.x + r1.y + r1.z + r1.w) + (r2.x + r2.y + r2.z + r2.w) + (r3.x + r3.y + r3.z + r3.w);
    float rstd = rsqrtf(ss * (1.f / 1024.f) + 1e-6f);
    float4* op = (float4*)(p.out + (size_t)row * 1024);
#pragma unroll
    for (int i = 0; i < 4; ++i) {
      float4 v = op[lane + 64 * i]; float4 g = ((const float4*)p.final_g)[lane + 64 * i];
      v.x *= rstd * g.x; v.y *= rstd * g.y; v.z *= rstd * g.z; v.w *= rstd * g.w;
      op[lane + 64 * i] = v;
    }
  }
}

template <int PH>
__device__ __forceinline__ void run_phase(const Params& p, char* smem) {
  if (PH == 0) phase_prep(p, smem);
  if (PH == 1) { s5_tables(p); EpiProj e{p.proj, p.logf, p.hg_lb}; gemm_phase(p.xn, p.Wt_in, T, 2560, 1024, e, smem); }
  if (PH == 2) phase_mix_a(p, smem);
  if (PH == 3) phase_scan(p);
  if (PH == 4) phase_mix_c(p, smem);
  if (PH == 5) { EpiGlu e{p.ybuf, p.b_glu, p.mix}; gemm_phase(p.ybuf, p.Wt_glu, T, 512, 512, e, smem); }
  if (PH == 6) { EpiOut e{p.x, p.out, p.hb, p.rsq1}; gemm_phase(p.mix, p.Wt_out, T, 1024, 1024, e, smem); }
  if (PH == 7) { EpiUp e{p.hid, p.rsq1, 0}; gemm_phase(p.hb, p.Wt_up, 8192, 5632, 1024, e, smem); }
  if (PH == 8) phase_conv(p, 0);
  if (PH == 9) { EpiUp e{p.hid, p.rsq1, 8192}; gemm_phase(p.hb + (size_t)8192 * 1024, p.Wt_up, 8192, 5632, 1024, e, smem); }
  if (PH == 10) phase_conv(p, 1);
  if (PH == 11) { EpiDown e{p.out, p.rsq2}; gemm_phase(p.act, p.Wt_down, T, 1024, 2816, e, smem); }
  if (PH == 12) phase_final(p);
}

#if MK_FUSED
__global__ void __launch_bounds__(NTHR) fwd_megakernel(Params p) {
  extern __shared__ __attribute__((aligned(16))) char smem[];
  cg::grid_group grid = cg::this_grid();
  run_phase<0>(p, smem); grid.sync();
  run_phase<1>(p, smem); grid.sync();
  run_phase<2>(p, smem); grid.sync();
  run_phase<3>(p, smem); grid.sync();
  run_phase<4>(p, smem); grid.sync();
  run_phase<5>(p, smem); grid.sync();
  run_phase<6>(p, smem); grid.sync();
  run_phase<7>(p, smem); grid.sync();
  run_phase<8>(p, smem); grid.sync();
  run_phase<9>(p, smem); grid.sync();
  run_phase<10>(p, smem); grid.sync();
  run_phase<11>(p, smem); grid.sync();
  run_phase<12>(p, smem);
}
#else
template <int PH>
__global__ void __launch_bounds__(NTHR) phase_kernel(Params p) {
  extern __shared__ __attribute__((aligned(16))) char smem[];
  run_phase<PH>(p, smem);
}
template <int PH>
static void launch_phase(const Params& p, int grid, hipStream_t stream) {
  (void)hipFuncSetAttribute((const void*)phase_kernel<PH>, hipFuncAttributeMaxDynamicSharedMemorySize, LDS_BYTES);
  hipLaunchKernelGGL(phase_kernel<PH>, dim3(grid), dim3(NTHR), LDS_BYTES, stream, p);
}
#endif

extern "C" void kernel_launch(void* const* d_in, const int* in_sizes, int n_in, void* d_out, int out_size, void* d_ws,
                              size_t ws_size, hipStream_t stream) {
  Params p{};
  p.x = (const float*)d_in[0]; p.in_norm_g = (const float*)d_in[1]; p.w_in = (const float*)d_in[2]; p.hg_lb = (const float*)d_in[3];
  p.hg_norm_g = (const float*)d_in[4]; p.a_re = (const float*)d_in[5]; p.a_im = (const float*)d_in[6]; p.log_dt = (const float*)d_in[7];
  p.b_re = (const float*)d_in[8]; p.b_im = (const float*)d_in[9]; p.c_re = (const float*)d_in[10]; p.c_im = (const float*)d_in[11];
  p.s5_d = (const float*)d_in[12]; p.w_glu = (const float*)d_in[13]; p.b_glu = (const float*)d_in[14]; p.w_out = (const float*)d_in[15];
  p.ffn_norm_g = (const float*)d_in[16]; p.w_up = (const float*)d_in[17]; p.conv_w = (const float*)d_in[18]; p.conv_b = (const float*)d_in[19];
  p.w_down = (const float*)d_in[20]; p.final_g = (const float*)d_in[21];
  p.out = (float*)d_out;
  char* ws = (char*)d_ws;
  size_t off = 0;
  auto take = [&](size_t bytes) { char* r = ws + off; off += (bytes + 255) & ~(size_t)255; return r; };
  p.Wt_in = (bf16_t*)take((size_t)2560 * 1024 * 2);
  p.Wt_glu = (bf16_t*)take((size_t)512 * 512 * 2);
  p.Wt_out = (bf16_t*)take((size_t)1024 * 1024 * 2);
  p.Wt_up = (bf16_t*)take((size_t)5632 * 1024 * 2);
  p.Wt_down = (bf16_t*)take((size_t)1024 * 2816 * 2);
  p.Ktab = (bf16_t*)take((size_t)32 * 16 * 256 * 2);
  p.Etab = (bf16_t*)take((size_t)32 * 256 * 128 * 2);
  p.Ftab = (bf16_t*)take((size_t)32 * 128 * 256 * 2);
  p.Pw = (float2*)take((size_t)32 * 17 * 64 * 8);
  p.Bbar = (float2*)take((size_t)32 * 64 * 16 * 8);
  p.rsq1 = (float*)take((size_t)T * 16 * 4);
  p.rsq2 = (float*)take((size_t)T * 16 * 4);
  p.decay = (float*)take((size_t)1024 * 128 * 4);
  const size_t dyn0 = off;
  p.xn = (bf16_t*)take((size_t)T * 1024 * 2);
  p.sstart = p.xn; p.hb = p.xn;
  const size_t r2 = off;
  p.proj = (bf16_t*)take((size_t)T * 2560 * 2);
  p.logf = (float*)take((size_t)T * 512 * 4);
  p.mix = (bf16_t*)take((size_t)T * 1024 * 2);
  p.ybuf = (bf16_t*)take((size_t)T * 512 * 2);
  p.Xend = (float*)take((size_t)1024 * 32 * 128 * 4);
  p.Xs = (bf16_t*)take((size_t)1024 * 32 * 128 * 2);
  const size_t endA = off;
  p.dstate = (float*)d_out;
  off = r2;
  p.act = (bf16_t*)take((size_t)T * 2816 * 2);
  p.hid = (bf16_t*)take((size_t)8192 * 5632 * 2);
  const size_t endB = off;
  (void)dyn0;
  if (endA > ws_size || endB > ws_size) fprintf(stderr, "workspace too small: need %zu / %zu have %zu\n", endA, endB, ws_size);

  static int grid_blocks = 0;
#if MK_FUSED
  if (!grid_blocks) {
    int dev = 0, cus = 0, per_cu = 0;
    (void)hipGetDevice(&dev);
    (void)hipDeviceGetAttribute(&cus, hipDeviceAttributeMultiprocessorCount, dev);
    (void)hipFuncSetAttribute((const void*)fwd_megakernel, hipFuncAttributeMaxDynamicSharedMemorySize, LDS_BYTES);
    (void)hipOccupancyMaxActiveBlocksPerMultiprocessor(&per_cu, fwd_megakernel, NTHR, LDS_BYTES);
    if (per_cu > 1) per_cu = 1;
    grid_blocks = cus * per_cu;
  }
  void* args[] = {&p};
  hipError_t e = hipLaunchCooperativeKernel((void*)fwd_megakernel, dim3(grid_blocks), dim3(NTHR), args, LDS_BYTES, stream);
  if (e != hipSuccess) fprintf(stderr, "cooperative launch failed: %s (grid %d)\n", hipGetErrorString(e), grid_blocks);
#else
  if (!grid_blocks) {
    int dev = 0, cus = 0;
    (void)hipGetDevice(&dev);
    (void)hipDeviceGetAttribute(&cus, hipDeviceAttributeMultiprocessorCount, dev);
    grid_blocks = cus;
  }
  launch_phase<0>(p, grid_blocks, stream);
  launch_phase<1>(p, grid_blocks, stream);
  launch_phase<2>(p, grid_blocks, stream);
  launch_phase<3>(p, grid_blocks, stream);
  launch_phase<4>(p, grid_blocks, stream);
  launch_phase<5>(p, grid_blocks, stream);
  launch_phase<6>(p, grid_blocks, stream);
  launch_phase<7>(p, grid_blocks, stream);
  launch_phase<8>(p, grid_blocks, stream);
  launch_phase<9>(p, grid_blocks, stream);
  launch_phase<10>(p, grid_blocks, stream);
  launch_phase<11>(p, grid_blocks, stream);
  launch_phase<12>(p, grid_blocks, stream);
#endif
}
```

```cpp
#include <hip/hip_runtime.h>
#include <hip/hip_cooperative_groups.h>
#include <stdint.h>
#include <cstdio>
namespace cg = cooperative_groups;

#ifndef MK_FUSED
#define MK_FUSED 1
#endif

typedef unsigned short bf16_t;
typedef short bf16x8 __attribute__((ext_vector_type(8)));
typedef float f32x4 __attribute__((ext_vector_type(4)));

constexpr int T = 16384;
constexpr int NTHR = 512;
constexpr int LDS_BYTES = 128 * 1024 + 16;

struct Params {
  const float *x, *in_norm_g, *w_in, *hg_lb, *hg_norm_g, *a_re, *a_im, *log_dt, *b_re, *b_im, *c_re, *c_im, *s5_d,
      *w_glu, *b_glu, *w_out, *ffn_norm_g, *w_up, *conv_w, *conv_b, *w_down, *final_g;
  float* out;
  bf16_t *Wt_in, *Wt_glu, *Wt_out, *Wt_up, *Wt_down, *xn, *proj, *sstart, *Xs, *mix, *ybuf, *hb, *hid, *act, *Ktab, *Etab, *Ftab;
  float *logf, *dstate, *decay, *Xend, *rsq1, *rsq2;
  float2 *Pw, *Bbar;
  unsigned* bar;
};

__device__ __forceinline__ bf16_t f2bf(float f) { unsigned u = __float_as_uint(f); u += 0x7fffu + ((u >> 16) & 1u); return (bf16_t)(u >> 16); }
__device__ __forceinline__ float bf2f(bf16_t h) { return __uint_as_float(((unsigned)h) << 16); }
__device__ __forceinline__ unsigned pack2(float a, float b) { return (unsigned)f2bf(a) | ((unsigned)f2bf(b) << 16); }
__device__ __forceinline__ float lo2f(unsigned w) { return __uint_as_float(w << 16); }
__device__ __forceinline__ float hi2f(unsigned w) { return __uint_as_float(w & 0xffff0000u); }
__device__ __forceinline__ float sigm(float x) { return 1.f / (1.f + __expf(-x)); }
__device__ __forceinline__ float gelu_tanh(float y) {
  float u = 0.7978845608028654f * (y + 0.044715f * y * y * y);
  return y * sigm(2.f * u);
}

__device__ double exp_d(double x) {
  double k = rint(x * 1.4426950408889634);
  double r = fma(-k, 0.6931471805599453, x);
  r = fma(-k, 2.3190468138462996e-17, r);
  double p = 1.0;
#pragma unroll
  for (int i = 16; i >= 1; --i) p = 1.0 + r * p / (double)i;
  return ldexp(p, (int)k);
}
__device__ void sincos_d(double x, double& s, double& c) {
  double q = rint(x * 0.6366197723675814);
  double r = fma(-q, 1.5707963267948966, x);
  r = fma(-q, 6.123233995736766e-17, r);
  int iq = ((int)q) & 3;
  double r2 = r * r;
  double sp = 1.0, cp = 1.0;
#pragma unroll
  for (int i = 9; i >= 1; --i) sp = 1.0 - r2 * sp / (double)((2 * i) * (2 * i + 1));
  sp *= r;
#pragma unroll
  for (int i = 10; i >= 1; --i) cp = 1.0 - r2 * cp / (double)((2 * i - 1) * (2 * i));
  if (iq == 0) { s = sp; c = cp; }
  else if (iq == 1) { s = cp; c = -sp; }
  else if (iq == 2) { s = -sp; c = -cp; }
  else { s = -cp; c = sp; }
}

__device__ void transpose_tile(const float* __restrict__ src, bf16_t* __restrict__ dst, int K, int N, int tk, int tn,
                               const float* __restrict__ rowscale, float* tile) {
  const int tid = threadIdx.x;
  const int k0 = tk * 64, n0 = tn * 64;
#pragma unroll
  for (int i = 0; i < 2; ++i) {
    int idx = tid + i * 512; int r = idx >> 4, c4 = (idx & 15) * 4;
    float4 v = *(const float4*)(src + (size_t)(k0 + r) * N + n0 + c4);
    float s = rowscale ? rowscale[k0 + r] : 1.f;
    tile[r * 65 + c4 + 0] = v.x * s; tile[r * 65 + c4 + 1] = v.y * s; tile[r * 65 + c4 + 2] = v.z * s; tile[r * 65 + c4 + 3] = v.w * s;
  }
  __syncthreads();
  int n = tid >> 3, kc = (tid & 7) * 8;
  uint4 o;
  o.x = pack2(tile[(kc + 0) * 65 + n], tile[(kc + 1) * 65 + n]);
  o.y = pack2(tile[(kc + 2) * 65 + n], tile[(kc + 3) * 65 + n]);
  o.z = pack2(tile[(kc + 4) * 65 + n], tile[(kc + 5) * 65 + n]);
  o.w = pack2(tile[(kc + 6) * 65 + n], tile[(kc + 7) * 65 + n]);
  *(uint4*)(dst + (size_t)(n0 + n) * K + k0 + kc) = o;
  __syncthreads();
}

__device__ void phase_prep(const Params& p, char* smem) {
  float* tile = (float*)smem;
  const int tid = threadIdx.x, lane = tid & 63, wid = tid >> 6;
  for (int t = blockIdx.x; t < 3072; t += gridDim.x) {
    if (t < 640) transpose_tile(p.w_in, p.Wt_in, 1024, 2560, t / 40, t % 40, nullptr, tile);
    else if (t < 704) { int u = t - 640; transpose_tile(p.w_glu, p.Wt_glu, 512, 512, u / 8, u % 8, nullptr, tile); }
    else if (t < 960) { int u = t - 704; transpose_tile(p.w_out, p.Wt_out, 1024, 1024, u / 16, u % 16, nullptr, tile); }
    else if (t < 2368) { int u = t - 960; transpose_tile(p.w_up, p.Wt_up, 1024, 5632, u / 88, u % 88, p.ffn_norm_g, tile); }
    else { int u = t - 2368; transpose_tile(p.w_down, p.Wt_down, 2816, 1024, u / 16, u % 16, nullptr, tile); }
  }
  for (int row = blockIdx.x * 8 + wid; row < T; row += gridDim.x * 8) {
    const float4* xr = (const float4*)(p.x + (size_t)row * 1024);
    float4 v[4]; float ss = 0.f;
#pragma unroll
    for (int i = 0; i < 4; ++i) { v[i] = xr[lane + 64 * i]; ss += v[i].x * v[i].x + v[i].y * v[i].y + v[i].z * v[i].z + v[i].w * v[i].w; }
#pragma unroll
    for (int o = 32; o >= 1; o >>= 1) ss += __shfl_xor(ss, o);
    float rstd = rsqrtf(ss * (1.f / 1024.f) + 1e-6f);
#pragma unroll
    for (int i = 0; i < 4; ++i) {
      float4 g = ((const float4*)p.in_norm_g)[lane + 64 * i];
      uint2 o; o.x = pack2(v[i].x * rstd * g.x, v[i].y * rstd * g.y); o.y = pack2(v[i].z * rstd * g.z, v[i].w * rstd * g.w);
      *(uint2*)(p.xn + (size_t)row * 1024 + (lane + 64 * i) * 4) = o;
    }
  }
  const int gtid = blockIdx.x * NTHR + tid, gthr = gridDim.x * NTHR;
  for (int idx = gtid; idx < 32 * 17 * 64; idx += gthr) {
    int g = idx / (17 * 64), j = (idx / 64) % 17, n = idx % 64;
    double dt = exp_d((double)p.log_dt[g]);
    double ar = (double)p.a_re[g * 64 + n], ai = (double)p.a_im[g * 64 + n];
    double mag = exp_d((double)j * dt * ar), s, c;
    sincos_d((double)j * dt * ai, s, c);
    p.Pw[idx] = make_float2((float)(mag * c), (float)(mag * s));
  }
  for (int idx = gtid; idx < 32 * 64 * 16; idx += gthr) {
    int g = idx / 1024, n = (idx / 16) % 64;
    double dt = exp_d((double)p.log_dt[g]);
    double ar = (double)p.a_re[g * 64 + n], ai = (double)p.a_im[g * 64 + n];
    double mag = exp_d(dt * ar), s, c;
    sincos_d(dt * ai, s, c);
    double nr = mag * c - 1.0, ni = mag * s, den = ar * ar + ai * ai;
    double zr = (nr * ar + ni * ai) / den, zi = (ni * ar - nr * ai) / den;
    double br = (double)p.b_re[idx], bi = (double)p.b_im[idx];
    p.Bbar[idx] = make_float2((float)(zr * br - zi * bi), (float)(zr * bi + zi * br));
  }
}

__device__ void s5_tables(const Params& p) {
  const int gtid = blockIdx.x * NTHR + threadIdx.x, gthr = gridDim.x * NTHR;
  for (int idx = gtid; idx < 32 * 128 * 256; idx += gthr) {
    int g = idx >> 15, np = (idx >> 8) & 127, kk = idx & 255;
    int n = np & 63, part = np >> 6, s = kk >> 4, pp = kk & 15;
    float2 pw = p.Pw[(g * 17 + (15 - s)) * 64 + n];
    float2 bb = p.Bbar[(g * 64 + n) * 16 + pp];
    float v = part ? (pw.x * bb.y + pw.y * bb.x) : (pw.x * bb.x - pw.y * bb.y);
    p.Ftab[idx] = f2bf(v);
  }
  for (int idx = gtid; idx < 32 * 256 * 128; idx += gthr) {
    int g = idx >> 15, tp = (idx >> 7) & 255, np = idx & 127;
    int n = np & 63, part = np >> 6, t = tp >> 4, pp = tp & 15;
    float2 pw = p.Pw[(g * 17 + (t + 1)) * 64 + n];
    float cr = p.c_re[(g * 16 + pp) * 64 + n], ci = p.c_im[(g * 16 + pp) * 64 + n];
    float v = part ? -(cr * pw.y + ci * pw.x) : (cr * pw.x - ci * pw.y);
    p.Etab[idx] = f2bf(v);
  }
  for (int idx = gtid; idx < 32 * 16 * 256; idx += gthr) {
    int g = idx >> 12, tau = (idx >> 8) & 15, pp = (idx >> 4) & 15, pq = idx & 15;
    float acc = 0.f;
    for (int n = 0; n < 64; ++n) {
      float2 pw = p.Pw[(g * 17 + tau) * 64 + n];
      float2 bb = p.Bbar[(g * 64 + n) * 16 + pq];
      float cr = p.c_re[(g * 16 + pp) * 64 + n], ci = p.c_im[(g * 16 + pp) * 64 + n];
      float mr = pw.x * bb.x - pw.y * bb.y, mi = pw.x * bb.y + pw.y * bb.x;
      acc += cr * mr - ci * mi;
    }
    p.Ktab[idx] = f2bf(acc);
  }
}

struct TileMap {
  int nM, nN, nwg;
  __device__ void init(int M, int N) { nM = M / 256; nN = N / 256; nwg = nM * nN; }
  __device__ void get(int L, int& pm, int& pn) const {
    int wgid = L;
    { const int q = nwg / 8, r = nwg % 8, xcd = wgid % 8, off = wgid / 8; wgid = (xcd < r ? xcd * (q + 1) : r * (q + 1) + (xcd - r) * q) + off; }
    const int nig = 8 * nN, gid = wgid / nig, fm = gid * 8, gsz = (nM - fm) < 8 ? (nM - fm) : 8;
    pm = fm + ((wgid % nig) % gsz); pn = (wgid % nig) / gsz;
  }
};

#define LAS __attribute__((address_space(3)))
constexpr int G_BK = 64, G_HALF = 128, G_HTB = G_HALF * G_BK * 2;
__device__ __forceinline__ int lds_byte(int r, int c) {
  const int st = (r >> 4) * 2 + (c >> 5), rr = r & 15, cc = c & 31, ob = rr * 64 + cc * 2;
  return st * 1024 + (ob ^ (((ob >> 9) & 1) << 5));
}
__device__ __forceinline__ void stage_rc(int b, int& R, int& C) {
  const int st = b / 1024, sb = b % 1024, swz = sb ^ (((sb >> 9) & 1) << 5);
  R = (st >> 1) * 16 + swz / 64; C = (st & 1) * 32 + (swz % 64) / 2;
}

template <class Epi>
__device__ __forceinline__ void gemm_phase(const bf16_t* __restrict__ A, const bf16_t* __restrict__ Bt, int M, int N, int K,
                                           const Epi& E, char* smem) {
  LAS unsigned char* lds = (LAS unsigned char*)smem;
  const int tid = threadIdx.x, wid = __builtin_amdgcn_readfirstlane(tid >> 6), lane = tid & 63, wr = wid >> 2, wc = wid & 3, fr = lane & 15, fq = lane >> 4;
  const int nt = K / G_BK;
  TileMap tm; tm.init(M, N);
  if ((int)blockIdx.x >= tm.nwg) return;
  unsigned voffA[2], voffB[2];
#pragma unroll
  for (int i = 0; i < 2; ++i) { int R, C; stage_rc(tid * 16 + i * 8192, R, C); voffA[i] = (unsigned)(R * K + C) * 2u; voffB[i] = voffA[i]; }
  const size_t kstep = (size_t)(G_BK * 2);
  const size_t hstep = (size_t)G_HALF * K * 2;
  const size_t tstep = 2 * hstep;
  const unsigned ldsw = (unsigned)wid * 1024u;
  const int aoff = lds_byte(wr * 64 + fr, fq * 8), boff = lds_byte(wc * 32 + fr, fq * 8);
#define PG8_SA(b, h) (((b) * 2 + (h)) * G_HTB)
#define PG8_SB(b, h) ((4 + (b) * 2 + (h)) * G_HTB)
#define PG8_STAGE(bufoff, gbase, voff) do { _Pragma("unroll") for (int _i = 0; _i < 2; ++_i) \
    __builtin_amdgcn_global_load_lds((const unsigned*)((const char*)(gbase) + (voff)[_i]), (LAS unsigned*)(lds + (bufoff) + ldsw + _i * 8192), 16, 0, 0); } while (0)
#define PG8_LDA(dst, b, h) do { _Pragma("unroll") for (int m = 0; m < 4; ++m) _Pragma("unroll") for (int k = 0; k < 2; ++k) dst[m][k] = *(const LAS bf16x8*)(lds + PG8_SA(b, h) + aoff + m * 2048 + k * 1024); } while (0)
#define PG8_LDB(dst, b, h) do { _Pragma("unroll") for (int n = 0; n < 2; ++n) _Pragma("unroll") for (int k = 0; k < 2; ++k) dst[n][k] = *(const LAS bf16x8*)(lds + PG8_SB(b, h) + boff + n * 2048 + k * 1024); } while (0)
#define PG8_MMA(ai, bj, At_, Bt_) do { __builtin_amdgcn_s_setprio(1); _Pragma("unroll") for (int m = 0; m < 4; ++m) _Pragma("unroll") for (int n = 0; n < 2; ++n) _Pragma("unroll") for (int k = 0; k < 2; ++k) \
    acc[ai][bj][m][n] = __builtin_amdgcn_mfma_f32_16x16x32_bf16(Bt_[n][k], At_[m][k], acc[ai][bj][m][n], 0, 0, 0); __builtin_amdgcn_s_setprio(0); } while (0)
#define PG8_WAIT_V(n) asm volatile("s_waitcnt vmcnt(" #n ")" ::: "memory")
#define PG8_WAIT_L(n) asm volatile("s_waitcnt lgkmcnt(" #n ")" ::: "memory")
#define PG8_BAR __builtin_amdgcn_s_barrier()
#define PG8_SCHED __builtin_amdgcn_sched_barrier(0)
  int pm, pn, npm = 0, npn = 0, ui = 0;
  tm.get((int)blockIdx.x, pm, pn);
  f32x4 acc[2][2][4][2];
#pragma unroll
  for (int a = 0; a < 2; ++a)
#pragma unroll
    for (int b = 0; b < 2; ++b)
#pragma unroll
      for (int m = 0; m < 4; ++m)
#pragma unroll
        for (int n = 0; n < 2; ++n) acc[a][b][m][n] = (f32x4){0.f, 0.f, 0.f, 0.f};
  bf16x8 At[4][2], B0[2][2], B1[2][2];
  const char* cA = (const char*)A + (size_t)pm * tstep; const char* cB = (const char*)Bt + (size_t)pn * tstep;
  PG8_WAIT_V(0); __syncthreads();
  PG8_STAGE(PG8_SB(0, 0), cB, voffB); PG8_STAGE(PG8_SA(0, 0), cA, voffA); PG8_STAGE(PG8_SB(0, 1), cB + hstep, voffB); PG8_STAGE(PG8_SA(0, 1), cA + hstep, voffA);
  if (wr == 1) PG8_BAR;
  PG8_WAIT_V(4); PG8_BAR;
  PG8_STAGE(PG8_SB(1, 0), cB + kstep, voffB); PG8_STAGE(PG8_SA(1, 0), cA + kstep, voffA); PG8_STAGE(PG8_SB(1, 1), cB + hstep + kstep, voffB);
  PG8_WAIT_V(6); PG8_BAR;
  for (;;) {
    const int Ln = (ui + 1) * (int)gridDim.x + (int)blockIdx.x;
    const bool has_next = Ln < tm.nwg;
    if (has_next) tm.get(Ln, npm, npn);
    const char* nA = has_next ? (const char*)A + (size_t)npm * tstep : cA; const char* nB = has_next ? (const char*)Bt + (size_t)npn * tstep : cB;
    for (int t = 0; t < nt; t += 2) {
      const bool last = (t == nt - 2);
      const char* a1 = cA + (size_t)(t + 1) * kstep;
      const char* a2 = last ? nA : cA + (size_t)(t + 2) * kstep; const char* b2 = last ? nB : cB + (size_t)(t + 2) * kstep;
      const char* a3 = a2 + kstep; const char* b3 = b2 + kstep;
      PG8_LDB(B0, 0, 0); PG8_SCHED; PG8_LDA(At, 0, 0); PG8_STAGE(PG8_SA(1, 1), a1 + hstep, voffA);
      PG8_WAIT_L(8); PG8_BAR; PG8_WAIT_L(0); PG8_MMA(0, 0, At, B0); PG8_BAR; PG8_SCHED;
      PG8_LDB(B1, 0, 1); PG8_STAGE(PG8_SB(0, 0), b2, voffB);
      PG8_BAR; PG8_WAIT_L(0); PG8_MMA(0, 1, At, B1); PG8_BAR;
      PG8_LDA(At, 0, 1); PG8_STAGE(PG8_SA(0, 0), a2, voffA);
      PG8_BAR; PG8_WAIT_L(0); PG8_MMA(1, 0, At, B0); PG8_BAR; PG8_SCHED;
      PG8_STAGE(PG8_SB(0, 1), b2 + hstep, voffB);
      PG8_WAIT_V(6); PG8_BAR; PG8_MMA(1, 1, At, B1); PG8_BAR;
      PG8_LDB(B0, 1, 0); PG8_SCHED; PG8_LDA(At, 1, 0); PG8_STAGE(PG8_SA(0, 1), a2 + hstep, voffA);
      PG8_WAIT_L(8); PG8_BAR; PG8_WAIT_L(0); PG8_MMA(0, 0, At, B0); PG8_BAR; PG8_SCHED;
      PG8_LDB(B1, 1, 1); PG8_STAGE(PG8_SB(1, 0), b3, voffB);
      PG8_BAR; PG8_WAIT_L(0); PG8_MMA(0, 1, At, B1); PG8_BAR;
      PG8_LDA(At, 1, 1); PG8_STAGE(PG8_SA(1, 0), a3, voffA);
      PG8_BAR; PG8_WAIT_L(0); PG8_MMA(1, 0, At, B0); PG8_BAR; PG8_SCHED;
      PG8_STAGE(PG8_SB(1, 1), b3 + hstep, voffB);
      PG8_WAIT_V(6); PG8_BAR; PG8_MMA(1, 1, At, B1); PG8_BAR;
    }
    E(acc, pm, pn, wr, wc, fr, fq);
    if (!has_next) break;
#pragma unroll
    for (int a = 0; a < 2; ++a)
#pragma unroll
      for (int b = 0; b < 2; ++b)
#pragma unroll
        for (int m = 0; m < 4; ++m)
#pragma unroll
          for (int n = 0; n < 2; ++n) acc[a][b][m][n] = (f32x4){0.f, 0.f, 0.f, 0.f};
    pm = npm; pn = npn; cA = nA; cB = nB; ++ui;
  }
  PG8_WAIT_V(0);
  if (wr == 0) PG8_BAR;
  PG8_BAR;
#undef PG8_SA
#undef PG8_SB
#undef PG8_STAGE
#undef PG8_LDA
#undef PG8_LDB
#undef PG8_MMA
#undef PG8_WAIT_V
#undef PG8_WAIT_L
#undef PG8_BAR
#undef PG8_SCHED
}

struct EpiProj {
  bf16_t* proj; float* lgf; const float* hg_lb;
  __device__ __forceinline__ void operator()(const f32x4 (&acc)[2][2][4][2], int pm, int pn, int wr, int wc, int fr, int fq) const {
    const int sec = pn >> 1;
    if (sec == 1) {
#pragma unroll
      for (int b = 0; b < 2; ++b)
#pragma unroll
        for (int n = 0; n < 2; ++n) {
          const int col = 256 * pn + 128 * b + 32 * wc + 16 * n + 4 * fq;
          const float4 h0 = *(const float4*)(hg_lb + (col - 512)), h1 = *(const float4*)(hg_lb + col);
          float lb[4];
          lb[0] = 1.f / (1.f + __expf(h1.x - h0.x)); lb[1] = 1.f / (1.f + __expf(h1.y - h0.y));
          lb[2] = 1.f / (1.f + __expf(h1.z - h0.z)); lb[3] = 1.f / (1.f + __expf(h1.w - h0.w));
#pragma unroll
          for (int a = 0; a < 2; ++a)
#pragma unroll
            for (int m = 0; m < 4; ++m) {
              const int row = 256 * pm + 128 * a + 64 * wr + 16 * m + fr;
              f32x4 v = acc[a][b][m][n]; f32x4 lf; float kk[4];
#pragma unroll
              for (int r = 0; r < 4; ++r) {
                float l = lb[r];
                float sg = 1.f / (1.f + __expf(-v[r]));
                lf[r] = __logf(l + (1.f - l) * sg);
                kk[r] = (1.f - l) / (1.f + __expf(v[r]));
              }
              *(f32x4*)(lgf + (size_t)row * 512 + (col - 512)) = lf;
              uint2 o; o.x = pack2(kk[0], kk[1]); o.y = pack2(kk[2], kk[3]);
              *(uint2*)(proj + (size_t)row * 2560 + col) = o;
            }
        }
    } else {
#pragma unroll
      for (int a = 0; a < 2; ++a)
#pragma unroll
        for (int m = 0; m < 4; ++m) {
          const int row = 256 * pm + 128 * a + 64 * wr + 16 * m + fr;
#pragma unroll
          for (int b = 0; b < 2; ++b)
#pragma unroll
            for (int n = 0; n < 2; ++n) {
              const int col = 256 * pn + 128 * b + 32 * wc + 16 * n + 4 * fq;
              f32x4 v = acc[a][b][m][n];
              uint2 o; o.x = pack2(v[0], v[1]); o.y = pack2(v[2], v[3]);
              *(uint2*)(proj + (size_t)row * 2560 + col) = o;
            }
        }
    }
  }
};

struct EpiGlu {
  const bf16_t* ybuf; const float* b_glu; bf16_t* mix;
  __device__ __forceinline__ void operator()(const f32x4 (&acc)[2][2][4][2], int pm, int pn, int wr, int wc, int fr, int fq) const {
#pragma unroll
    for (int a = 0; a < 2; ++a)
#pragma unroll
      for (int m = 0; m < 4; ++m) {
        const int row = 256 * pm + 128 * a + 64 * wr + 16 * m + fr;
#pragma unroll
        for (int b = 0; b < 2; ++b)
#pragma unroll
          for (int n = 0; n < 2; ++n) {
            const int col = 256 * pn + 128 * b + 32 * wc + 16 * n + 4 * fq;
            f32x4 v = acc[a][b][m][n];
            float4 bg = *(const float4*)(b_glu + col);
            uint2 yw = *(const uint2*)(ybuf + (size_t)row * 512 + col);
            float o0 = lo2f(yw.x) * sigm(v[0] + bg.x), o1 = hi2f(yw.x) * sigm(v[1] + bg.y);
            float o2 = lo2f(yw.y) * sigm(v[2] + bg.z), o3 = hi2f(yw.y) * sigm(v[3] + bg.w);
            uint2 o; o.x = pack2(o0, o1); o.y = pack2(o2, o3);
            *(uint2*)(mix + (size_t)row * 1024 + 512 + col) = o;
          }
      }
  }
};

struct EpiOut {
  const float* x; float* hout; bf16_t* hb; float* rsq;
  __device__ __forceinline__ void operator()(const f32x4 (&acc)[2][2][4][2], int pm, int pn, int wr, int wc, int fr, int fq) const {
#pragma unroll
    for (int a = 0; a < 2; ++a)
#pragma unroll
      for (int m = 0; m < 4; ++m) {
        const int row = 256 * pm + 128 * a + 64 * wr + 16 * m + fr;
        float ss = 0.f;
#pragma unroll
        for (int b = 0; b < 2; ++b)
#pragma unroll
          for (int n = 0; n < 2; ++n) {
            const int col = 256 * pn + 128 * b + 32 * wc + 16 * n + 4 * fq;
            f32x4 v = acc[a][b][m][n];
            float4 xv = *(const float4*)(x + (size_t)row * 1024 + col);
            float4 hv = make_float4(xv.x + v[0], xv.y + v[1], xv.z + v[2], xv.w + v[3]);
            *(float4*)(hout + (size_t)row * 1024 + col) = hv;
            uint2 o; o.x = pack2(hv.x, hv.y); o.y = pack2(hv.z, hv.w);
            *(uint2*)(hb + (size_t)row * 1024 + col) = o;
            ss += hv.x * hv.x + hv.y * hv.y + hv.z * hv.z + hv.w * hv.w;
          }
        ss += __shfl_xor(ss, 16); ss += __shfl_xor(ss, 32);
        if (fq == 0) rsq[(size_t)row * 16 + pn * 4 + wc] = ss;
      }
  }
};

struct EpiUp {
  bf16_t* hid; const float* rsq; int row_off;
  __device__ __forceinline__ void operator()(const f32x4 (&acc)[2][2][4][2], int pm, int pn, int wr, int wc, int fr, int fq) const {
#pragma unroll
    for (int a = 0; a < 2; ++a)
#pragma unroll
      for (int m = 0; m < 4; ++m) {
        const int row = 256 * pm + 128 * a + 64 * wr + 16 * m + fr;
        const float4* rp = (const float4*)(rsq + (size_t)(row + row_off) * 16);
        float4 r0 = rp[0], r1 = rp[1], r2 = rp[2], r3 = rp[3];
        float ss = (r0.x + r0.y + r0.z + r0.w) + (r1.x + r1.y + r1.z + r1.w) + (r2.x + r2.y + r2.z + r2.w) + (r3.x + r3.y + r3.z + r3.w);
        float rstd = rsqrtf(ss * (1.f / 1024.f) + 1e-6f);
#pragma unroll
        for (int b = 0; b < 2; ++b)
#pragma unroll
          for (int n = 0; n < 2; ++n) {
            const int col = 256 * pn + 128 * b + 32 * wc + 16 * n + 4 * fq;
            f32x4 v = acc[a][b][m][n];
            uint2 o; o.x = pack2(v[0] * rstd, v[1] * rstd); o.y = pack2(v[2] * rstd, v[3] * rstd);
            *(uint2*)(hid + (size_t)row * 5632 + col) = o;
          }
      }
  }
};

struct EpiDown {
  float* out; float* rsq;
  __device__ __forceinline__ void operator()(const f32x4 (&acc)[2][2][4][2], int pm, int pn, int wr, int wc, int fr, int fq) const {
#pragma unroll
    for (int a = 0; a < 2; ++a)
#pragma unroll
      for (int m = 0; m < 4; ++m) {
        const int row = 256 * pm + 128 * a + 64 * wr + 16 * m + fr;
        float ss = 0.f;
#pragma unroll
        for (int b = 0; b < 2; ++b)
#pragma unroll
          for (int n = 0; n < 2; ++n) {
            const int col = 256 * pn + 128 * b + 32 * wc + 16 * n + 4 * fq;
            f32x4 v = acc[a][b][m][n];
            float4 xv = *(const float4*)(out + (size_t)row * 1024 + col);
            float4 hv = make_float4(xv.x + v[0], xv.y + v[1], xv.z + v[2], xv.w + v[3]);
            *(float4*)(out + (size_t)row * 1024 + col) = hv;
            ss += hv.x * hv.x + hv.y * hv.y + hv.z * hv.z + hv.w * hv.w;
          }
        ss += __shfl_xor(ss, 16); ss += __shfl_xor(ss, 32);
        if (fq == 0) rsq[(size_t)row * 16 + pn * 4 + wc] = ss;
      }
  }
};

__device__ void hg_a_item(const Params& p, int item, char* smem) {
  bf16_t* kT = (bf16_t*)smem;
  bf16_t* vT = kT + 128 * 72;
  float* tot = (float*)(vT + 128 * 72);
  const int tid = threadIdx.x, lane = tid & 63, wid = tid >> 6, fr = lane & 15, fq = lane >> 4;
  const int b = item >> 8, h = (item >> 6) & 3, n = item & 63;
  const int t0 = b * 4096 + n * 64;
  const int k = tid & 127, seg = tid >> 7;
  float bc[16];
  {
    const float* lp = p.logf + (size_t)(t0 + seg * 16) * 512 + h * 128 + k;
    float a = 0.f;
#pragma unroll
    for (int i = 0; i < 16; ++i) { a += lp[(size_t)i * 512]; bc[i] = a; }
    tot[seg * 128 + k] = a;
  }
  __syncthreads();
  float pre = 0.f, all = 0.f;
#pragma unroll
  for (int s4 = 0; s4 < 4; ++s4) { float tv = tot[s4 * 128 + k]; if (s4 < seg) pre += tv; all += tv; }
  const bf16_t* kp = p.proj + (size_t)(t0 + seg * 16) * 2560 + 512 + h * 128 + k;
  const bf16_t* vp = kp + 512;
  unsigned kw[8], vw[8];
#pragma unroll
  for (int i = 0; i < 8; ++i) {
    float k0 = bf2f(kp[(size_t)(2 * i) * 2560]) * __expf(all - (bc[2 * i] + pre));
    float k1 = bf2f(kp[(size_t)(2 * i + 1) * 2560]) * __expf(all - (bc[2 * i + 1] + pre));
    kw[i] = pack2(k0, k1);
    vw[i] = (unsigned)vp[(size_t)(2 * i) * 2560] | ((unsigned)vp[(size_t)(2 * i + 1) * 2560] << 16);
  }
  *(uint4*)(kT + k * 72 + seg * 16) = make_uint4(kw[0], kw[1], kw[2], kw[3]);
  *(uint4*)(kT + k * 72 + seg * 16 + 8) = make_uint4(kw[4], kw[5], kw[6], kw[7]);
  *(uint4*)(vT + k * 72 + seg * 16) = make_uint4(vw[0], vw[1], vw[2], vw[3]);
  *(uint4*)(vT + k * 72 + seg * 16 + 8) = make_uint4(vw[4], vw[5], vw[6], vw[7]);
  if (seg == 0) p.decay[(size_t)item * 128 + k] = __expf(all);
  __syncthreads();
  bf16x8 af[2];
#pragma unroll
  for (int ks = 0; ks < 2; ++ks) af[ks] = *(const bf16x8*)(kT + (16 * wid + fr) * 72 + 32 * ks + 8 * fq);
#pragma unroll
  for (int j = 0; j < 8; ++j) {
    f32x4 acc = (f32x4){0.f, 0.f, 0.f, 0.f};
#pragma unroll
    for (int ks = 0; ks < 2; ++ks) {
      bf16x8 bfr = *(const bf16x8*)(vT + (16 * j + fr) * 72 + 32 * ks + 8 * fq);
      acc = __builtin_amdgcn_mfma_f32_16x16x32_bf16(af[ks], bfr, acc, 0, 0, 0);
    }
    *(f32x4*)(p.dstate + (size_t)item * 16384 + (16 * j + fr) * 128 + 16 * wid + 4 * fq) = acc;
  }
  __syncthreads();
}

__device__ void hg_c_item(const Params& p, int item, char* smem) {
  bf16_t* qd = (bf16_t*)smem;
  bf16_t* kd = qd + 64 * 136;
  bf16_t* vT = kd + 64 * 136;
  bf16_t* att = vT + 128 * 72;
  float* tot = (float*)(att + 64 * 72);
  float* ssq = tot + 512;
  const int tid = threadIdx.x, lane = tid & 63, wid = tid >> 6, fr = lane & 15, fq = lane >> 4;
  const int b = item >> 8, h = (item >> 6) & 3, n = item & 63;
  const int t0 = b * 4096 + n * 64;
  const int k = tid & 127, seg = tid >> 7;
  float bc[16];
  {
    const float* lp = p.logf + (size_t)(t0 + seg * 16) * 512 + h * 128 + k;
    float a = 0.f;
#pragma unroll
    for (int i = 0; i < 16; ++i) { a += lp[(size_t)i * 512]; bc[i] = a; }
    tot[seg * 128 + k] = a;
  }
  __syncthreads();
  float pre = 0.f;
#pragma unroll
  for (int s4 = 0; s4 < 4; ++s4) { float tv = tot[s4 * 128 + k]; if (s4 < seg) pre += tv; }
  const bf16_t* qp = p.proj + (size_t)(t0 + seg * 16) * 2560 + h * 128 + k;
  unsigned vw[8];
#pragma unroll
  for (int i = 0; i < 16; ++i) {
    float bb = bc[i] + pre;
    float qv = bf2f(qp[(size_t)i * 2560]) * __expf(bb);
    float kv = bf2f(qp[(size_t)i * 2560 + 512]) * __expf(-bb);
    qd[(seg * 16 + i) * 136 + k] = f2bf(qv);
    kd[(seg * 16 + i) * 136 + k] = f2bf(kv);
    unsigned vv = (unsigned)qp[(size_t)i * 2560 + 1024];
    if (i & 1) vw[i >> 1] |= vv << 16; else vw[i >> 1] = vv;
  }
  *(uint4*)(vT + k * 72 + seg * 16) = make_uint4(vw[0], vw[1], vw[2], vw[3]);
  *(uint4*)(vT + k * 72 + seg * 16 + 8) = make_uint4(vw[4], vw[5], vw[6], vw[7]);
  __syncthreads();
  const int rt = wid & 3, hh = wid >> 2;
#pragma unroll
  for (int st2 = 0; st2 < 2; ++st2) {
    const int st = 2 * hh + st2;
    f32x4 acc = (f32x4){0.f, 0.f, 0.f, 0.f};
#pragma unroll
    for (int ks = 0; ks < 4; ++ks) {
      bf16x8 a = *(const bf16x8*)(kd + (16 * st + fr) * 136 + 32 * ks + 8 * fq);
      bf16x8 bq = *(const bf16x8*)(qd + (16 * rt + fr) * 136 + 32 * ks + 8 * fq);
      acc = __builtin_amdgcn_mfma_f32_16x16x32_bf16(a, bq, acc, 0, 0, 0);
    }
    const int c = 16 * rt + fr, s0 = 16 * st + 4 * fq;
    float v0 = (s0 + 0 <= c) ? acc[0] : 0.f, v1 = (s0 + 1 <= c) ? acc[1] : 0.f, v2 = (s0 + 2 <= c) ? acc[2] : 0.f, v3 = (s0 + 3 <= c) ? acc[3] : 0.f;
    uint2 o; o.x = pack2(v0, v1); o.y = pack2(v2, v3);
    *(uint2*)(att + c * 72 + s0) = o;
  }
  __syncthreads();
  f32x4 o[4];
#pragma unroll
  for (int j = 0; j < 4; ++j) o[j] = (f32x4){0.f, 0.f, 0.f, 0.f};
#pragma unroll
  for (int ks = 0; ks < 2; ++ks) {
    bf16x8 bq = *(const bf16x8*)(att + (16 * rt + fr) * 72 + 32 * ks + 8 * fq);
#pragma unroll
    for (int j = 0; j < 4; ++j) {
      bf16x8 a = *(const bf16x8*)(vT + (16 * (4 * hh + j) + fr) * 72 + 32 * ks + 8 * fq);
      o[j] = __builtin_amdgcn_mfma_f32_16x16x32_bf16(a, bq, o[j], 0, 0, 0);
    }
  }
  const bf16_t* sp = p.sstart + (size_t)item * 16384;
#pragma unroll
  for (int ks = 0; ks < 4; ++ks) {
    bf16x8 bq = *(const bf16x8*)(qd + (16 * rt + fr) * 136 + 32 * ks + 8 * fq);
#pragma unroll
    for (int j = 0; j < 4; ++j) {
      bf16x8 a = *(const bf16x8*)(sp + (16 * (4 * hh + j) + fr) * 128 + 32 * ks + 8 * fq);
      o[j] = __builtin_amdgcn_mfma_f32_16x16x32_bf16(a, bq, o[j], 0, 0, 0);
    }
  }
  float ss = 0.f;
#pragma unroll
  for (int j = 0; j < 4; ++j) ss += o[j][0] * o[j][0] + o[j][1] * o[j][1] + o[j][2] * o[j][2] + o[j][3] * o[j][3];
  ss += __shfl_xor(ss, 16); ss += __shfl_xor(ss, 32);
  if (fq == 0) ssq[hh * 64 + 16 * rt + fr] = ss;
  __syncthreads();
  const float tss = ssq[16 * rt + fr] + ssq[64 + 16 * rt + fr];
  const float rstd = rsqrtf(tss * (1.f / 128.f) + 1e-6f);
  const int token = t0 + 16 * rt + fr;
#pragma unroll
  for (int j = 0; j < 4; ++j) {
    const int col = h * 128 + 16 * (4 * hh + j) + 4 * fq;
    uint2 gw = *(const uint2*)(p.proj + (size_t)token * 2560 + 1536 + col);
    float4 g4 = *(const float4*)(p.hg_norm_g + col);
    float z0 = lo2f(gw.x), z1 = hi2f(gw.x), z2 = lo2f(gw.y), z3 = hi2f(gw.y);
    float r0 = o[j][0] * rstd * g4.x * z0 * sigm(z0), r1 = o[j][1] * rstd * g4.y * z1 * sigm(z1);
    float r2 = o[j][2] * rstd * g4.z * z2 * sigm(z2), r3 = o[j][3] * rstd * g4.w * z3 * sigm(z3);
    uint2 ow; ow.x = pack2(r0, r1); ow.y = pack2(r2, r3);
    *(uint2*)(p.mix + (size_t)token * 1024 + col) = ow;
  }
  __syncthreads();
}

__device__ void s5_a_wave(const Params& p, int tt, int g, int lane) {
  const int fr = lane & 15, fq = lane >> 4;
  bf16x8 U[8];
#pragma unroll
  for (int ks = 0; ks < 8; ++ks) {
    const int tok = tt * 256 + 16 * fr + 2 * ks + (fq >> 1);
    U[ks] = *(const bf16x8*)(p.proj + (size_t)tok * 2560 + 2048 + g * 16 + 8 * (fq & 1));
  }
#pragma unroll
  for (int rt = 0; rt < 8; ++rt) {
    f32x4 acc = (f32x4){0.f, 0.f, 0.f, 0.f};
#pragma unroll
    for (int ks = 0; ks < 8; ++ks) {
      bf16x8 a = *(const bf16x8*)(p.Ftab + (size_t)(g * 128 + 16 * rt + fr) * 256 + 32 * ks + 8 * fq);
      acc = __builtin_amdgcn_mfma_f32_16x16x32_bf16(a, U[ks], acc, 0, 0, 0);
    }
    *(f32x4*)(p.Xend + ((size_t)(tt * 16 + fr) * 32 + g) * 128 + 16 * rt + 4 * fq) = acc;
  }
}

__device__ void s5_c_wave(const Params& p, int tt, int g, int lane) {
  const int fr = lane & 15, fq = lane >> 4;
  bf16x8 U[8], Kf[16], Xf[4];
#pragma unroll
  for (int ks = 0; ks < 8; ++ks) {
    const int tok = tt * 256 + 16 * fr + 2 * ks + (fq >> 1);
    U[ks] = *(const bf16x8*)(p.proj + (size_t)tok * 2560 + 2048 + g * 16 + 8 * (fq & 1));
  }
#pragma unroll
  for (int d = 0; d < 16; ++d) {
    const int tau = d - (fq >> 1);
    bf16x8 z = (bf16x8){0, 0, 0, 0, 0, 0, 0, 0};
    if (tau >= 0) z = *(const bf16x8*)(p.Ktab + (size_t)((g * 16 + tau) * 16 + fr) * 16 + 8 * (fq & 1));
    Kf[d] = z;
  }
#pragma unroll
  for (int ks = 0; ks < 4; ++ks) Xf[ks] = *(const bf16x8*)(p.Xs + ((size_t)(tt * 16 + fr) * 32 + g) * 128 + 32 * ks + 8 * fq);
  const int c0 = g * 16 + 4 * fq;
  const float4 dsk = *(const float4*)(p.s5_d + c0);
#pragma unroll
  for (int t = 0; t < 16; ++t) {
    f32x4 acc = (f32x4){0.f, 0.f, 0.f, 0.f};
#pragma unroll
    for (int ks = 0; ks <= t / 2; ++ks) acc = __builtin_amdgcn_mfma_f32_16x16x32_bf16(Kf[t - 2 * ks], U[ks], acc, 0, 0, 0);
#pragma unroll
    for (int ks = 0; ks < 4; ++ks) {
      bf16x8 a = *(const bf16x8*)(p.Etab + (size_t)(g * 256 + t * 16 + fr) * 128 + 32 * ks + 8 * fq);
      acc = __builtin_amdgcn_mfma_f32_16x16x32_bf16(a, Xf[ks], acc, 0, 0, 0);
    }
    const int token = tt * 256 + 16 * fr + t;
    uint2 uw = *(const uint2*)(p.proj + (size_t)token * 2560 + 2048 + c0);
    float y0 = acc[0] + dsk.x * lo2f(uw.x), y1 = acc[1] + dsk.y * hi2f(uw.x), y2 = acc[2] + dsk.z * lo2f(uw.y), y3 = acc[3] + dsk.w * hi2f(uw.y);
    uint2 ow; ow.x = pack2(gelu_tanh(y0), gelu_tanh(y1)); ow.y = pack2(gelu_tanh(y2), gelu_tanh(y3));
    *(uint2*)(p.ybuf + (size_t)token * 512 + c0) = ow;
  }
}

#define XB_TMO      128
#define XB_XCNT(j)  (256  + 64 * (j))
#define XB_XSUB(j)  (1280 + 64 * (j))
#define XB_XGEN(j)  (2304 + 64 * (j))
#define XB_TOP      3328
#define XB_TOPGEN   3392
#define XCD_BAR_WORDS 3456
#define XB_SPIN_CAP (1u << 20)
__device__ __forceinline__ unsigned xb_ld(unsigned* p) { return __hip_atomic_load(p, __ATOMIC_RELAXED, __HIP_MEMORY_SCOPE_AGENT); }
__device__ __forceinline__ unsigned xb_add(unsigned* p, unsigned v) { return __hip_atomic_fetch_add(p, v, __ATOMIC_RELAXED, __HIP_MEMORY_SCOPE_AGENT); }
__device__ __forceinline__ unsigned xb_xcc_id() { return (unsigned)__builtin_amdgcn_s_getreg((3 << 11) | 20) & 0xFu; }
#define XB_SPIN(cond, bar) do { unsigned _sp = 0; while (cond) { __builtin_amdgcn_s_sleep(1); \
    if ((++_sp & 255u) == 0u) { if (xb_ld(&(bar)[XB_TMO])) break; if (_sp > XB_SPIN_CAP) { atomicAdd(&(bar)[XB_TMO], 1u); break; } } } } while (0)
struct XcdBarrier { unsigned* bar; unsigned x; volatile LAS unsigned* st; };
__device__ __forceinline__ XcdBarrier xcd_barrier_post(unsigned* bar, volatile LAS unsigned* st) {
  XcdBarrier b; b.bar = bar; b.x = xb_xcc_id(); b.st = st;
  if (threadIdx.x == 0) (void)xb_add(&bar[XB_XCNT(b.x)], 1u);
  return b;
}
__device__ __forceinline__ void xcd_barrier_complete(unsigned* bar, unsigned x, unsigned& nloc, unsigned& nx) {
  const unsigned G = gridDim.x * gridDim.y * gridDim.z;
  unsigned sum, cnt, mine, sp = 0u;
  for (;;) {
    sum = 0u; cnt = 0u; mine = 0u;
#pragma unroll
    for (unsigned j = 0; j < 16; ++j) { const unsigned c = xb_ld(&bar[XB_XCNT(j)]); sum += c; cnt += (c > 0u) ? 1u : 0u; mine = (j == x) ? c : mine; }
    if (sum == G) break;
    __builtin_amdgcn_s_sleep(1);
    if ((++sp & 255u) == 0u) { if (xb_ld(&bar[XB_TMO])) break; if (sp > XB_SPIN_CAP) { atomicAdd(&bar[XB_TMO], 1u); break; } }
  }
  nloc = mine > 0u ? mine : 1u; nx = cnt > 0u ? cnt : 1u;
}
__device__ __forceinline__ void xcd_barrier(const XcdBarrier& b) {
  asm volatile("s_waitcnt vmcnt(0)" ::: "memory");
  __syncthreads();
  if (threadIdx.x == 0) {
    unsigned* bar = b.bar;
    __builtin_amdgcn_s_waitcnt(0);
    unsigned nloc = b.st[0], nx = b.st[1];
    if (nloc == 0u) { xcd_barrier_complete(bar, b.x, nloc, nx); b.st[0] = nloc; b.st[1] = nx; }
    const unsigned old = xb_add(&bar[XB_XSUB(b.x)], 1u);
    const unsigned gen = old / nloc;
    if (old + 1u == (gen + 1u) * nloc) {
      __builtin_amdgcn_fence(__ATOMIC_RELEASE, "agent");
      asm volatile("s_waitcnt vmcnt(0)" ::: "memory");
      const unsigned og = xb_add(&bar[XB_TOP], 1u);
      const unsigned tg = og / nx;
      if (og + 1u == (tg + 1u) * nx) xb_add(&bar[XB_TOPGEN], 1u);
      else XB_SPIN(xb_ld(&bar[XB_TOPGEN]) == tg, bar);
      __builtin_amdgcn_fence(__ATOMIC_ACQUIRE, "agent");
      xb_add(&bar[XB_XGEN(b.x)], 1u);
      asm volatile("s_waitcnt vmcnt(0)" ::: "memory");
    } else {
      XB_SPIN(xb_ld(&bar[XB_XGEN(b.x)]) == gen, bar);
      __builtin_amdgcn_fence(__ATOMIC_ACQUIRE, "agent");
      asm volatile("s_waitcnt vmcnt(0)" ::: "memory");
    }
  }
  __syncthreads();
}

__device__ void phase_mix_a(const Params& p, char* smem) {
  for (int it = blockIdx.x; it < 1024 + 256; it += gridDim.x) {
    if (it < 1024) hg_a_item(p, it, smem);
    else { int u = it - 1024; s5_a_wave(p, u >> 2, (u & 3) * 8 + (threadIdx.x >> 6), threadIdx.x & 63); }
  }
}

__device__ void phase_scan(const Params& p) {
  const int tid = threadIdx.x;
  if (tid < 32) {
    for (int it = blockIdx.x * 32 + tid; it < 8192; it += gridDim.x * 32) {
      const int bt = it >> 11, g = (it >> 6) & 31, n = it & 63;
      const float2 a16 = p.Pw[(g * 17 + 16) * 64 + n];
      float xr = 0.f, xi = 0.f;
#pragma unroll 8
      for (int jj = 0; jj < 256; ++jj) {
        const size_t base = ((size_t)(bt * 256 + jj) * 32 + g) * 128;
        p.Xs[base + n] = f2bf(xr); p.Xs[base + 64 + n] = f2bf(xi);
        const float er = p.Xend[base + n], ei = p.Xend[base + 64 + n];
        const float nr = a16.x * xr - a16.y * xi + er, ni = a16.x * xi + a16.y * xr + ei;
        xr = nr; xi = ni;
      }
    }
  }
  const int gtid = blockIdx.x * NTHR + tid, gthr = gridDim.x * NTHR;
  for (int e2 = gtid; e2 < 16 * 8192; e2 += gthr) {
    const int bh = e2 >> 13, e = (e2 & 8191) * 2, k = e & 127;
    float sx = 0.f, sy = 0.f;
#pragma unroll 8
    for (int n = 0; n < 64; ++n) {
      const int item = bh * 64 + n;
      const float2 ds = *(const float2*)(p.dstate + (size_t)item * 16384 + e);
      const float2 dc = *(const float2*)(p.decay + (size_t)item * 128 + k);
      *(unsigned*)(p.sstart + (size_t)item * 16384 + e) = pack2(sx, sy);
      sx = dc.x * sx + ds.x; sy = dc.y * sy + ds.y;
    }
  }
}

__device__ void phase_mix_c(const Params& p, char* smem) {
  for (int it = blockIdx.x; it < 1024 + 256; it += gridDim.x) {
    if (it < 1024) hg_c_item(p, it, smem);
    else { int u = it - 1024; s5_c_wave(p, u >> 2, (u & 3) * 8 + (threadIdx.x >> 6), threadIdx.x & 63); }
  }
}

__device__ void phase_conv(const Params& p, int half) {
  const int gtid = blockIdx.x * NTHR + threadIdx.x, gthr = gridDim.x * NTHR;
  for (int it = gtid; it < 512 * 352; it += gthr) {
    const int tg = it / 352, c = (it % 352) * 8;
    float wg[3][8], wv[3][8], bg[8], bv[8];
#pragma unroll
    for (int j = 0; j < 3; ++j) {
      float4 a0 = *(const float4*)(p.conv_w + j * 5632 + c), a1 = *(const float4*)(p.conv_w + j * 5632 + c + 4);
      float4 b0 = *(const float4*)(p.conv_w + j * 5632 + 2816 + c), b1 = *(const float4*)(p.conv_w + j * 5632 + 2816 + c + 4);
      wg[j][0] = a0.x; wg[j][1] = a0.y; wg[j][2] = a0.z; wg[j][3] = a0.w; wg[j][4] = a1.x; wg[j][5] = a1.y; wg[j][6] = a1.z; wg[j][7] = a1.w;
      wv[j][0] = b0.x; wv[j][1] = b0.y; wv[j][2] = b0.z; wv[j][3] = b0.w; wv[j][4] = b1.x; wv[j][5] = b1.y; wv[j][6] = b1.z; wv[j][7] = b1.w;
    }
    {
      float4 a0 = *(const float4*)(p.conv_b + c), a1 = *(const float4*)(p.conv_b + c + 4);
      float4 b0 = *(const float4*)(p.conv_b + 2816 + c), b1 = *(const float4*)(p.conv_b + 2816 + c + 4);
      bg[0] = a0.x; bg[1] = a0.y; bg[2] = a0.z; bg[3] = a0.w; bg[4] = a1.x; bg[5] = a1.y; bg[6] = a1.z; bg[7] = a1.w;
      bv[0] = b0.x; bv[1] = b0.y; bv[2] = b0.z; bv[3] = b0.w; bv[4] = b1.x; bv[5] = b1.y; bv[6] = b1.z; bv[7] = b1.w;
    }
    const int lr0 = tg * 16;
    const int l0 = lr0 & 4095;
    uint4 g2 = make_uint4(0, 0, 0, 0), g1 = g2, v2 = g2, v1 = g2;
    if (l0 >= 2) {
      g2 = *(const uint4*)(p.hid + (size_t)(lr0 - 2) * 5632 + c); v2 = *(const uint4*)(p.hid + (size_t)(lr0 - 2) * 5632 + 2816 + c);
      g1 = *(const uint4*)(p.hid + (size_t)(lr0 - 1) * 5632 + c); v1 = *(const uint4*)(p.hid + (size_t)(lr0 - 1) * 5632 + 2816 + c);
    }
#pragma unroll 4
    for (int i = 0; i < 16; ++i) {
      const uint4 g0 = *(const uint4*)(p.hid + (size_t)(lr0 + i) * 5632 + c);
      const uint4 v0 = *(const uint4*)(p.hid + (size_t)(lr0 + i) * 5632 + 2816 + c);
      const unsigned G2[4] = {g2.x, g2.y, g2.z, g2.w}, G1[4] = {g1.x, g1.y, g1.z, g1.w}, G0[4] = {g0.x, g0.y, g0.z, g0.w};
      const unsigned V2[4] = {v2.x, v2.y, v2.z, v2.w}, V1[4] = {v1.x, v1.y, v1.z, v1.w}, V0[4] = {v0.x, v0.y, v0.z, v0.w};
      unsigned ow[4];
#pragma unroll
      for (int q = 0; q < 4; ++q) {
        float ga = bg[2 * q] + wg[0][2 * q] * lo2f(G2[q]) + wg[1][2 * q] * lo2f(G1[q]) + wg[2][2 * q] * lo2f(G0[q]);
        float gb = bg[2 * q + 1] + wg[0][2 * q + 1] * hi2f(G2[q]) + wg[1][2 * q + 1] * hi2f(G1[q]) + wg[2][2 * q + 1] * hi2f(G0[q]);
        float va = bv[2 * q] + wv[0][2 * q] * lo2f(V2[q]) + wv[1][2 * q] * lo2f(V1[q]) + wv[2][2 * q] * lo2f(V0[q]);
        float vb = bv[2 * q + 1] + wv[0][2 * q + 1] * hi2f(V2[q]) + wv[1][2 * q + 1] * hi2f(V1[q]) + wv[2][2 * q + 1] * hi2f(V0[q]);
        ow[q] = pack2(ga * sigm(ga) * va, gb * sigm(gb) * vb);
      }
      *(uint4*)(p.act + (size_t)(half * 8192 + lr0 + i) * 2816 + c) = make_uint4(ow[0], ow[1], ow[2], ow[3]);
      g2 = g1; g1 = g0; v2 = v1; v1 = v0;
    }
  }
}

__device__ void phase_final(const Params& p) {
  int tid_ = threadIdx.x; asm volatile("" : "+v"(tid_));
  const int lane = tid_ & 63, wid = tid_ >> 6;
  for (int row = blockIdx.x * 8 + wid; row < T; row += gridDim.x * 8) {
    const float4* rp = (const float4*)(p.rsq2 + (size_t)row * 16);
    float4 r0 = rp[0], r1 = rp[1], r2 = rp[2], r3 = rp[3];
    float ss = (r0.x + r0.y + r0.z + r0.w) + (r1.x + r1.y + r1.z + r1.w) + (r2.x + r2.y + r2.z + r2.w) + (r3.x + r3.y + r3.z + r3.w);
    float rstd = rsqrtf(ss * (1.f / 1024.f) + 1e-6f);
    float4* op = (float4*)(p.out + (size_t)row * 1024);
#pragma unroll
    for (int i = 0; i < 4; ++i) {
      float4 v = op[lane + 64 * i]; float4 g = ((const float4*)p.final_g)[lane + 64 * i];
      v.x *= rstd * g.x; v.y *= rstd * g.y; v.z *= rstd * g.z; v.w *= rstd * g.w;
      op[lane + 64 * i] = v;
    }
  }
}

template <int PH>
__device__ __forceinline__ void run_phase(const Params& p, char* smem) {
  if (PH == 0) phase_prep(p, smem);
  if (PH == 1) { s5_tables(p); EpiProj e{p.proj, p.logf, p.hg_lb}; gemm_phase(p.xn, p.Wt_in, T, 2560, 1024, e, smem); }
  if (PH == 2) phase_mix_a(p, smem);
  if (PH == 3) phase_scan(p);
  if (PH == 4) phase_mix_c(p, smem);
  if (PH == 5) { EpiGlu e{p.ybuf, p.b_glu, p.mix}; gemm_phase(p.ybuf, p.Wt_glu, T, 512, 512, e, smem); }
  if (PH == 6) { EpiOut e{p.x, p.out, p.hb, p.rsq1}; gemm_phase(p.mix, p.Wt_out, T, 1024, 1024, e, smem); }
  if (PH == 7) { EpiUp e{p.hid, p.rsq1, 0}; gemm_phase(p.hb, p.Wt_up, 8192, 5632, 1024, e, smem); }
  if (PH == 8) phase_conv(p, 0);
  if (PH == 9) { EpiUp e{p.hid, p.rsq1, 8192}; gemm_phase(p.hb + (size_t)8192 * 1024, p.Wt_up, 8192, 5632, 1024, e, smem); }
  if (PH == 10) phase_conv(p, 1);
  if (PH == 11) { EpiDown e{p.out, p.rsq2}; gemm_phase(p.act, p.Wt_down, T, 1024, 2816, e, smem); }
  if (PH == 12) phase_final(p);
}

#if MK_FUSED
__global__ void __launch_bounds__(NTHR) fwd_megakernel(Params p) {
  extern __shared__ __attribute__((aligned(16))) char smem[];
  volatile LAS unsigned* st = (volatile LAS unsigned*)((LAS unsigned char*)smem + 131072);
  if (threadIdx.x == 0) { st[0] = 0u; st[1] = 0u; st[2] = 0u; st[3] = 0u; }
  __syncthreads();
  const XcdBarrier xb = xcd_barrier_post(p.bar, st);
  run_phase<0>(p, smem);
  cg::this_grid().sync();
  run_phase<1>(p, smem); xcd_barrier(xb);
  run_phase<2>(p, smem); xcd_barrier(xb);
  run_phase<3>(p, smem); xcd_barrier(xb);
  run_phase<4>(p, smem); xcd_barrier(xb);
  run_phase<5>(p, smem); xcd_barrier(xb);
  run_phase<6>(p, smem); xcd_barrier(xb);
  run_phase<7>(p, smem); xcd_barrier(xb);
  run_phase<8>(p, smem); xcd_barrier(xb);
  run_phase<9>(p, smem); xcd_barrier(xb);
  run_phase<10>(p, smem); xcd_barrier(xb);
  run_phase<11>(p, smem); xcd_barrier(xb);
  run_phase<12>(p, smem);
}
#else
template <int PH>
__global__ void __launch_bounds__(NTHR) phase_kernel(Params p) {
  extern __shared__ __attribute__((aligned(16))) char smem[];
  run_phase<PH>(p, smem);
}
template <int PH>
static void launch_phase(const Params& p, int grid, hipStream_t stream) {
  (void)hipFuncSetAttribute((const void*)phase_kernel<PH>, hipFuncAttributeMaxDynamicSharedMemorySize, LDS_BYTES);
  hipLaunchKernelGGL(phase_kernel<PH>, dim3(grid), dim3(NTHR), LDS_BYTES, stream, p);
}
#endif

extern "C" void kernel_launch(void* const* d_in, const int* in_sizes, int n_in, void* d_out, int out_size, void* d_ws,
                              size_t ws_size, hipStream_t stream) {
  Params p{};
  p.x = (const float*)d_in[0]; p.in_norm_g = (const float*)d_in[1]; p.w_in = (const float*)d_in[2]; p.hg_lb = (const float*)d_in[3];
  p.hg_norm_g = (const float*)d_in[4]; p.a_re = (const float*)d_in[5]; p.a_im = (const float*)d_in[6]; p.log_dt = (const float*)d_in[7];
  p.b_re = (const float*)d_in[8]; p.b_im = (const float*)d_in[9]; p.c_re = (const float*)d_in[10]; p.c_im = (const float*)d_in[11];
  p.s5_d = (const float*)d_in[12]; p.w_glu = (const float*)d_in[13]; p.b_glu = (const float*)d_in[14]; p.w_out = (const float*)d_in[15];
  p.ffn_norm_g = (const float*)d_in[16]; p.w_up = (const float*)d_in[17]; p.conv_w = (const float*)d_in[18]; p.conv_b = (const float*)d_in[19];
  p.w_down = (const float*)d_in[20]; p.final_g = (const float*)d_in[21];
  p.out = (float*)d_out;
  char* ws = (char*)d_ws;
  size_t off = 0;
  auto take = [&](size_t bytes) { char* r = ws + off; off += (bytes + 255) & ~(size_t)255; return r; };
  p.Wt_in = (bf16_t*)take((size_t)2560 * 1024 * 2);
  p.Wt_glu = (bf16_t*)take((size_t)512 * 512 * 2);
  p.Wt_out = (bf16_t*)take((size_t)1024 * 1024 * 2);
  p.Wt_up = (bf16_t*)take((size_t)5632 * 1024 * 2);
  p.Wt_down = (bf16_t*)take((size_t)1024 * 2816 * 2);
  p.Ktab = (bf16_t*)take((size_t)32 * 16 * 256 * 2);
  p.Etab = (bf16_t*)take((size_t)32 * 256 * 128 * 2);
  p.Ftab = (bf16_t*)take((size_t)32 * 128 * 256 * 2);
  p.Pw = (float2*)take((size_t)32 * 17 * 64 * 8);
  p.Bbar = (float2*)take((size_t)32 * 64 * 16 * 8);
  p.rsq1 = (float*)take((size_t)T * 16 * 4);
  p.rsq2 = (float*)take((size_t)T * 16 * 4);
  p.decay = (float*)take((size_t)1024 * 128 * 4);
  p.bar = (unsigned*)take((size_t)XCD_BAR_WORDS * 4);
  const size_t dyn0 = off;
  p.xn = (bf16_t*)take((size_t)T * 1024 * 2);
  p.sstart = p.xn; p.hb = p.xn;
  const size_t r2 = off;
  p.proj = (bf16_t*)take((size_t)T * 2560 * 2);
  p.logf = (float*)take((size_t)T * 512 * 4);
  p.mix = (bf16_t*)take((size_t)T * 1024 * 2);
  p.ybuf = (bf16_t*)take((size_t)T * 512 * 2);
  p.Xend = (float*)take((size_t)1024 * 32 * 128 * 4);
  p.Xs = (bf16_t*)take((size_t)1024 * 32 * 128 * 2);
  const size_t endA = off;
  p.dstate = (float*)d_out;
  off = r2;
  p.act = (bf16_t*)take((size_t)T * 2816 * 2);
  p.hid = (bf16_t*)take((size_t)8192 * 5632 * 2);
  const size_t endB = off;
  (void)dyn0;
  if (endA > ws_size || endB > ws_size) fprintf(stderr, "workspace too small: need %zu / %zu have %zu\n", endA, endB, ws_size);

  static int grid_blocks = 0;
#if MK_FUSED
  if (!grid_blocks) {
    int dev = 0, cus = 0, per_cu = 0;
    (void)hipGetDevice(&dev);
    (void)hipDeviceGetAttribute(&cus, hipDeviceAttributeMultiprocessorCount, dev);
    (void)hipFuncSetAttribute((const void*)fwd_megakernel, hipFuncAttributeMaxDynamicSharedMemorySize, LDS_BYTES);
    (void)hipOccupancyMaxActiveBlocksPerMultiprocessor(&per_cu, fwd_megakernel, NTHR, LDS_BYTES);
    if (per_cu > 1) per_cu = 1;
    grid_blocks = cus * per_cu;
  }
  (void)hipMemsetAsync(p.bar, 0, (size_t)XCD_BAR_WORDS * 4, stream);
  void* args[] = {&p};
  hipError_t e = hipLaunchCooperativeKernel((void*)fwd_megakernel, dim3(grid_blocks), dim3(NTHR), args, LDS_BYTES, stream);
  if (e != hipSuccess) fprintf(stderr, "cooperative launch failed: %s (grid %d)\n", hipGetErrorString(e), grid_blocks);
#else
  if (!grid_blocks) {
    int dev = 0, cus = 0;
    (void)hipGetDevice(&dev);
    (void)hipDeviceGetAttribute(&cus, hipDeviceAttributeMultiprocessorCount, dev);
    grid_blocks = cus;
  }
  launch_phase<0>(p, grid_blocks, stream);
  launch_phase<1>(p, grid_blocks, stream);
  launch_phase<2>(p, grid_blocks, stream);
  launch_phase<3>(p, grid_blocks, stream);
  launch_phase<4>(p, grid_blocks, stream);
  launch_phase<5>(p, grid_blocks, stream);
  launch_phase<6>(p, grid_blocks, stream);
  launch_phase<7>(p, grid_blocks, stream);
  launch_phase<8>(p, grid_blocks, stream);
  launch_phase<9>(p, grid_blocks, stream);
  launch_phase<10>(p, grid_blocks, stream);
  launch_phase<11>(p, grid_blocks, stream);
  launch_phase<12>(p, grid_blocks, stream);
#endif
}
```

```cpp
#include <hip/hip_runtime.h>
#include <hip/hip_cooperative_groups.h>
#include <stdint.h>
#include <cstdio>
namespace cg = cooperative_groups;

#ifndef PROBE_K
#define PROBE_K -1
#endif
#ifndef MK_FUSED
#define MK_FUSED 1
#endif

typedef unsigned short bf16_t;
typedef short bf16x8 __attribute__((ext_vector_type(8)));
typedef float f32x4 __attribute__((ext_vector_type(4)));

constexpr int T = 16384;
constexpr int NTHR = 512;
constexpr int LDS_BYTES = 128 * 1024 + 16 + 6144;

struct Params {
  const float *x, *in_norm_g, *w_in, *hg_lb, *hg_norm_g, *a_re, *a_im, *log_dt, *b_re, *b_im, *c_re, *c_im, *s5_d,
      *w_glu, *b_glu, *w_out, *ffn_norm_g, *w_up, *conv_w, *conv_b, *w_down, *final_g;
  float* out;
  bf16_t *Wt_in, *Wt_glu, *Wt_out, *Wt_up, *Wt_down, *xn, *proj, *sstart, *Xs, *mix, *ybuf, *hb, *hid, *act, *Ktab, *Etab, *Ftab;
  _Float16* logf; bf16_t* dstate;
  float *decay, *Xend, *rsq1, *rsq2;
  float2 *Pw, *Bbar;
  unsigned* bar;
};

__device__ __forceinline__ int otid() { int t = threadIdx.x; asm volatile("" : "+v"(t)); return t; }
typedef float f32x2_t __attribute__((ext_vector_type(2)));
typedef __bf16 bf16x2_t __attribute__((ext_vector_type(2)));
__device__ __forceinline__ unsigned pack2(float a, float b) { f32x2_t v = {a, b}; bf16x2_t h = __builtin_convertvector(v, bf16x2_t); return __builtin_bit_cast(unsigned, h); }
__device__ __forceinline__ bf16_t f2bf(float f) { return (bf16_t)(pack2(f, f) & 0xffffu); }
__device__ __forceinline__ float bf2f(bf16_t h) { return __uint_as_float(((unsigned)h) << 16); }
__device__ __forceinline__ float lo2f(unsigned w) { return __uint_as_float(w << 16); }
__device__ __forceinline__ float hi2f(unsigned w) { return __uint_as_float(w & 0xffff0000u); }
__device__ __forceinline__ float sigm(float x) { return __builtin_amdgcn_rcpf(1.f + __expf(-x)); }
__device__ __forceinline__ float gelu_tanh(float y) {
  float u = 0.7978845608028654f * (y + 0.044715f * y * y * y);
  return y * sigm(2.f * u);
}

__device__ double exp_d(double x) {
  double k = rint(x * 1.4426950408889634);
  double r = fma(-k, 0.6931471805599453, x);
  r = fma(-k, 2.3190468138462996e-17, r);
  double p = 1.0;
#pragma unroll
  for (int i = 16; i >= 1; --i) p = fma(r * p, 1.0 / (double)i, 1.0);
  return ldexp(p, (int)k);
}
__device__ void sincos_d(double x, double& s, double& c) {
  double q = rint(x * 0.6366197723675814);
  double r = fma(-q, 1.5707963267948966, x);
  r = fma(-q, 6.123233995736766e-17, r);
  int iq = ((int)q) & 3;
  double r2 = r * r;
  double sp = 1.0, cp = 1.0;
#pragma unroll
  for (int i = 9; i >= 1; --i) sp = fma(-r2 * sp, 1.0 / (double)((2 * i) * (2 * i + 1)), 1.0);
  sp *= r;
#pragma unroll
  for (int i = 10; i >= 1; --i) cp = fma(-r2 * cp, 1.0 / (double)((2 * i - 1) * (2 * i)), 1.0);
  if (iq == 0) { s = sp; c = cp; }
  else if (iq == 1) { s = cp; c = -sp; }
  else if (iq == 2) { s = -sp; c = -cp; }
  else { s = -cp; c = sp; }
}

__device__ __forceinline__ int up_dst_row(int n) { const int isv = n >= 2816, nn = isv ? n - 2816 : n; return ((nn >> 7) << 8) + isv * 128 + (nn & 127); }

__device__ void transpose_big(const float* __restrict__ src, bf16_t* __restrict__ dst, int K, int N, int tk, int tn,
                              const float* __restrict__ rowscale, bool perm, float* tile) {
  const int tid = otid();
  const int k0 = tk * 64, n0 = tn * 256;
  float4 v[8];
#pragma unroll
  for (int i = 0; i < 8; ++i) { const int r = (tid >> 6) + 8 * i, c4 = (tid & 63) * 4; v[i] = *(const float4*)(src + (size_t)(k0 + r) * N + n0 + c4); }
#pragma unroll
  for (int i = 0; i < 8; ++i) {
    const int r = (tid >> 6) + 8 * i, c4 = (tid & 63) * 4;
    const float sc = rowscale ? rowscale[k0 + r] : 1.f;
    tile[r * 257 + c4 + 0] = v[i].x * sc; tile[r * 257 + c4 + 1] = v[i].y * sc; tile[r * 257 + c4 + 2] = v[i].z * sc; tile[r * 257 + c4 + 3] = v[i].w * sc;
  }
  __syncthreads();
  const int n = tid >> 1, kh = (tid & 1) * 32;
  const int drow = perm ? up_dst_row(n0 + n) : (n0 + n);
#pragma unroll
  for (int q = 0; q < 4; ++q) {
    uint4 o;
    o.x = pack2(tile[(kh + 8 * q + 0) * 257 + n], tile[(kh + 8 * q + 1) * 257 + n]);
    o.y = pack2(tile[(kh + 8 * q + 2) * 257 + n], tile[(kh + 8 * q + 3) * 257 + n]);
    o.z = pack2(tile[(kh + 8 * q + 4) * 257 + n], tile[(kh + 8 * q + 5) * 257 + n]);
    o.w = pack2(tile[(kh + 8 * q + 6) * 257 + n], tile[(kh + 8 * q + 7) * 257 + n]);
    *(uint4*)(dst + (size_t)drow * K + k0 + kh + 8 * q) = o;
  }
  __syncthreads();
}

__device__ void transpose_any(const Params& p, int t, float* tile) {
  if (t < 160) transpose_big(p.w_in, p.Wt_in, 1024, 2560, t / 10, t % 10, nullptr, false, tile);
  else if (t < 176) { int u = t - 160; transpose_big(p.w_glu, p.Wt_glu, 512, 512, u / 2, u % 2, nullptr, false, tile); }
  else if (t < 240) { int u = t - 176; transpose_big(p.w_out, p.Wt_out, 1024, 1024, u / 4, u % 4, nullptr, false, tile); }
  else if (t < 592) { int u = t - 240; transpose_big(p.w_up, p.Wt_up, 1024, 5632, u / 22, u % 22, p.ffn_norm_g, true, tile); }
  else { int u = t - 592; transpose_big(p.w_down, p.Wt_down, 2816, 1024, u / 4, u % 4, nullptr, false, tile); }
}

__device__ void s5_tables_block(const Params& p, int bi, char* smem) {
  float* Cr = (float*)smem; float* Ci = Cr + 1024; float* Br = Ci + 1024; float* Bi = Br + 1024;
  float2* Pj = (float2*)(Bi + 1024);
  float2* PZ = Pj + 64;
  const int tid = otid();
  const int g = bi & 31, jb = bi >> 5;
  for (int i = tid; i < 1024; i += NTHR) { Cr[i] = p.c_re[g * 1024 + i]; Ci[i] = p.c_im[g * 1024 + i]; Br[i] = p.b_re[g * 1024 + i]; Bi[i] = p.b_im[g * 1024 + i]; }
  for (int jj = 0; jj < 3; ++jj) {
    const int j = jb + 8 * jj;
    if (j > 16) break;
    __syncthreads();
    if (tid < 64) {
      const int n = tid;
      const double dt = exp_d((double)p.log_dt[g]);
      const double ar = (double)p.a_re[g * 64 + n], ai = (double)p.a_im[g * 64 + n];
      double sj, cj, s1, c1;
      const double mj = exp_d((double)j * dt * ar); sincos_d((double)j * dt * ai, sj, cj);
      const double m1 = exp_d(dt * ar); sincos_d(dt * ai, s1, c1);
      const double pr = mj * cj, pi = mj * sj;
      const double nr = m1 * c1 - 1.0, ni = m1 * s1, den = ar * ar + ai * ai;
      const double zr = (nr * ar + ni * ai) / den, zi = (ni * ar - nr * ai) / den;
      Pj[n] = make_float2((float)pr, (float)pi);
      PZ[n] = make_float2((float)(pr * zr - pi * zi), (float)(pr * zi + pi * zr));
      if (j == 16) p.Pw[g * 64 + n] = make_float2((float)pr, (float)pi);
    }
    __syncthreads();
    if (j >= 1) {
      const int t = j - 1;
#pragma unroll
      for (int i = 0; i < 4; ++i) {
        const int idx = tid + 512 * i, pp = idx >> 7, np = idx & 127, n = np & 63, part = np >> 6;
        const float2 pw = Pj[n];
        const float cr = Cr[pp * 64 + n], ci = Ci[pp * 64 + n];
        const float v = part ? -(cr * pw.y + ci * pw.x) : (cr * pw.x - ci * pw.y);
        p.Etab[(size_t)(g * 256 + t * 16 + pp) * 128 + np] = f2bf(v);
      }
    }
    if (j <= 15) {
      const int sidx = 15 - j;
#pragma unroll
      for (int i = 0; i < 4; ++i) {
        const int idx = tid + 512 * i, np = idx >> 4, pq = idx & 15, n = np & 63, part = np >> 6;
        const float2 m = PZ[n];
        const float br = Br[n * 16 + pq], bi2 = Bi[n * 16 + pq];
        const float v = part ? (m.x * bi2 + m.y * br) : (m.x * br - m.y * bi2);
        p.Ftab[(size_t)(g * 128 + np) * 256 + sidx * 16 + pq] = f2bf(v);
      }
      if (tid < 256) {
        const int pp = tid >> 4, pq = tid & 15;
        float acc = 0.f;
#pragma unroll 8
        for (int n = 0; n < 64; ++n) {
          const float2 m = PZ[n];
          const float br = Br[n * 16 + pq], bi2 = Bi[n * 16 + pq];
          const float cr = Cr[pp * 64 + n], ci = Ci[pp * 64 + n];
          const float mr = m.x * br - m.y * bi2, mi = m.x * bi2 + m.y * br;
          acc += cr * mr - ci * mi;
        }
        p.Ktab[(size_t)((g * 16 + j) * 16 + pp) * 16 + pq] = f2bf(acc);
      }
    }
  }
  __syncthreads();
}

__device__ void phase_prep(const Params& p, char* smem) {
  float* tile = (float*)smem;
  const int tid = otid(), lane = tid & 63, wid = tid >> 6;
  const int gtid = blockIdx.x * NTHR + tid, gthr = gridDim.x * NTHR;
  for (int idx = gtid; idx < T; idx += gthr) { p.rsq1[idx] = 0.f; p.rsq2[idx] = 0.f; }
  const int ntr = (gridDim.x == 256) ? 160 : 768;
  for (int t = blockIdx.x; t < ntr; t += gridDim.x) transpose_any(p, t, tile);
  for (int t = blockIdx.x; t < 256; t += gridDim.x) s5_tables_block(p, t, smem);
}
__device__ void phase_prep_xn(const Params& p) {
  const int tid = otid(), lane = tid & 63, wid = tid >> 6;
  for (int row0 = (blockIdx.x * 8 + wid) * 8; row0 < T; row0 += gridDim.x * 64) {
    float4 v[8][4]; float ss[8];
#pragma unroll
    for (int r = 0; r < 8; ++r) {
      const float4* xr = (const float4*)(p.x + (size_t)(row0 + r) * 1024);
#pragma unroll
      for (int i = 0; i < 4; ++i) v[r][i] = xr[lane + 64 * i];
    }
#pragma unroll
    for (int r = 0; r < 8; ++r) {
      float a = 0.f;
#pragma unroll
      for (int i = 0; i < 4; ++i) a += v[r][i].x * v[r][i].x + v[r][i].y * v[r][i].y + v[r][i].z * v[r][i].z + v[r][i].w * v[r][i].w;
#pragma unroll
      for (int o = 32; o >= 1; o >>= 1) a += __shfl_xor(a, o);
      ss[r] = rsqrtf(a * (1.f / 1024.f) + 1e-6f);
    }
#pragma unroll
    for (int i = 0; i < 4; ++i) {
      const float4 g = ((const float4*)p.in_norm_g)[lane + 64 * i];
#pragma unroll
      for (int r = 0; r < 8; ++r) {
        uint2 o; o.x = pack2(v[r][i].x * ss[r] * g.x, v[r][i].y * ss[r] * g.y); o.y = pack2(v[r][i].z * ss[r] * g.z, v[r][i].w * ss[r] * g.w);
        *(uint2*)(p.xn + (size_t)(row0 + r) * 1024 + (lane + 64 * i) * 4) = o;
      }
    }
  }
}

struct TileMap {
  int nM, nN, nwg;
  __device__ void init(int M, int N) { nM = M / 256; nN = N / 256; nwg = nM * nN; }
  __device__ void get(int L, int& pm, int& pn) const {
    int wgid = L;
    { const int q = nwg / 8, r = nwg % 8, xcd = wgid % 8, off = wgid / 8; wgid = (xcd < r ? xcd * (q + 1) : r * (q + 1) + (xcd - r) * q) + off; }
    const int nig = 8 * nN, gid = wgid / nig, fm = gid * 8, gsz = (nM - fm) < 8 ? (nM - fm) : 8;
    pm = fm + ((wgid % nig) % gsz); pn = (wgid % nig) / gsz;
  }
};

#define LAS __attribute__((address_space(3)))
constexpr int G_BK = 64, G_HALF = 128, G_HTB = G_HALF * G_BK * 2;
__device__ __forceinline__ int lds_byte(int r, int c) {
  const int st = (r >> 4) * 2 + (c >> 5), rr = r & 15, cc = c & 31, ob = rr * 64 + cc * 2;
  return st * 1024 + (ob ^ (((ob >> 9) & 1) << 5));
}
__device__ __forceinline__ void stage_rc(int b, int& R, int& C) {
  const int st = b / 1024, sb = b % 1024, swz = sb ^ (((sb >> 9) & 1) << 5);
  R = (st >> 1) * 16 + swz / 64; C = (st & 1) * 32 + (swz % 64) / 2;
}

struct RowMapLinear { static constexpr bool PERMA = false; __device__ __forceinline__ long operator()(int pm) const { return (long)pm * 256; } };
struct RowMapConv { static constexpr bool PERMA = true; __device__ __forceinline__ long operator()(int pm) const { return (long)(pm / 17) * 4096 + 254 * (pm % 17) - 2; } };

template <class Epi, class RowMap = RowMapLinear>
__device__ __forceinline__ void gemm_phase(const bf16_t* __restrict__ A, const bf16_t* __restrict__ Bt, int M, int N, int K,
                                           const Epi& E, char* smem, const RowMap rmap = RowMap()) {
  LAS unsigned char* lds = (LAS unsigned char*)smem;
  const int tid = otid(), wid = __builtin_amdgcn_readfirstlane(tid >> 6), lane = tid & 63, wr = wid >> 2, wc = wid & 3, fr = lane & 15, fq = lane >> 4;
  const int nt = K / G_BK;
  TileMap tm; tm.init(M, N);
  if ((int)blockIdx.x >= tm.nwg) return;
  unsigned voffA[2], voffB[2];
#pragma unroll
  for (int i = 0; i < 2; ++i) {
    int R, C; stage_rc(tid * 16 + i * 8192, R, C);
    voffB[i] = (unsigned)(R * K + C) * 2u;
    const int Ra = RowMap::PERMA ? ((R & ~63) + 4 * (R & 15) + ((R >> 4) & 3)) : R;
    voffA[i] = (unsigned)(Ra * K + C) * 2u;
  }
  const size_t kstep = (size_t)(G_BK * 2);
  const size_t hstep = (size_t)G_HALF * K * 2;
  const size_t tstep = 2 * hstep;
  const unsigned ldsw = (unsigned)wid * 1024u;
  const int aoff = lds_byte(wr * 64 + fr, fq * 8), boff = lds_byte(wc * 32 + fr, fq * 8);
#define PG8_SA(b, h) (((b) * 2 + (h)) * G_HTB)
#define PG8_SB(b, h) ((4 + (b) * 2 + (h)) * G_HTB)
#define PG8_STAGE(bufoff, gbase, voff) do { _Pragma("unroll") for (int _i = 0; _i < 2; ++_i) \
    __builtin_amdgcn_global_load_lds((const unsigned*)((const char*)(gbase) + (voff)[_i]), (LAS unsigned*)(lds + (bufoff) + ldsw + _i * 8192), 16, 0, 0); } while (0)
#define PG8_LDA(dst, b, h) do { _Pragma("unroll") for (int m = 0; m < 4; ++m) _Pragma("unroll") for (int k = 0; k < 2; ++k) dst[m][k] = *(const LAS bf16x8*)(lds + PG8_SA(b, h) + aoff + m * 2048 + k * 1024); } while (0)
#define PG8_LDB(dst, b, h) do { _Pragma("unroll") for (int n = 0; n < 2; ++n) _Pragma("unroll") for (int k = 0; k < 2; ++k) dst[n][k] = *(const LAS bf16x8*)(lds + PG8_SB(b, h) + boff + n * 2048 + k * 1024); } while (0)
#define PG8_MMA(ai, bj, At_, Bt_) do { __builtin_amdgcn_s_setprio(1); _Pragma("unroll") for (int m = 0; m < 4; ++m) _Pragma("unroll") for (int n = 0; n < 2; ++n) _Pragma("unroll") for (int k = 0; k < 2; ++k) \
    acc[ai][bj][m][n] = __builtin_amdgcn_mfma_f32_16x16x32_bf16(Bt_[n][k], At_[m][k], acc[ai][bj][m][n], 0, 0, 0); __builtin_amdgcn_s_setprio(0); } while (0)
#define PG8_WAIT_V(n) asm volatile("s_waitcnt vmcnt(" #n ")" ::: "memory")
#define PG8_WAIT_L(n) asm volatile("s_waitcnt lgkmcnt(" #n ")" ::: "memory")
#define PG8_BAR __builtin_amdgcn_s_barrier()
#define PG8_SCHED __builtin_amdgcn_sched_barrier(0)
  int pm, pn, npm = 0, npn = 0, ui = 0;
  tm.get((int)blockIdx.x, pm, pn);
  f32x4 acc[2][2][4][2];
#pragma unroll
  for (int a = 0; a < 2; ++a)
#pragma unroll
    for (int b = 0; b < 2; ++b)
#pragma unroll
      for (int m = 0; m < 4; ++m)
#pragma unroll
        for (int n = 0; n < 2; ++n) acc[a][b][m][n] = (f32x4){0.f, 0.f, 0.f, 0.f};
  bf16x8 At[4][2], B0[2][2], B1[2][2];
  const size_t rstep = (size_t)K * 2;
  const char* cA = (const char*)A + rmap(pm) * (long)rstep; const char* cB = (const char*)Bt + (size_t)pn * tstep;
  PG8_WAIT_V(0); __syncthreads();
  PG8_STAGE(PG8_SB(0, 0), cB, voffB); PG8_STAGE(PG8_SA(0, 0), cA, voffA); PG8_STAGE(PG8_SB(0, 1), cB + hstep, voffB); PG8_STAGE(PG8_SA(0, 1), cA + hstep, voffA);
  if (wr == 1) PG8_BAR;
  PG8_WAIT_V(4); PG8_BAR;
  PG8_STAGE(PG8_SB(1, 0), cB + kstep, voffB); PG8_STAGE(PG8_SA(1, 0), cA + kstep, voffA); PG8_STAGE(PG8_SB(1, 1), cB + hstep + kstep, voffB);
  PG8_WAIT_V(6); PG8_BAR;
  for (;;) {
    const int Ln = (ui + 1) * (int)gridDim.x + (int)blockIdx.x;
    const bool has_next = Ln < tm.nwg;
    if (has_next) tm.get(Ln, npm, npn);
    const char* nA = has_next ? (const char*)A + rmap(npm) * (long)rstep : cA; const char* nB = has_next ? (const char*)Bt + (size_t)npn * tstep : cB;
    for (int t = 0; t < nt; t += 2) {
      const bool last = (t == nt - 2);
      const char* a1 = cA + (size_t)(t + 1) * kstep;
      const char* a2 = last ? nA : cA + (size_t)(t + 2) * kstep; const char* b2 = last ? nB : cB + (size_t)(t + 2) * kstep;
      const char* a3 = a2 + kstep; const char* b3 = b2 + kstep;
      PG8_LDB(B0, 0, 0); PG8_SCHED; PG8_LDA(At, 0, 0); PG8_STAGE(PG8_SA(1, 1), a1 + hstep, voffA);
      PG8_WAIT_L(8); PG8_BAR; PG8_WAIT_L(0); PG8_MMA(0, 0, At, B0); PG8_BAR; PG8_SCHED;
      PG8_LDB(B1, 0, 1); PG8_STAGE(PG8_SB(0, 0), b2, voffB);
      PG8_BAR; PG8_WAIT_L(0); PG8_MMA(0, 1, At, B1); PG8_BAR;
      PG8_LDA(At, 0, 1); PG8_STAGE(PG8_SA(0, 0), a2, voffA);
      PG8_BAR; PG8_WAIT_L(0); PG8_MMA(1, 0, At, B0); PG8_BAR; PG8_SCHED;
      PG8_STAGE(PG8_SB(0, 1), b2 + hstep, voffB);
      PG8_WAIT_V(6); PG8_BAR; PG8_MMA(1, 1, At, B1); PG8_BAR;
      PG8_LDB(B0, 1, 0); PG8_SCHED; PG8_LDA(At, 1, 0); PG8_STAGE(PG8_SA(0, 1), a2 + hstep, voffA);
      PG8_WAIT_L(8); PG8_BAR; PG8_WAIT_L(0); PG8_MMA(0, 0, At, B0); PG8_BAR; PG8_SCHED;
      PG8_LDB(B1, 1, 1); PG8_STAGE(PG8_SB(1, 0), b3, voffB);
      PG8_BAR; PG8_WAIT_L(0); PG8_MMA(0, 1, At, B1); PG8_BAR;
      PG8_LDA(At, 1, 1); PG8_STAGE(PG8_SA(1, 0), a3, voffA);
      PG8_BAR; PG8_WAIT_L(0); PG8_MMA(1, 0, At, B0); PG8_BAR; PG8_SCHED;
      PG8_STAGE(PG8_SB(1, 1), b3 + hstep, voffB);
      PG8_WAIT_V(6); PG8_BAR; PG8_MMA(1, 1, At, B1); PG8_BAR;
    }
    E(acc, pm, pn, wr, wc, fr, fq);
    if (!has_next) break;
#pragma unroll
    for (int a = 0; a < 2; ++a)
#pragma unroll
      for (int b = 0; b < 2; ++b)
#pragma unroll
        for (int m = 0; m < 4; ++m)
#pragma unroll
          for (int n = 0; n < 2; ++n) acc[a][b][m][n] = (f32x4){0.f, 0.f, 0.f, 0.f};
    pm = npm; pn = npn; cA = nA; cB = nB; ++ui;
  }
  PG8_WAIT_V(0);
  if (wr == 0) PG8_BAR;
  PG8_BAR;
#undef PG8_SA
#undef PG8_SB
#undef PG8_STAGE
#undef PG8_LDA
#undef PG8_LDB
#undef PG8_MMA
#undef PG8_WAIT_V
#undef PG8_WAIT_L
#undef PG8_BAR
#undef PG8_SCHED
}

#define PROBE_STAMP_ONCE(k, base) do { if (PROBE_K == (k) && threadIdx.x == 0) { volatile LAS unsigned long long* _s = (volatile LAS unsigned long long*)((LAS unsigned char*)(base) - 8); \
    if (*_s == 0ull) *_s = __builtin_amdgcn_s_memrealtime(); } } while (0)
struct EpiProj {
  bf16_t* proj; _Float16* lgf; const float* hg_lb;
  __device__ __forceinline__ void operator()(const f32x4 (&acc)[2][2][4][2], int pm, int pn, int wr, int wc, int fr, int fq) const {
    const int sec = pn >> 1;
    if (sec == 1) {
#pragma unroll
      for (int b = 0; b < 2; ++b)
#pragma unroll
        for (int n = 0; n < 2; ++n) {
          const int col = 256 * pn + 128 * b + 32 * wc + 16 * n + 4 * fq;
          const float4 h0 = *(const float4*)(hg_lb + (col - 512)), h1 = *(const float4*)(hg_lb + col);
          float lb[4];
          lb[0] = __builtin_amdgcn_rcpf(1.f + __expf(h1.x - h0.x)); lb[1] = __builtin_amdgcn_rcpf(1.f + __expf(h1.y - h0.y));
          lb[2] = __builtin_amdgcn_rcpf(1.f + __expf(h1.z - h0.z)); lb[3] = __builtin_amdgcn_rcpf(1.f + __expf(h1.w - h0.w));
#pragma unroll
          for (int a = 0; a < 2; ++a)
#pragma unroll
            for (int m = 0; m < 4; ++m) {
              const int row = 256 * pm + 128 * a + 64 * wr + 16 * m + fr;
              f32x4 v = acc[a][b][m][n]; f32x4 lf; float kk[4];
#pragma unroll
              for (int r = 0; r < 4; ++r) {
                float l = lb[r];
                float sg = __builtin_amdgcn_rcpf(1.f + __expf(-v[r]));
                lf[r] = __logf(l + (1.f - l) * sg);
                kk[r] = (1.f - l) * __builtin_amdgcn_rcpf(1.f + __expf(v[r]));
              }
              typedef _Float16 f16x4 __attribute__((ext_vector_type(4)));
              f16x4 lh; lh[0] = (_Float16)lf[0]; lh[1] = (_Float16)lf[1]; lh[2] = (_Float16)lf[2]; lh[3] = (_Float16)lf[3];
              *(f16x4*)(lgf + (size_t)row * 512 + (col - 512)) = lh;
              uint2 o; o.x = pack2(kk[0], kk[1]); o.y = pack2(kk[2], kk[3]);
              *(uint2*)(proj + (size_t)row * 2560 + col) = o;
            }
        }
    } else {
#pragma unroll
      for (int a = 0; a < 2; ++a)
#pragma unroll
        for (int m = 0; m < 4; ++m) {
          const int row = 256 * pm + 128 * a + 64 * wr + 16 * m + fr;
#pragma unroll
          for (int b = 0; b < 2; ++b)
#pragma unroll
            for (int n = 0; n < 2; ++n) {
              const int col = 256 * pn + 128 * b + 32 * wc + 16 * n + 4 * fq;
              f32x4 v = acc[a][b][m][n];
              uint2 o; o.x = pack2(v[0], v[1]); o.y = pack2(v[2], v[3]);
              *(uint2*)(proj + (size_t)row * 2560 + col) = o;
            }
        }
    }
  }
};

struct EpiGlu {
  const bf16_t* ybuf; const float* b_glu; bf16_t* mix;
  __device__ __forceinline__ void operator()(const f32x4 (&acc)[2][2][4][2], int pm, int pn, int wr, int wc, int fr, int fq) const {
#pragma unroll
    for (int a = 0; a < 2; ++a)
#pragma unroll
      for (int m = 0; m < 4; ++m) {
        const int row = 256 * pm + 128 * a + 64 * wr + 16 * m + fr;
#pragma unroll
        for (int b = 0; b < 2; ++b)
#pragma unroll
          for (int n = 0; n < 2; ++n) {
            const int col = 256 * pn + 128 * b + 32 * wc + 16 * n + 4 * fq;
            f32x4 v = acc[a][b][m][n];
            float4 bg = *(const float4*)(b_glu + col);
            uint2 yw = *(const uint2*)(ybuf + (size_t)row * 512 + col);
            float o0 = lo2f(yw.x) * sigm(v[0] + bg.x), o1 = hi2f(yw.x) * sigm(v[1] + bg.y);
            float o2 = lo2f(yw.y) * sigm(v[2] + bg.z), o3 = hi2f(yw.y) * sigm(v[3] + bg.w);
            uint2 o; o.x = pack2(o0, o1); o.y = pack2(o2, o3);
            *(uint2*)(mix + (size_t)row * 1024 + 512 + col) = o;
          }
      }
  }
};

typedef unsigned u32x2 __attribute__((ext_vector_type(2)));
__device__ __forceinline__ void st_nt8(void* p, unsigned a, unsigned b) { u32x2 v; v.x = a; v.y = b; __builtin_nontemporal_store(v, (u32x2*)p); }
__device__ __forceinline__ void st_nt16(void* p, f32x4 v) { __builtin_nontemporal_store(v, (f32x4*)p); }

struct EpiOut {
  const float* x; bf16_t* hb; float* rsq;
  __device__ __forceinline__ void operator()(const f32x4 (&acc)[2][2][4][2], int pm, int pn, int wr, int wc, int fr, int fq) const {
#pragma unroll
    for (int a = 0; a < 2; ++a)
#pragma unroll
      for (int m = 0; m < 4; ++m) {
        const int row = 256 * pm + 128 * a + 64 * wr + 16 * m + fr;
        float ss = 0.f;
#pragma unroll
        for (int b = 0; b < 2; ++b)
#pragma unroll
          for (int n = 0; n < 2; ++n) {
            const int col = 256 * pn + 128 * b + 32 * wc + 16 * n + 4 * fq;
            f32x4 v = acc[a][b][m][n];
            float4 xv = *(const float4*)(x + (size_t)row * 1024 + col);
            float4 hv = make_float4(xv.x + v[0], xv.y + v[1], xv.z + v[2], xv.w + v[3]);
            *(uint2*)(hb + (size_t)row * 1024 + col) = make_uint2(pack2(hv.x, hv.y), pack2(hv.z, hv.w));
            ss += hv.x * hv.x + hv.y * hv.y + hv.z * hv.z + hv.w * hv.w;
          }
        ss += __shfl_xor(ss, 16); ss += __shfl_xor(ss, 32);
        if (fq == 0) unsafeAtomicAdd(rsq + row, ss);
      }
  }
};

template <int CTRL> __device__ __forceinline__ float dpp_upd(float old, float src) {
  return __int_as_float(__builtin_amdgcn_update_dpp(__float_as_int(old), __float_as_int(src), CTRL, 0xf, 0xf, false));
}
struct EpiUpConv {
  bf16_t* act; const float* rsq; const float* conv_w; const float* conv_b; LAS float* xb;
  __device__ __forceinline__ void operator()(f32x4 (&acc)[2][2][4][2], int pm, int pn, int wr, int wc, int fr, int fq) const {
    PROBE_STAMP_ONCE(31, xb);
    const int seq = pm / 17, it = pm - seq * 17, l0 = 254 * it - 2;
#pragma unroll
    for (int a = 0; a < 2; ++a)
#pragma unroll
      for (int m = 0; m < 4; ++m) {
        const int l = l0 + 128 * a + 64 * wr + 4 * fr + m;
        int tok = seq * 4096 + l; tok = tok < 0 ? 0 : (tok > T - 1 ? T - 1 : tok);
        float rstd = rsqrtf(rsq[tok] * (1.f / 1024.f) + 1e-6f);
#pragma unroll
        for (int b = 0; b < 2; ++b)
#pragma unroll
          for (int n = 0; n < 2; ++n) {
            f32x4 v = acc[a][b][m][n] * rstd;
            if (a == 0 && m < 2 && l < 0) v = (f32x4){0.f, 0.f, 0.f, 0.f};
            acc[a][b][m][n] = v;
          }
      }
    if (fr == 15) {
#pragma unroll
      for (int a = 0; a < 2; ++a) {
        const int bd = 2 * a + wr;
        if (bd < 3) {
#pragma unroll
          for (int q = 0; q < 2; ++q)
#pragma unroll
            for (int b = 0; b < 2; ++b)
#pragma unroll
              for (int n = 0; n < 2; ++n) *(LAS f32x4*)(xb + ((bd * 2 + q) * 2 + b) * 128 + 32 * wc + 16 * n + 4 * fq) = acc[a][b][2 + q][n];
        }
      }
    }
    asm volatile("s_waitcnt lgkmcnt(0)" ::: "memory");
    __builtin_amdgcn_s_barrier(); asm volatile("" ::: "memory");
    __builtin_amdgcn_s_barrier(); asm volatile("" ::: "memory");
#pragma unroll
    for (int n = 0; n < 2; ++n) {
      const int c = pn * 128 + 32 * wc + 16 * n + 4 * fq;
      const f32x4 wg0 = *(const f32x4*)(conv_w + c), wg1 = *(const f32x4*)(conv_w + 5632 + c), wg2 = *(const f32x4*)(conv_w + 2 * 5632 + c);
      const f32x4 wv0 = *(const f32x4*)(conv_w + 2816 + c), wv1 = *(const f32x4*)(conv_w + 5632 + 2816 + c), wv2 = *(const f32x4*)(conv_w + 2 * 5632 + 2816 + c);
      const f32x4 bg = *(const f32x4*)(conv_b + c), bv = *(const f32x4*)(conv_b + 2816 + c);
#pragma unroll
      for (int a = 0; a < 2; ++a) {
        const int bdp = 2 * a + wr - 1;
        f32x4 g2b = (f32x4){0.f, 0.f, 0.f, 0.f}, g1b = g2b, v2b = g2b, v1b = g2b;
        if (bdp >= 0 && fr == 0) {
          g2b = *(const LAS f32x4*)(xb + ((bdp * 2 + 0) * 2 + 0) * 128 + 32 * wc + 16 * n + 4 * fq);
          v2b = *(const LAS f32x4*)(xb + ((bdp * 2 + 0) * 2 + 1) * 128 + 32 * wc + 16 * n + 4 * fq);
          g1b = *(const LAS f32x4*)(xb + ((bdp * 2 + 1) * 2 + 0) * 128 + 32 * wc + 16 * n + 4 * fq);
          v1b = *(const LAS f32x4*)(xb + ((bdp * 2 + 1) * 2 + 1) * 128 + 32 * wc + 16 * n + 4 * fq);
        }
        f32x4 pg3, pg2, pv3, pv2;
#pragma unroll
        for (int r = 0; r < 4; ++r) {
          pg3[r] = dpp_upd<0x111>(g1b[r], acc[a][0][3][n][r]); pg2[r] = dpp_upd<0x111>(g2b[r], acc[a][0][2][n][r]);
          pv3[r] = dpp_upd<0x111>(v1b[r], acc[a][1][3][n][r]); pv2[r] = dpp_upd<0x111>(v2b[r], acc[a][1][2][n][r]);
        }
#pragma unroll
        for (int m = 0; m < 4; ++m) {
          const f32x4 cg = acc[a][0][m][n], cv = acc[a][1][m][n];
          const f32x4 s1g = m == 0 ? pg3 : acc[a][0][m == 0 ? 0 : m - 1][n], s2g = m == 0 ? pg2 : (m == 1 ? pg3 : acc[a][0][m < 2 ? 0 : m - 2][n]);
          const f32x4 s1v = m == 0 ? pv3 : acc[a][1][m == 0 ? 0 : m - 1][n], s2v = m == 0 ? pv2 : (m == 1 ? pv3 : acc[a][1][m < 2 ? 0 : m - 2][n]);
          const f32x4 G = bg + wg0 * s2g + wg1 * s1g + wg2 * cg;
          const f32x4 V = bv + wv0 * s2v + wv1 * s1v + wv2 * cv;
          const int rr = 128 * a + 64 * wr + 4 * fr + m, l = l0 + rr;
          if (rr >= 2 && l < 4096) {
            uint2 ow; ow.x = pack2(G[0] * sigm(G[0]) * V[0], G[1] * sigm(G[1]) * V[1]); ow.y = pack2(G[2] * sigm(G[2]) * V[2], G[3] * sigm(G[3]) * V[3]);
            *(uint2*)(act + (size_t)(seq * 4096 + l) * 2816 + c) = ow;
          }
        }
      }
    }
    PROBE_STAMP_ONCE(32, xb);
  }
};

struct EpiDown {
  float* out; const bf16_t* hb; float* rsq; unsigned* cnt; const float* g; LAS float* red; bool fused;
  __device__ __forceinline__ void operator()(f32x4 (&acc)[2][2][4][2], int pm, int pn, int wr, int wc, int fr, int fq) const {
    PROBE_STAMP_ONCE(30, red);
#pragma unroll
    for (int a = 0; a < 2; ++a)
#pragma unroll
      for (int m = 0; m < 4; ++m) {
        const int row = 256 * pm + 128 * a + 64 * wr + 16 * m + fr;
        float ss = 0.f;
#pragma unroll
        for (int b = 0; b < 2; ++b)
#pragma unroll
          for (int n = 0; n < 2; ++n) {
            const int col = 256 * pn + 128 * b + 32 * wc + 16 * n + 4 * fq;
            const uint2 hw = *(const uint2*)(hb + (size_t)row * 1024 + col);
            f32x4 v = acc[a][b][m][n];
            v[0] += lo2f(hw.x); v[1] += hi2f(hw.x); v[2] += lo2f(hw.y); v[3] += hi2f(hw.y);
            acc[a][b][m][n] = v;
            ss += v[0] * v[0] + v[1] * v[1] + v[2] * v[2] + v[3] * v[3];
          }
        ss += __shfl_xor(ss, 16); ss += __shfl_xor(ss, 32);
        if (fused) { if (fq == 0) red[(128 * a + 64 * wr + 16 * m + fr) * 4 + wc] = ss; }
        else if (fq == 0) unsafeAtomicAdd(rsq + row, ss);
      }
    if (!fused) {
#pragma unroll
      for (int a = 0; a < 2; ++a)
#pragma unroll
        for (int m = 0; m < 4; ++m) {
          const int row = 256 * pm + 128 * a + 64 * wr + 16 * m + fr;
#pragma unroll
          for (int b = 0; b < 2; ++b)
#pragma unroll
            for (int n = 0; n < 2; ++n) {
              const int col = 256 * pn + 128 * b + 32 * wc + 16 * n + 4 * fq;
              const f32x4 v = acc[a][b][m][n];
              *(float4*)(out + (size_t)row * 1024 + col) = make_float4(v[0], v[1], v[2], v[3]);
            }
        }
      return;
    }
    asm volatile("s_waitcnt lgkmcnt(0)" ::: "memory");
    __builtin_amdgcn_s_barrier(); asm volatile("" ::: "memory");
    __builtin_amdgcn_s_barrier(); asm volatile("" ::: "memory");
    const int wid = wr * 4 + wc, lane = fq * 16 + fr;
    unsigned* c = cnt + pm * 64;
    if (wid < 4) {
      const int r = wid * 64 + lane;
      const f32x4 q = *(const LAS f32x4*)(red + r * 4);
      const float old = unsafeAtomicAdd(rsq + 256 * pm + r, (q[0] + q[1]) + (q[2] + q[3]));
      asm volatile("s_waitcnt vmcnt(0)" :: "v"(old) : "memory");
      if (lane == 0) __hip_atomic_fetch_add(c, 1u, __ATOMIC_RELAXED, __HIP_MEMORY_SCOPE_AGENT);
    }
    {
      unsigned spins = 0;
      while ((unsigned)__builtin_amdgcn_readfirstlane((int)__hip_atomic_load(c, __ATOMIC_RELAXED, __HIP_MEMORY_SCOPE_AGENT)) < 16u) {
        __builtin_amdgcn_s_sleep(2);
        if (++spins > (1u << 22)) break;
      }
    }
#pragma unroll
    for (int a = 0; a < 2; ++a)
#pragma unroll
      for (int m = 0; m < 4; ++m) {
        const int row = 256 * pm + 128 * a + 64 * wr + 16 * m + fr;
        const float rstd = rsqrtf(__hip_atomic_load(rsq + row, __ATOMIC_RELAXED, __HIP_MEMORY_SCOPE_AGENT) * (1.f / 1024.f) + 1e-6f);
#pragma unroll
        for (int b = 0; b < 2; ++b)
#pragma unroll
          for (int n = 0; n < 2; ++n) {
            const int col = 256 * pn + 128 * b + 32 * wc + 16 * n + 4 * fq;
            const float4 gv = *(const float4*)(g + col);
            const f32x4 v = acc[a][b][m][n];
            st_nt16(out + (size_t)row * 1024 + col, (f32x4){v[0] * rstd * gv.x, v[1] * rstd * gv.y, v[2] * rstd * gv.z, v[3] * rstd * gv.w});
          }
      }
  }
};

__device__ void hg_a_item(const Params& p, int item, char* smem) {
  bf16_t* kT = (bf16_t*)smem;
  bf16_t* vT = kT + 128 * 72;
  float* tot = (float*)(vT + 128 * 72);
  const int tid = otid(), lane = tid & 63, wid = tid >> 6, fr = lane & 15, fq = lane >> 4;
  const int b = item >> 8, h = (item >> 6) & 3, n = item & 63;
  const int t0 = b * 4096 + n * 64;
  const int k = tid & 127, seg = tid >> 7;
  float bc[16]; bf16_t kr[16], vr[16];
  {
    const _Float16* lp = p.logf + (size_t)(t0 + seg * 16) * 512 + h * 128 + k;
    const bf16_t* kp = p.proj + (size_t)(t0 + seg * 16) * 2560 + 512 + h * 128 + k;
#pragma unroll
    for (int i = 0; i < 16; ++i) { bc[i] = (float)lp[(size_t)i * 512]; kr[i] = kp[(size_t)i * 2560]; vr[i] = kp[(size_t)i * 2560 + 512]; }
    float a = 0.f;
#pragma unroll
    for (int i = 0; i < 16; ++i) { a += bc[i]; bc[i] = a; }
    tot[seg * 128 + k] = a;
  }
  __syncthreads();
  float pre = 0.f, all = 0.f;
#pragma unroll
  for (int s4 = 0; s4 < 4; ++s4) { float tv = tot[s4 * 128 + k]; if (s4 < seg) pre += tv; all += tv; }
  unsigned kw[8], vw[8];
#pragma unroll
  for (int i = 0; i < 8; ++i) {
    float k0 = bf2f(kr[2 * i]) * __expf(all - (bc[2 * i] + pre));
    float k1 = bf2f(kr[2 * i + 1]) * __expf(all - (bc[2 * i + 1] + pre));
    kw[i] = pack2(k0, k1);
    vw[i] = (unsigned)vr[2 * i] | ((unsigned)vr[2 * i + 1] << 16);
  }
  *(uint4*)(kT + k * 72 + seg * 16) = make_uint4(kw[0], kw[1], kw[2], kw[3]);
  *(uint4*)(kT + k * 72 + seg * 16 + 8) = make_uint4(kw[4], kw[5], kw[6], kw[7]);
  *(uint4*)(vT + k * 72 + seg * 16) = make_uint4(vw[0], vw[1], vw[2], vw[3]);
  *(uint4*)(vT + k * 72 + seg * 16 + 8) = make_uint4(vw[4], vw[5], vw[6], vw[7]);
  if (seg == 0) p.decay[(size_t)item * 128 + k] = __expf(all);
  __syncthreads();
  bf16x8 af[2];
#pragma unroll
  for (int ks = 0; ks < 2; ++ks) af[ks] = *(const bf16x8*)(kT + (16 * wid + fr) * 72 + 32 * ks + 8 * fq);
#pragma unroll
  for (int j = 0; j < 8; ++j) {
    f32x4 acc = (f32x4){0.f, 0.f, 0.f, 0.f};
#pragma unroll
    for (int ks = 0; ks < 2; ++ks) {
      bf16x8 bfr = *(const bf16x8*)(vT + (16 * j + fr) * 72 + 32 * ks + 8 * fq);
      acc = __builtin_amdgcn_mfma_f32_16x16x32_bf16(af[ks], bfr, acc, 0, 0, 0);
    }
    *(uint2*)(p.dstate + (size_t)item * 16384 + (16 * j + fr) * 128 + 16 * wid + 4 * fq) = make_uint2(pack2(acc[0], acc[1]), pack2(acc[2], acc[3]));
  }
  __syncthreads();
}

__device__ void hg_c_item(const Params& p, int item, char* smem) {
  bf16_t* qd = (bf16_t*)smem;
  bf16_t* kd = qd + 64 * 136;
  bf16_t* vT = kd + 64 * 136;
  bf16_t* att = vT + 128 * 72;
  float* tot = (float*)(att + 64 * 72);
  float* ssq = tot + 512;
  const int tid = otid(), lane = tid & 63, wid = tid >> 6, fr = lane & 15, fq = lane >> 4;
  const int b = item >> 8, h = (item >> 6) & 3, n = item & 63;
  const int t0 = b * 4096 + n * 64;
  const int k = tid & 127, seg = tid >> 7;
  const int rt = wid & 3, hh = wid >> 2;
  const int token = t0 + 16 * rt + fr;
  float bc[16]; bf16_t qr[16], kr[16], vr[16];
  uint2 gw[4]; float4 g4[4];
  {
    const _Float16* lp = p.logf + (size_t)(t0 + seg * 16) * 512 + h * 128 + k;
    const bf16_t* qp = p.proj + (size_t)(t0 + seg * 16) * 2560 + h * 128 + k;
#pragma unroll
    for (int i = 0; i < 16; ++i) { bc[i] = (float)lp[(size_t)i * 512]; qr[i] = qp[(size_t)i * 2560]; kr[i] = qp[(size_t)i * 2560 + 512]; vr[i] = qp[(size_t)i * 2560 + 1024]; }
#pragma unroll
    for (int j = 0; j < 4; ++j) {
      const int col = h * 128 + 16 * (4 * hh + j) + 4 * fq;
      gw[j] = *(const uint2*)(p.proj + (size_t)token * 2560 + 1536 + col);
      g4[j] = *(const float4*)(p.hg_norm_g + col);
    }
    float a = 0.f;
#pragma unroll
    for (int i = 0; i < 16; ++i) { a += bc[i]; bc[i] = a; }
    tot[seg * 128 + k] = a;
  }
  __syncthreads();
  const bf16_t* sp = p.sstart + (size_t)item * 16384;
  bf16x8 sf[4][4];
#pragma unroll
  for (int ks = 0; ks < 4; ++ks)
#pragma unroll
    for (int j = 0; j < 4; ++j) sf[ks][j] = *(const bf16x8*)(sp + (16 * (4 * hh + j) + fr) * 128 + 32 * ks + 8 * fq);
  float pre = 0.f;
#pragma unroll
  for (int s4 = 0; s4 < 4; ++s4) { float tv = tot[s4 * 128 + k]; if (s4 < seg) pre += tv; }
  unsigned vw[8];
#pragma unroll
  for (int i = 0; i < 16; ++i) {
    float bb = bc[i] + pre;
    qd[(seg * 16 + i) * 136 + k] = f2bf(bf2f(qr[i]) * __expf(bb));
    kd[(seg * 16 + i) * 136 + k] = f2bf(bf2f(kr[i]) * __expf(-bb));
    unsigned vv = (unsigned)vr[i];
    if (i & 1) vw[i >> 1] |= vv << 16; else vw[i >> 1] = vv;
  }
  *(uint4*)(vT + k * 72 + seg * 16) = make_uint4(vw[0], vw[1], vw[2], vw[3]);
  *(uint4*)(vT + k * 72 + seg * 16 + 8) = make_uint4(vw[4], vw[5], vw[6], vw[7]);
  __syncthreads();
#pragma unroll
  for (int st2 = 0; st2 < 2; ++st2) {
    const int st = 2 * hh + st2;
    f32x4 acc = (f32x4){0.f, 0.f, 0.f, 0.f};
#pragma unroll
    for (int ks = 0; ks < 4; ++ks) {
      bf16x8 a = *(const bf16x8*)(kd + (16 * st + fr) * 136 + 32 * ks + 8 * fq);
      bf16x8 bq = *(const bf16x8*)(qd + (16 * rt + fr) * 136 + 32 * ks + 8 * fq);
      acc = __builtin_amdgcn_mfma_f32_16x16x32_bf16(a, bq, acc, 0, 0, 0);
    }
    const int c = 16 * rt + fr, s0 = 16 * st + 4 * fq;
    float v0 = (s0 + 0 <= c) ? acc[0] : 0.f, v1 = (s0 + 1 <= c) ? acc[1] : 0.f, v2 = (s0 + 2 <= c) ? acc[2] : 0.f, v3 = (s0 + 3 <= c) ? acc[3] : 0.f;
    uint2 o; o.x = pack2(v0, v1); o.y = pack2(v2, v3);
    *(uint2*)(att + c * 72 + s0) = o;
  }
  __syncthreads();
  f32x4 o[4];
#pragma unroll
  for (int j = 0; j < 4; ++j) o[j] = (f32x4){0.f, 0.f, 0.f, 0.f};
#pragma unroll
  for (int ks = 0; ks < 2; ++ks) {
    bf16x8 bq = *(const bf16x8*)(att + (16 * rt + fr) * 72 + 32 * ks + 8 * fq);
#pragma unroll
    for (int j = 0; j < 4; ++j) {
      bf16x8 a = *(const bf16x8*)(vT + (16 * (4 * hh + j) + fr) * 72 + 32 * ks + 8 * fq);
      o[j] = __builtin_amdgcn_mfma_f32_16x16x32_bf16(a, bq, o[j], 0, 0, 0);
    }
  }
#pragma unroll
  for (int ks = 0; ks < 4; ++ks) {
    bf16x8 bq = *(const bf16x8*)(qd + (16 * rt + fr) * 136 + 32 * ks + 8 * fq);
#pragma unroll
    for (int j = 0; j < 4; ++j) o[j] = __builtin_amdgcn_mfma_f32_16x16x32_bf16(sf[ks][j], bq, o[j], 0, 0, 0);
  }
  float ss = 0.f;
#pragma unroll
  for (int j = 0; j < 4; ++j) ss += o[j][0] * o[j][0] + o[j][1] * o[j][1] + o[j][2] * o[j][2] + o[j][3] * o[j][3];
  ss += __shfl_xor(ss, 16); ss += __shfl_xor(ss, 32);
  if (fq == 0) ssq[hh * 64 + 16 * rt + fr] = ss;
  __syncthreads();
  const float tss = ssq[16 * rt + fr] + ssq[64 + 16 * rt + fr];
  const float rstd = rsqrtf(tss * (1.f / 128.f) + 1e-6f);
#pragma unroll
  for (int j = 0; j < 4; ++j) {
    const int col = h * 128 + 16 * (4 * hh + j) + 4 * fq;
    float z0 = lo2f(gw[j].x), z1 = hi2f(gw[j].x), z2 = lo2f(gw[j].y), z3 = hi2f(gw[j].y);
    float r0 = o[j][0] * rstd * g4[j].x * z0 * sigm(z0), r1 = o[j][1] * rstd * g4[j].y * z1 * sigm(z1);
    float r2 = o[j][2] * rstd * g4[j].z * z2 * sigm(z2), r3 = o[j][3] * rstd * g4[j].w * z3 * sigm(z3);
    uint2 ow; ow.x = pack2(r0, r1); ow.y = pack2(r2, r3);
    *(uint2*)(p.mix + (size_t)token * 1024 + col) = ow;
  }
  __syncthreads();
}

__device__ void s5_a_block(const Params& p, int g, int to, char* smem) {
  const int tid = otid(), lane = tid & 63, wid = tid >> 6, fr = lane & 15, fq = lane >> 4;
  const int tt = to * 8 + wid;
  bf16x8 U[8];
#pragma unroll
  for (int ks = 0; ks < 8; ++ks) {
    const int tok = tt * 256 + 16 * fr + 2 * ks + (fq >> 1);
    U[ks] = *(const bf16x8*)(p.proj + (size_t)tok * 2560 + 2048 + g * 16 + 8 * (fq & 1));
  }
  {
    const uint4* src = (const uint4*)(p.Ftab + (size_t)g * 128 * 256);
    uint4 v[8];
#pragma unroll
    for (int i = 0; i < 8; ++i) v[i] = src[tid + 512 * i];
#pragma unroll
    for (int i = 0; i < 8; ++i) { const int c = tid + 512 * i; *(uint4*)(smem + (c >> 5) * 528 + (c & 31) * 16) = v[i]; }
  }
  __syncthreads();
#pragma unroll
  for (int rt = 0; rt < 8; ++rt) {
    f32x4 acc = (f32x4){0.f, 0.f, 0.f, 0.f};
#pragma unroll
    for (int ks = 0; ks < 8; ++ks) {
      bf16x8 a = *(const bf16x8*)(smem + (16 * rt + fr) * 528 + 64 * ks + 16 * fq);
      acc = __builtin_amdgcn_mfma_f32_16x16x32_bf16(a, U[ks], acc, 0, 0, 0);
    }
    *(f32x4*)(p.Xend + ((size_t)(tt * 16 + fr) * 32 + g) * 128 + 16 * rt + 4 * fq) = acc;
  }
  __syncthreads();
}

__device__ void s5_c_block(const Params& p, int g, int to, char* smem) {
  const int tid = otid(), lane = tid & 63, wid = tid >> 6, fr = lane & 15, fq = lane >> 4;
  const int tt = to * 8 + wid;
  bf16x8 U[8], Kf[16], Xf[4];
#pragma unroll
  for (int ks = 0; ks < 8; ++ks) {
    const int tok = tt * 256 + 16 * fr + 2 * ks + (fq >> 1);
    U[ks] = *(const bf16x8*)(p.proj + (size_t)tok * 2560 + 2048 + g * 16 + 8 * (fq & 1));
  }
#pragma unroll
  for (int d = 0; d < 16; ++d) {
    const int tau = d - (fq >> 1);
    bf16x8 z = (bf16x8){0, 0, 0, 0, 0, 0, 0, 0};
    if (tau >= 0) z = *(const bf16x8*)(p.Ktab + (size_t)((g * 16 + tau) * 16 + fr) * 16 + 8 * (fq & 1));
    Kf[d] = z;
  }
#pragma unroll
  for (int ks = 0; ks < 4; ++ks) Xf[ks] = *(const bf16x8*)(p.Xs + ((size_t)(tt * 16 + fr) * 32 + g) * 128 + 32 * ks + 8 * fq);
  const int c0 = g * 16 + 4 * fq;
  const float4 dsk = *(const float4*)(p.s5_d + c0);
  uint2 uw[16];
#pragma unroll
  for (int t = 0; t < 16; ++t) uw[t] = *(const uint2*)(p.proj + (size_t)(tt * 256 + 16 * fr + t) * 2560 + 2048 + c0);
  {
    const uint4* src = (const uint4*)(p.Etab + (size_t)g * 256 * 128);
    uint4 v[8];
#pragma unroll
    for (int i = 0; i < 8; ++i) v[i] = src[tid + 512 * i];
#pragma unroll
    for (int i = 0; i < 8; ++i) { const int c = tid + 512 * i; *(uint4*)(smem + (c >> 4) * 272 + (c & 15) * 16) = v[i]; }
  }
  __syncthreads();
#pragma unroll
  for (int t = 0; t < 16; ++t) {
    f32x4 acc = (f32x4){0.f, 0.f, 0.f, 0.f};
#pragma unroll
    for (int ks = 0; ks <= t / 2; ++ks) acc = __builtin_amdgcn_mfma_f32_16x16x32_bf16(Kf[t - 2 * ks], U[ks], acc, 0, 0, 0);
#pragma unroll
    for (int ks = 0; ks < 4; ++ks) {
      bf16x8 a = *(const bf16x8*)(smem + (t * 16 + fr) * 272 + 64 * ks + 16 * fq);
      acc = __builtin_amdgcn_mfma_f32_16x16x32_bf16(a, Xf[ks], acc, 0, 0, 0);
    }
    const int token = tt * 256 + 16 * fr + t;
    float y0 = acc[0] + dsk.x * lo2f(uw[t].x), y1 = acc[1] + dsk.y * hi2f(uw[t].x), y2 = acc[2] + dsk.z * lo2f(uw[t].y), y3 = acc[3] + dsk.w * hi2f(uw[t].y);
    uint2 ow; ow.x = pack2(gelu_tanh(y0), gelu_tanh(y1)); ow.y = pack2(gelu_tanh(y2), gelu_tanh(y3));
    *(uint2*)(p.ybuf + (size_t)token * 512 + c0) = ow;
  }
  __syncthreads();
}

#define XB_TMO      128
#define XB_XCNT(j)  (256  + 64 * (j))
#define XB_XSUB(j)  (1280 + 64 * (j))
#define XB_XGEN(j)  (2304 + 64 * (j))
#define XB_TOP      3328
#define XB_TOPGEN   3392
#define XCD_BAR_WORDS 3456
#define XB_SPIN_CAP (1u << 20)
__device__ __forceinline__ unsigned xb_ld(unsigned* p) { return __hip_atomic_load(p, __ATOMIC_RELAXED, __HIP_MEMORY_SCOPE_AGENT); }
__device__ __forceinline__ unsigned xb_add(unsigned* p, unsigned v) { return __hip_atomic_fetch_add(p, v, __ATOMIC_RELAXED, __HIP_MEMORY_SCOPE_AGENT); }
__device__ __forceinline__ unsigned xb_xcc_id() { return (unsigned)__builtin_amdgcn_s_getreg((3 << 11) | 20) & 0xFu; }
#define XB_SPIN(cond, bar) do { unsigned _sp = 0; while (cond) { __builtin_amdgcn_s_sleep(1); \
    if ((++_sp & 255u) == 0u) { if (xb_ld(&(bar)[XB_TMO])) break; if (_sp > XB_SPIN_CAP) { atomicAdd(&(bar)[XB_TMO], 1u); break; } } } } while (0)
struct XcdBarrier { unsigned* bar; unsigned x; volatile LAS unsigned* st; };
__device__ __forceinline__ XcdBarrier xcd_barrier_post(unsigned* bar, volatile LAS unsigned* st) {
  XcdBarrier b; b.bar = bar; b.x = xb_xcc_id(); b.st = st;
  if (threadIdx.x == 0) (void)xb_add(&bar[XB_XCNT(b.x)], 1u);
  return b;
}
__device__ __forceinline__ void xcd_barrier_complete(unsigned* bar, unsigned x, unsigned& nloc, unsigned& nx) {
  const unsigned G = gridDim.x * gridDim.y * gridDim.z;
  unsigned sum, cnt, mine, sp = 0u;
  for (;;) {
    sum = 0u; cnt = 0u; mine = 0u;
#pragma unroll
    for (unsigned j = 0; j < 16; ++j) { const unsigned c = xb_ld(&bar[XB_XCNT(j)]); sum += c; cnt += (c > 0u) ? 1u : 0u; mine = (j == x) ? c : mine; }
    if (sum == G) break;
    __builtin_amdgcn_s_sleep(1);
    if ((++sp & 255u) == 0u) { if (xb_ld(&bar[XB_TMO])) break; if (sp > XB_SPIN_CAP) { atomicAdd(&bar[XB_TMO], 1u); break; } }
  }
  nloc = mine > 0u ? mine : 1u; nx = cnt > 0u ? cnt : 1u;
}
__device__ __forceinline__ void xcd_barrier(const XcdBarrier& b) {
  asm volatile("s_waitcnt vmcnt(0)" ::: "memory");
  __syncthreads();
  if (threadIdx.x == 0) {
    unsigned* bar = b.bar;
    __builtin_amdgcn_s_waitcnt(0);
    unsigned nloc = b.st[0], nx = b.st[1];
    if (nloc == 0u) { xcd_barrier_complete(bar, b.x, nloc, nx); b.st[0] = nloc; b.st[1] = nx; }
    const unsigned old = xb_add(&bar[XB_XSUB(b.x)], 1u);
    const unsigned gen = old / nloc;
    if (old + 1u == (gen + 1u) * nloc) {
      __builtin_amdgcn_fence(__ATOMIC_RELEASE, "agent");
      asm volatile("s_waitcnt vmcnt(0)" ::: "memory");
      const unsigned og = xb_add(&bar[XB_TOP], 1u);
      const unsigned tg = og / nx;
      if (og + 1u == (tg + 1u) * nx) xb_add(&bar[XB_TOPGEN], 1u);
      else XB_SPIN(xb_ld(&bar[XB_TOPGEN]) == tg, bar);
      __builtin_amdgcn_fence(__ATOMIC_ACQUIRE, "agent");
      xb_add(&bar[XB_XGEN(b.x)], 1u);
      asm volatile("s_waitcnt vmcnt(0)" ::: "memory");
    } else {
      XB_SPIN(xb_ld(&bar[XB_XGEN(b.x)]) == gen, bar);
      __builtin_amdgcn_fence(__ATOMIC_ACQUIRE, "agent");
      asm volatile("s_waitcnt vmcnt(0)" ::: "memory");
    }
  }
  __syncthreads();
}

__device__ void phase_mix_a(const Params& p, char* smem, int part) {
  if (part == 0) { for (int it = blockIdx.x; it < 1024; it += gridDim.x) hg_a_item(p, it, smem); }
  else { for (int u = blockIdx.x; u < 256; u += gridDim.x) s5_a_block(p, u & 31, u >> 5, smem); }
}

__device__ void phase_scan(const Params& p) {
  int tid = otid();
  if (tid < 128) {
    for (int it = blockIdx.x * 128 + tid; it < 32768; it += gridDim.x * 128) {
      const int seg = it & 3, ch = it >> 2;
      const int bt = ch >> 11, g = (ch >> 6) & 31, n = ch & 63;
      const float2 a = p.Pw[g * 64 + n];
      const size_t base = ((size_t)(bt * 256 + seg * 64) * 32 + g) * 128 + n;
      const float* __restrict__ xe = p.Xend + base;
      bf16_t* __restrict__ xs = p.Xs + base;
      float xr = 0.f, xi = 0.f;
#pragma unroll 1
      for (int h = 0; h < 2; ++h) {
        float er[32], ei[32];
#pragma unroll
        for (int j = 0; j < 32; ++j) { er[j] = xe[(size_t)(h * 32 + j) * 4096]; ei[j] = xe[(size_t)(h * 32 + j) * 4096 + 64]; }
#pragma unroll
        for (int j = 0; j < 32; ++j) { const float nr = a.x * xr - a.y * xi + er[j], ni = a.x * xi + a.y * xr + ei[j]; xr = nr; xi = ni; }
      }
      float Ar = a.x, Ai = a.y;
#pragma unroll
      for (int q = 0; q < 6; ++q) { const float t = Ar * Ar - Ai * Ai; Ai = 2.f * Ar * Ai; Ar = t; }
      const int lb = (tid & 63) & ~3;
      const float e0r = __shfl(xr, lb), e0i = __shfl(xi, lb), e1r = __shfl(xr, lb + 1), e1i = __shfl(xi, lb + 1), e2r = __shfl(xr, lb + 2), e2i = __shfl(xi, lb + 2);
      const float s2r = Ar * e0r - Ai * e0i + e1r, s2i = Ar * e0i + Ai * e0r + e1i;
      const float s3r = Ar * s2r - Ai * s2i + e2r, s3i = Ar * s2i + Ai * s2r + e2i;
      xr = seg == 0 ? 0.f : (seg == 1 ? e0r : (seg == 2 ? s2r : s3r));
      xi = seg == 0 ? 0.f : (seg == 1 ? e0i : (seg == 2 ? s2i : s3i));
#pragma unroll 1
      for (int h = 0; h < 2; ++h) {
        float er[32], ei[32];
#pragma unroll
        for (int j = 0; j < 32; ++j) { er[j] = xe[(size_t)(h * 32 + j) * 4096]; ei[j] = xe[(size_t)(h * 32 + j) * 4096 + 64]; }
#pragma unroll
        for (int j = 0; j < 32; ++j) {
          xs[(size_t)(h * 32 + j) * 4096] = f2bf(xr); xs[(size_t)(h * 32 + j) * 4096 + 64] = f2bf(xi);
          const float nr = a.x * xr - a.y * xi + er[j], ni = a.x * xi + a.y * xr + ei[j]; xr = nr; xi = ni;
        }
      }
    }
  }
  const int gtid = blockIdx.x * NTHR + tid, gthr = gridDim.x * NTHR;
  for (int e2 = gtid; e2 < 16 * 8192; e2 += gthr) {
    const int bh = e2 >> 13, e = (e2 & 8191) * 2, k = e & 127;
    const bf16_t* __restrict__ dsp = p.dstate + (size_t)bh * 64 * 16384 + e;
    const float* __restrict__ dcp = p.decay + (size_t)bh * 64 * 128 + k;
    bf16_t* __restrict__ sp = p.sstart + (size_t)bh * 64 * 16384 + e;
    float sx = 0.f, sy = 0.f;
#pragma unroll 1
    for (int n0 = 0; n0 < 64; n0 += 16) {
      unsigned ds[16]; float2 dc[16];
#pragma unroll
      for (int j = 0; j < 16; ++j) { ds[j] = *(const unsigned*)(dsp + (size_t)(n0 + j) * 16384); dc[j] = *(const float2*)(dcp + (n0 + j) * 128); }
#pragma unroll
      for (int j = 0; j < 16; ++j) {
        *(unsigned*)(sp + (size_t)(n0 + j) * 16384) = pack2(sx, sy);
        sx = dc[j].x * sx + lo2f(ds[j]); sy = dc[j].y * sy + hi2f(ds[j]);
      }
    }
  }
}

__device__ void phase_mix_c(const Params& p, char* smem, int part) {
  if (part == 0) {
    if (gridDim.x == 256) {
      const int b = blockIdx.x, first = b < 128 ? b * 3 : 384 + (b - 128) * 5, cnt = b < 128 ? 3 : 5;
      for (int j = 0; j < cnt; ++j) hg_c_item(p, first + j, smem);
    } else { for (int it = blockIdx.x; it < 1024; it += gridDim.x) hg_c_item(p, it, smem); }
  }
  else { for (int u = blockIdx.x; u < 256; u += gridDim.x) s5_c_block(p, u & 31, u >> 5, smem); }
}

__device__ void phase_final(const Params& p) {
  int tid_ = otid();
  const int lane = tid_ & 63, wid = tid_ >> 6;
  for (int row0 = (blockIdx.x * 8 + wid) * 4; row0 < T; row0 += gridDim.x * 32) {
    float4 v[4][4]; float rs[4];
#pragma unroll
    for (int r = 0; r < 4; ++r) {
      const float4* op = (const float4*)(p.out + (size_t)(row0 + r) * 1024);
#pragma unroll
      for (int i = 0; i < 4; ++i) v[r][i] = op[lane + 64 * i];
      rs[r] = rsqrtf(p.rsq2[row0 + r] * (1.f / 1024.f) + 1e-6f);
    }
#pragma unroll
    for (int i = 0; i < 4; ++i) {
      const float4 g = ((const float4*)p.final_g)[lane + 64 * i];
#pragma unroll
      for (int r = 0; r < 4; ++r) {
        float4 w = v[r][i];
        w.x *= rs[r] * g.x; w.y *= rs[r] * g.y; w.z *= rs[r] * g.z; w.w *= rs[r] * g.w;
        ((float4*)(p.out + (size_t)(row0 + r) * 1024))[lane + 64 * i] = w;
      }
    }
  }
}

template <int PH>
__device__ __forceinline__ void run_phase(const Params& p, char* smem) {
  if (PH == 0) phase_prep(p, smem);
  if (PH == 100) phase_prep_xn(p);
  if (PH == 1) {
    EpiProj e{p.proj, p.logf, p.hg_lb}; gemm_phase(p.xn, p.Wt_in, T, 2560, 1024, e, smem);
    if (gridDim.x == 256 && blockIdx.x >= 128)
      for (int t = 160 + ((int)blockIdx.x - 128); t < 768; t += 128) transpose_any(p, t, (float*)smem);
  }
  if (PH == 2) phase_mix_a(p, smem, 0);
  if (PH == 102) phase_mix_a(p, smem, 1);
  if (PH == 3) phase_scan(p);
  if (PH == 4) phase_mix_c(p, smem, 1);
  if (PH == 104) { }
  if (PH == 5) { EpiGlu e{p.ybuf, p.b_glu, p.mix}; gemm_phase(p.ybuf, p.Wt_glu, T, 512, 512, e, smem); phase_mix_c(p, smem, 0); }
  if (PH == 6) { EpiOut e{p.x, p.hb, p.rsq1}; gemm_phase(p.mix, p.Wt_out, T, 1024, 1024, e, smem); }
  if (PH == 7) { EpiUpConv e{p.act, p.rsq1, p.conv_w, p.conv_b, (LAS float*)((LAS unsigned char*)smem + 131088)}; gemm_phase(p.hb, p.Wt_up, 68 * 256, 5632, 1024, e, smem, RowMapConv()); }
  if (PH == 8) { EpiDown e{p.out, p.hb, p.rsq2, p.bar + XCD_BAR_WORDS, p.final_g, (LAS float*)((LAS unsigned char*)smem + 131088), gridDim.x >= 256}; gemm_phase(p.act, p.Wt_down, T, 1024, 2816, e, smem); }
  if (PH == 9) { if (gridDim.x < 256) phase_final(p); }
}

#if MK_FUSED
#define PROBE_MARK(k) do { if (PROBE_K == (k)) t_mark = __builtin_amdgcn_s_memrealtime(); } while (0)
__global__ void __launch_bounds__(NTHR) fwd_megakernel(Params p) {
  extern __shared__ __attribute__((aligned(16))) char smem[];
  volatile LAS unsigned* st = (volatile LAS unsigned*)((LAS unsigned char*)smem + 131072);
  if (threadIdx.x == 0) { st[0] = 0u; st[1] = 0u; st[2] = 0u; st[3] = 0u; }
  __syncthreads();
  const XcdBarrier xb = xcd_barrier_post(p.bar, st);
  unsigned long long t_start = 0, t_mark = 0;
  if (PROBE_K >= 0) { t_start = __builtin_amdgcn_s_memrealtime(); t_mark = t_start; }
  run_phase<0>(p, smem); PROBE_MARK(21); run_phase<100>(p, smem); PROBE_MARK(20);
  cg::this_grid().sync(); PROBE_MARK(0);
  run_phase<1>(p, smem); xcd_barrier(xb); PROBE_MARK(1);
  run_phase<2>(p, smem); PROBE_MARK(23); run_phase<102>(p, smem); xcd_barrier(xb); PROBE_MARK(2);
  run_phase<3>(p, smem); PROBE_MARK(40); xcd_barrier(xb); PROBE_MARK(3);
  run_phase<4>(p, smem); PROBE_MARK(22); run_phase<104>(p, smem); xcd_barrier(xb); PROBE_MARK(4);
  run_phase<5>(p, smem); xcd_barrier(xb); PROBE_MARK(5);
  run_phase<6>(p, smem); xcd_barrier(xb); PROBE_MARK(6);
  run_phase<7>(p, smem); PROBE_MARK(41); xcd_barrier(xb); PROBE_MARK(7);
  run_phase<8>(p, smem);
  if (gridDim.x < 256) { xcd_barrier(xb); run_phase<9>(p, smem); }
  if (PROBE_K >= 30 && PROBE_K < 40) t_mark = *(volatile LAS unsigned long long*)((LAS unsigned char*)smem + 131080);
  if (PROBE_K >= 0) {
    const unsigned long long t_end = __builtin_amdgcn_s_memrealtime();
    const unsigned long long until = t_end + 4ull * (t_mark - t_start);
    while (__builtin_amdgcn_s_memrealtime() < until) __builtin_amdgcn_s_sleep(8);
  }
}
#else
template <int PH>
__global__ void __launch_bounds__(NTHR) phase_kernel(Params p) {
  extern __shared__ __attribute__((aligned(16))) char smem[];
  run_phase<PH>(p, smem);
}
template <int PH>
static void launch_phase(const Params& p, int grid, hipStream_t stream) {
  (void)hipFuncSetAttribute((const void*)phase_kernel<PH>, hipFuncAttributeMaxDynamicSharedMemorySize, LDS_BYTES);
  hipLaunchKernelGGL(phase_kernel<PH>, dim3(grid), dim3(NTHR), LDS_BYTES, stream, p);
}
#endif

extern "C" void kernel_launch(void* const* d_in, const int* in_sizes, int n_in, void* d_out, int out_size, void* d_ws,
                              size_t ws_size, hipStream_t stream) {
  Params p{};
  p.x = (const float*)d_in[0]; p.in_norm_g = (const float*)d_in[1]; p.w_in = (const float*)d_in[2]; p.hg_lb = (const float*)d_in[3];
  p.hg_norm_g = (const float*)d_in[4]; p.a_re = (const float*)d_in[5]; p.a_im = (const float*)d_in[6]; p.log_dt = (const float*)d_in[7];
  p.b_re = (const float*)d_in[8]; p.b_im = (const float*)d_in[9]; p.c_re = (const float*)d_in[10]; p.c_im = (const float*)d_in[11];
  p.s5_d = (const float*)d_in[12]; p.w_glu = (const float*)d_in[13]; p.b_glu = (const float*)d_in[14]; p.w_out = (const float*)d_in[15];
  p.ffn_norm_g = (const float*)d_in[16]; p.w_up = (const float*)d_in[17]; p.conv_w = (const float*)d_in[18]; p.conv_b = (const float*)d_in[19];
  p.w_down = (const float*)d_in[20]; p.final_g = (const float*)d_in[21];
  p.out = (float*)d_out;
  char* ws = (char*)d_ws;
  size_t off = 0;
  auto take = [&](size_t bytes) { char* r = ws + off; off += (bytes + 255) & ~(size_t)255; return r; };
  p.Wt_in = (bf16_t*)take((size_t)2560 * 1024 * 2);
  p.Wt_glu = (bf16_t*)take((size_t)512 * 512 * 2);
  p.Wt_out = (bf16_t*)take((size_t)1024 * 1024 * 2);
  p.Wt_up = (bf16_t*)take((size_t)5632 * 1024 * 2);
  p.Wt_down = (bf16_t*)take((size_t)1024 * 2816 * 2);
  p.Ktab = (bf16_t*)take((size_t)32 * 16 * 256 * 2);
  p.Etab = (bf16_t*)take((size_t)32 * 256 * 128 * 2);
  p.Ftab = (bf16_t*)take((size_t)32 * 128 * 256 * 2);
  p.Pw = (float2*)take((size_t)32 * 17 * 64 * 8);
  p.Bbar = (float2*)take((size_t)32 * 64 * 16 * 8);
  p.rsq1 = (float*)take((size_t)T * 16 * 4);
  p.rsq2 = (float*)take((size_t)T * 16 * 4);
  p.decay = (float*)take((size_t)1024 * 128 * 4);
  p.bar = (unsigned*)take((size_t)(XCD_BAR_WORDS + 64 * 64) * 4);
  const size_t dyn0 = off;
  p.xn = (bf16_t*)take((size_t)T * 1024 * 2);
  p.sstart = p.xn; p.hb = p.xn;
  const size_t r2 = off;
  p.proj = (bf16_t*)take((size_t)T * 2560 * 2);
  p.logf = (_Float16*)take((size_t)T * 512 * 4);
  p.mix = (bf16_t*)take((size_t)T * 1024 * 2);
  p.ybuf = (bf16_t*)take((size_t)T * 512 * 2);
  p.Xend = (float*)take((size_t)1024 * 32 * 128 * 4);
  p.Xs = (bf16_t*)take((size_t)1024 * 32 * 128 * 2);
  const size_t endA = off;
  p.dstate = (bf16_t*)d_out;
  off = r2;
  p.act = (bf16_t*)take((size_t)T * 2816 * 2);
  const size_t endB = off;
  (void)dyn0;
  if (endA > ws_size || endB > ws_size) fprintf(stderr, "workspace too small: need %zu / %zu have %zu\n", endA, endB, ws_size);

  static int grid_blocks = 0;
#if MK_FUSED
  if (!grid_blocks) {
    int dev = 0, cus = 0, per_cu = 0;
    (void)hipGetDevice(&dev);
    (void)hipDeviceGetAttribute(&cus, hipDeviceAttributeMultiprocessorCount, dev);
    (void)hipFuncSetAttribute((const void*)fwd_megakernel, hipFuncAttributeMaxDynamicSharedMemorySize, LDS_BYTES);
    (void)hipOccupancyMaxActiveBlocksPerMultiprocessor(&per_cu, fwd_megakernel, NTHR, LDS_BYTES);
    if (per_cu > 1) per_cu = 1;
    grid_blocks = cus * per_cu;
  }
  (void)hipMemsetAsync(p.bar, 0, (size_t)(XCD_BAR_WORDS + 64 * 64) * 4, stream);
  void* args[] = {&p};
  hipError_t e = hipLaunchCooperativeKernel((void*)fwd_megakernel, dim3(grid_blocks), dim3(NTHR), args, LDS_BYTES, stream);
  if (e != hipSuccess) fprintf(stderr, "cooperative launch failed: %s (grid %d)\n", hipGetErrorString(e), grid_blocks);
#else
  if (!grid_blocks) {
    int dev = 0, cus = 0;
    (void)hipGetDevice(&dev);
    (void)hipDeviceGetAttribute(&cus, hipDeviceAttributeMultiprocessorCount, dev);
    grid_blocks = cus;
  }
  launch_phase<0>(p, grid_blocks, stream);
  launch_phase<100>(p, grid_blocks, stream);
  launch_phase<1>(p, grid_blocks, stream);
  launch_phase<2>(p, grid_blocks, stream);
  launch_phase<102>(p, grid_blocks, stream);
  launch_phase<3>(p, grid_blocks, stream);
  launch_phase<4>(p, grid_blocks, stream);
  launch_phase<104>(p, grid_blocks, stream);
  launch_phase<5>(p, grid_blocks, stream);
  launch_phase<6>(p, grid_blocks, stream);
  launch_phase<7>(p, grid_blocks, stream);
  launch_phase<8>(p, grid_blocks, stream);
  launch_phase<9>(p, grid_blocks, stream);
#endif
}
```

```cpp
#include <hip/hip_runtime.h>
#include <hip/hip_cooperative_groups.h>
#include <stdint.h>
#include <cstdio>
namespace cg = cooperative_groups;

#ifndef PROBE_K
#define PROBE_K -1
#endif
#ifndef MK_FUSED
#define MK_FUSED 1
#endif

typedef unsigned short bf16_t;
typedef short bf16x8 __attribute__((ext_vector_type(8)));
typedef float f32x4 __attribute__((ext_vector_type(4)));

constexpr int T = 16384;
constexpr int NTHR = 512;
constexpr int LDS_BYTES = 128 * 1024 + 16 + 6144;

struct Params {
  const float *x, *in_norm_g, *w_in, *hg_lb, *hg_norm_g, *a_re, *a_im, *log_dt, *b_re, *b_im, *c_re, *c_im, *s5_d,
      *w_glu, *b_glu, *w_out, *ffn_norm_g, *w_up, *conv_w, *conv_b, *w_down, *final_g;
  float* out;
  bf16_t *Wt_in, *Wt_glu, *Wt_out, *Wt_up, *Wt_down, *xn, *proj, *sstart, *Xs, *mix, *ybuf, *ubuf, *hb, *hid, *act, *Ktab, *Etab, *Ftab;
  _Float16* logf; bf16_t* dstate;
  float *decay, *Xend, *rsq1, *rsq2;
  float2 *Pw, *Bbar;
  unsigned* bar;
};

__device__ __forceinline__ int otid() { int t = threadIdx.x; asm volatile("" : "+v"(t)); return t; }
typedef float f32x2_t __attribute__((ext_vector_type(2)));
typedef __bf16 bf16x2_t __attribute__((ext_vector_type(2)));
__device__ __forceinline__ unsigned pack2(float a, float b) { f32x2_t v = {a, b}; bf16x2_t h = __builtin_convertvector(v, bf16x2_t); return __builtin_bit_cast(unsigned, h); }
__device__ __forceinline__ bf16_t f2bf(float f) { return (bf16_t)(pack2(f, f) & 0xffffu); }
__device__ __forceinline__ float bf2f(bf16_t h) { return __uint_as_float(((unsigned)h) << 16); }
__device__ __forceinline__ float lo2f(unsigned w) { return __uint_as_float(w << 16); }
__device__ __forceinline__ float hi2f(unsigned w) { return __uint_as_float(w & 0xffff0000u); }
__device__ __forceinline__ float sigm(float x) { return __builtin_amdgcn_rcpf(1.f + __expf(-x)); }
__device__ __forceinline__ float gelu_tanh(float y) {
  float u = 0.7978845608028654f * (y + 0.044715f * y * y * y);
  return y * sigm(2.f * u);
}

__device__ double exp_d(double x) {
  double k = rint(x * 1.4426950408889634);
  double r = fma(-k, 0.6931471805599453, x);
  r = fma(-k, 2.3190468138462996e-17, r);
  double p = 1.0;
#pragma unroll
  for (int i = 16; i >= 1; --i) p = fma(r * p, 1.0 / (double)i, 1.0);
  return ldexp(p, (int)k);
}
__device__ void sincos_d(double x, double& s, double& c) {
  double q = rint(x * 0.6366197723675814);
  double r = fma(-q, 1.5707963267948966, x);
  r = fma(-q, 6.123233995736766e-17, r);
  int iq = ((int)q) & 3;
  double r2 = r * r;
  double sp = 1.0, cp = 1.0;
#pragma unroll
  for (int i = 9; i >= 1; --i) sp = fma(-r2 * sp, 1.0 / (double)((2 * i) * (2 * i + 1)), 1.0);
  sp *= r;
#pragma unroll
  for (int i = 10; i >= 1; --i) cp = fma(-r2 * cp, 1.0 / (double)((2 * i - 1) * (2 * i)), 1.0);
  if (iq == 0) { s = sp; c = cp; }
  else if (iq == 1) { s = cp; c = -sp; }
  else if (iq == 2) { s = -sp; c = -cp; }
  else { s = -cp; c = sp; }
}

__device__ __forceinline__ int perm32_row(int n) { const int j = n & 31; return (n & ~31) + 16 * ((j >> 2) & 1) + 4 * (j >> 3) + (j & 3); }
__device__ __forceinline__ int up_dst_row(int n) { const int isv = n >= 2816, nn = isv ? n - 2816 : n; return ((nn >> 7) << 8) + isv * 128 + (nn & 127); }

__device__ void transpose_big(const float* __restrict__ src, bf16_t* __restrict__ dst, int K, int N, int tk, int tn,
                              const float* __restrict__ rowscale, bool perm, float* tile, bool permB = false) {
  const int tid = otid();
  const int k0 = tk * 64, n0 = tn * 256;
  float4 v[8];
#pragma unroll
  for (int i = 0; i < 8; ++i) { const int r = (tid >> 6) + 8 * i, c4 = (tid & 63) * 4; v[i] = *(const float4*)(src + (size_t)(k0 + r) * N + n0 + c4); }
#pragma unroll
  for (int i = 0; i < 8; ++i) {
    const int r = (tid >> 6) + 8 * i, c4 = (tid & 63) * 4;
    const float sc = rowscale ? rowscale[k0 + r] : 1.f;
    tile[r * 257 + c4 + 0] = v[i].x * sc; tile[r * 257 + c4 + 1] = v[i].y * sc; tile[r * 257 + c4 + 2] = v[i].z * sc; tile[r * 257 + c4 + 3] = v[i].w * sc;
  }
  __syncthreads();
  const int n = tid >> 1, kh = (tid & 1) * 32;
  int drow = perm ? up_dst_row(n0 + n) : (n0 + n);
  if (permB) drow = perm32_row(drow);
#pragma unroll
  for (int q = 0; q < 4; ++q) {
    uint4 o;
    o.x = pack2(tile[(kh + 8 * q + 0) * 257 + n], tile[(kh + 8 * q + 1) * 257 + n]);
    o.y = pack2(tile[(kh + 8 * q + 2) * 257 + n], tile[(kh + 8 * q + 3) * 257 + n]);
    o.z = pack2(tile[(kh + 8 * q + 4) * 257 + n], tile[(kh + 8 * q + 5) * 257 + n]);
    o.w = pack2(tile[(kh + 8 * q + 6) * 257 + n], tile[(kh + 8 * q + 7) * 257 + n]);
    *(uint4*)(dst + (size_t)drow * K + k0 + kh + 8 * q) = o;
  }
  __syncthreads();
}

__device__ void transpose_any(const Params& p, int t, float* tile) {
  if (t < 160) transpose_big(p.w_in, p.Wt_in, 1024, 2560, t / 10, t % 10, nullptr, false, tile, true);
  else if (t < 176) { int u = t - 160; transpose_big(p.w_glu, p.Wt_glu, 512, 512, u / 2, u % 2, nullptr, false, tile, true); }
  else if (t < 240) { int u = t - 176; transpose_big(p.w_out, p.Wt_out, 1024, 1024, u / 4, u % 4, nullptr, false, tile, true); }
  else if (t < 592) { int u = t - 240; transpose_big(p.w_up, p.Wt_up, 1024, 5632, u / 22, u % 22, p.ffn_norm_g, true, tile); }
  else { int u = t - 592; transpose_big(p.w_down, p.Wt_down, 2816, 1024, u / 4, u % 4, nullptr, false, tile); }
}

__device__ void s5_tables_block(const Params& p, int bi, char* smem) {
  float* Cr = (float*)smem; float* Ci = Cr + 1024; float* Br = Ci + 1024; float* Bi = Br + 1024;
  float2* Pj = (float2*)(Bi + 1024);
  float2* PZ = Pj + 64;
  const int tid = otid();
  const int g = bi & 31, jb = bi >> 5;
  for (int i = tid; i < 1024; i += NTHR) { Cr[i] = p.c_re[g * 1024 + i]; Ci[i] = p.c_im[g * 1024 + i]; Br[i] = p.b_re[g * 1024 + i]; Bi[i] = p.b_im[g * 1024 + i]; }
  for (int jj = 0; jj < 3; ++jj) {
    const int j = jb + 8 * jj;
    if (j > 16) break;
    __syncthreads();
    if (tid < 64) {
      const int n = tid;
      const double dt = exp_d((double)p.log_dt[g]);
      const double ar = (double)p.a_re[g * 64 + n], ai = (double)p.a_im[g * 64 + n];
      double sj, cj, s1, c1;
      const double mj = exp_d((double)j * dt * ar); sincos_d((double)j * dt * ai, sj, cj);
      const double m1 = exp_d(dt * ar); sincos_d(dt * ai, s1, c1);
      const double pr = mj * cj, pi = mj * sj;
      const double nr = m1 * c1 - 1.0, ni = m1 * s1, den = ar * ar + ai * ai;
      const double zr = (nr * ar + ni * ai) / den, zi = (ni * ar - nr * ai) / den;
      Pj[n] = make_float2((float)pr, (float)pi);
      PZ[n] = make_float2((float)(pr * zr - pi * zi), (float)(pr * zi + pi * zr));
      if (j == 16) p.Pw[g * 64 + n] = make_float2((float)pr, (float)pi);
    }
    __syncthreads();
    if (j >= 1) {
      const int t = j - 1;
#pragma unroll
      for (int i = 0; i < 4; ++i) {
        const int idx = tid + 512 * i, pp = idx >> 7, np = idx & 127, n = np & 63, part = np >> 6;
        const float2 pw = Pj[n];
        const float cr = Cr[pp * 64 + n], ci = Ci[pp * 64 + n];
        const float v = part ? -(cr * pw.y + ci * pw.x) : (cr * pw.x - ci * pw.y);
        p.Etab[(size_t)(g * 256 + t * 16 + pp) * 128 + np] = f2bf(v);
      }
    }
    if (j <= 15) {
      const int sidx = 15 - j;
#pragma unroll
      for (int i = 0; i < 4; ++i) {
        const int idx = tid + 512 * i, np = idx >> 4, pq = idx & 15, n = np & 63, part = np >> 6;
        const float2 m = PZ[n];
        const float br = Br[n * 16 + pq], bi2 = Bi[n * 16 + pq];
        const float v = part ? (m.x * bi2 + m.y * br) : (m.x * br - m.y * bi2);
        p.Ftab[(size_t)(g * 128 + np) * 256 + sidx * 16 + pq] = f2bf(v);
      }
      if (tid < 256) {
        const int pp = tid >> 4, pq = tid & 15;
        float acc = 0.f;
#pragma unroll 8
        for (int n = 0; n < 64; ++n) {
          const float2 m = PZ[n];
          const float br = Br[n * 16 + pq], bi2 = Bi[n * 16 + pq];
          const float cr = Cr[pp * 64 + n], ci = Ci[pp * 64 + n];
          const float mr = m.x * br - m.y * bi2, mi = m.x * bi2 + m.y * br;
          acc += cr * mr - ci * mi;
        }
        p.Ktab[(size_t)((g * 16 + j) * 16 + pp) * 16 + pq] = f2bf(acc);
      }
    }
  }
  __syncthreads();
}

__device__ void phase_prep(const Params& p, char* smem) {
  float* tile = (float*)smem;
  const int tid = otid(), lane = tid & 63, wid = tid >> 6;
  const int gtid = blockIdx.x * NTHR + tid, gthr = gridDim.x * NTHR;
  for (int idx = gtid; idx < T; idx += gthr) { p.rsq1[idx] = 0.f; p.rsq2[idx] = 0.f; }
  const int ntr = (gridDim.x == 256) ? 160 : 768;
  for (int t = blockIdx.x; t < ntr; t += gridDim.x) transpose_any(p, t, tile);
  for (int t = blockIdx.x; t < 256; t += gridDim.x) s5_tables_block(p, t, smem);
}
__device__ void phase_prep_xn(const Params& p) {
  const int tid = otid(), lane = tid & 63, wid = tid >> 6;
  for (int row0 = (blockIdx.x * 8 + wid) * 8; row0 < T; row0 += gridDim.x * 64) {
    float4 v[8][4]; float ss[8];
#pragma unroll
    for (int r = 0; r < 8; ++r) {
      const float4* xr = (const float4*)(p.x + (size_t)(row0 + r) * 1024);
#pragma unroll
      for (int i = 0; i < 4; ++i) v[r][i] = xr[lane + 64 * i];
    }
#pragma unroll
    for (int r = 0; r < 8; ++r) {
      float a = 0.f;
#pragma unroll
      for (int i = 0; i < 4; ++i) a += v[r][i].x * v[r][i].x + v[r][i].y * v[r][i].y + v[r][i].z * v[r][i].z + v[r][i].w * v[r][i].w;
#pragma unroll
      for (int o = 32; o >= 1; o >>= 1) a += __shfl_xor(a, o);
      ss[r] = rsqrtf(a * (1.f / 1024.f) + 1e-6f);
    }
#pragma unroll
    for (int i = 0; i < 4; ++i) {
      const float4 g = ((const float4*)p.in_norm_g)[lane + 64 * i];
#pragma unroll
      for (int r = 0; r < 8; ++r) {
        uint2 o; o.x = pack2(v[r][i].x * ss[r] * g.x, v[r][i].y * ss[r] * g.y); o.y = pack2(v[r][i].z * ss[r] * g.z, v[r][i].w * ss[r] * g.w);
        *(uint2*)(p.xn + (size_t)(row0 + r) * 1024 + (lane + 64 * i) * 4) = o;
      }
    }
  }
}

struct TileMap {
  int nM, nN, nwg;
  __device__ void init(int M, int N) { nM = M / 256; nN = N / 256; nwg = nM * nN; }
  __device__ void get(int L, int& pm, int& pn) const {
    int wgid = L;
    { const int q = nwg / 8, r = nwg % 8, xcd = wgid % 8, off = wgid / 8; wgid = (xcd < r ? xcd * (q + 1) : r * (q + 1) + (xcd - r) * q) + off; }
    const int nig = 8 * nN, gid = wgid / nig, fm = gid * 8, gsz = (nM - fm) < 8 ? (nM - fm) : 8;
    pm = fm + ((wgid % nig) % gsz); pn = (wgid % nig) / gsz;
  }
};

#define LAS __attribute__((address_space(3)))
constexpr int G_BK = 64, G_HALF = 128, G_HTB = G_HALF * G_BK * 2;
__device__ __forceinline__ int lds_byte(int r, int c) {
  const int st = (r >> 4) * 2 + (c >> 5), rr = r & 15, cc = c & 31, ob = rr * 64 + cc * 2;
  return st * 1024 + (ob ^ (((ob >> 9) & 1) << 5));
}
__device__ __forceinline__ void stage_rc(int b, int& R, int& C) {
  const int st = b / 1024, sb = b % 1024, swz = sb ^ (((sb >> 9) & 1) << 5);
  R = (st >> 1) * 16 + swz / 64; C = (st & 1) * 32 + (swz % 64) / 2;
}

struct RowMapLinear { static constexpr bool PERMA = false, GMAJ = false; __device__ __forceinline__ long operator()(int pm) const { return (long)pm * 256; } };
struct RowMapGroupMajor { static constexpr bool PERMA = false, GMAJ = true; __device__ __forceinline__ long operator()(int pm) const { return (long)pm * 256; } };
struct RowMapConv { static constexpr bool PERMA = true, GMAJ = false; __device__ __forceinline__ long operator()(int pm) const { return (long)(pm / 17) * 4096 + 254 * (pm % 17) - 2; } };

template <class Epi, class RowMap = RowMapLinear>
__device__ __forceinline__ void gemm_phase(const bf16_t* __restrict__ A, const bf16_t* __restrict__ Bt, int M, int N, int K,
                                           const Epi& E, char* smem, const RowMap rmap = RowMap()) {
  LAS unsigned char* lds = (LAS unsigned char*)smem;
  const int tid = otid(), wid = __builtin_amdgcn_readfirstlane(tid >> 6), lane = tid & 63, wr = wid >> 2, wc = wid & 3, fr = lane & 15, fq = lane >> 4;
  const int nt = K / G_BK;
  TileMap tm; tm.init(M, N);
  if ((int)blockIdx.x >= tm.nwg) return;
  unsigned voffA[2], voffB[2];
#pragma unroll
  for (int i = 0; i < 2; ++i) {
    int R, C; stage_rc(tid * 16 + i * 8192, R, C);
    voffB[i] = (unsigned)(R * K + C) * 2u;
    const int Ra = RowMap::PERMA ? ((R & ~63) + 4 * (R & 15) + ((R >> 4) & 3)) : R;
    voffA[i] = RowMap::GMAJ ? (unsigned)((((C >> 4) * M + Ra) * 16 + (C & 15)) * 2) : (unsigned)(Ra * K + C) * 2u;
  }
  const size_t kstep = (size_t)(G_BK * 2);
  const size_t kstepA = RowMap::GMAJ ? (size_t)4 * M * 32 : kstep;
  const size_t hstepA = RowMap::GMAJ ? (size_t)G_HALF * 32 : (size_t)G_HALF * K * 2;
  const size_t hstep = (size_t)G_HALF * K * 2;
  const size_t tstep = 2 * hstep;
  const unsigned ldsw = (unsigned)wid * 1024u;
  const int aoff = lds_byte(wr * 64 + fr, fq * 8), boff = lds_byte(wc * 32 + fr, fq * 8);
#define PG8_SA(b, h) (((b) * 2 + (h)) * G_HTB)
#define PG8_SB(b, h) ((4 + (b) * 2 + (h)) * G_HTB)
#define PG8_STAGE(bufoff, gbase, voff) do { _Pragma("unroll") for (int _i = 0; _i < 2; ++_i) \
    __builtin_amdgcn_global_load_lds((const unsigned*)((const char*)(gbase) + (voff)[_i]), (LAS unsigned*)(lds + (bufoff) + ldsw + _i * 8192), 16, 0, 0); } while (0)
#define PG8_LDA(dst, b, h) do { _Pragma("unroll") for (int m = 0; m < 4; ++m) _Pragma("unroll") for (int k = 0; k < 2; ++k) dst[m][k] = *(const LAS bf16x8*)(lds + PG8_SA(b, h) + aoff + m * 2048 + k * 1024); } while (0)
#define PG8_LDB(dst, b, h) do { _Pragma("unroll") for (int n = 0; n < 2; ++n) _Pragma("unroll") for (int k = 0; k < 2; ++k) dst[n][k] = *(const LAS bf16x8*)(lds + PG8_SB(b, h) + boff + n * 2048 + k * 1024); } while (0)
#define PG8_MMA(ai, bj, At_, Bt_) do { __builtin_amdgcn_s_setprio(1); _Pragma("unroll") for (int m = 0; m < 4; ++m) _Pragma("unroll") for (int n = 0; n < 2; ++n) _Pragma("unroll") for (int k = 0; k < 2; ++k) \
    acc[ai][bj][m][n] = __builtin_amdgcn_mfma_f32_16x16x32_bf16(Bt_[n][k], At_[m][k], acc[ai][bj][m][n], 0, 0, 0); __builtin_amdgcn_s_setprio(0); } while (0)
#define PG8_WAIT_V(n) asm volatile("s_waitcnt vmcnt(" #n ")" ::: "memory")
#define PG8_WAIT_L(n) asm volatile("s_waitcnt lgkmcnt(" #n ")" ::: "memory")
#define PG8_BAR __builtin_amdgcn_s_barrier()
#define PG8_SCHED __builtin_amdgcn_sched_barrier(0)
  int pm, pn, npm = 0, npn = 0, ui = 0;
  tm.get((int)blockIdx.x, pm, pn);
  f32x4 acc[2][2][4][2];
#pragma unroll
  for (int a = 0; a < 2; ++a)
#pragma unroll
    for (int b = 0; b < 2; ++b)
#pragma unroll
      for (int m = 0; m < 4; ++m)
#pragma unroll
        for (int n = 0; n < 2; ++n) acc[a][b][m][n] = (f32x4){0.f, 0.f, 0.f, 0.f};
  bf16x8 At[4][2], B0[2][2], B1[2][2];
  const size_t rstep = RowMap::GMAJ ? (size_t)32 : (size_t)K * 2;
  const char* cA = (const char*)A + rmap(pm) * (long)rstep; const char* cB = (const char*)Bt + (size_t)pn * tstep;
  PG8_WAIT_V(0); __syncthreads();
  PG8_STAGE(PG8_SB(0, 0), cB, voffB); PG8_STAGE(PG8_SA(0, 0), cA, voffA); PG8_STAGE(PG8_SB(0, 1), cB + hstep, voffB); PG8_STAGE(PG8_SA(0, 1), cA + hstepA, voffA);
  if (wr == 1) PG8_BAR;
  PG8_WAIT_V(4); PG8_BAR;
  PG8_STAGE(PG8_SB(1, 0), cB + kstep, voffB); PG8_STAGE(PG8_SA(1, 0), cA + kstepA, voffA); PG8_STAGE(PG8_SB(1, 1), cB + hstep + kstep, voffB);
  PG8_WAIT_V(6); PG8_BAR;
  for (;;) {
    const int Ln = (ui + 1) * (int)gridDim.x + (int)blockIdx.x;
    const bool has_next = Ln < tm.nwg;
    if (has_next) tm.get(Ln, npm, npn);
    const char* nA = has_next ? (const char*)A + rmap(npm) * (long)rstep : cA; const char* nB = has_next ? (const char*)Bt + (size_t)npn * tstep : cB;
    for (int t = 0; t < nt; t += 2) {
      const bool last = (t == nt - 2);
      const char* a1 = cA + (size_t)(t + 1) * kstepA;
      const char* a2 = last ? nA : cA + (size_t)(t + 2) * kstepA; const char* b2 = last ? nB : cB + (size_t)(t + 2) * kstep;
      const char* a3 = a2 + kstepA; const char* b3 = b2 + kstep;
      PG8_LDB(B0, 0, 0); PG8_SCHED; PG8_LDA(At, 0, 0); PG8_STAGE(PG8_SA(1, 1), a1 + hstepA, voffA);
      PG8_WAIT_L(8); PG8_BAR; PG8_WAIT_L(0); PG8_MMA(0, 0, At, B0); PG8_BAR; PG8_SCHED;
      PG8_LDB(B1, 0, 1); PG8_STAGE(PG8_SB(0, 0), b2, voffB);
      PG8_BAR; PG8_WAIT_L(0); PG8_MMA(0, 1, At, B1); PG8_BAR;
      PG8_LDA(At, 0, 1); PG8_STAGE(PG8_SA(0, 0), a2, voffA);
      PG8_BAR; PG8_WAIT_L(0); PG8_MMA(1, 0, At, B0); PG8_BAR; PG8_SCHED;
      PG8_STAGE(PG8_SB(0, 1), b2 + hstep, voffB);
      PG8_WAIT_V(6); PG8_BAR; PG8_MMA(1, 1, At, B1); PG8_BAR;
      PG8_LDB(B0, 1, 0); PG8_SCHED; PG8_LDA(At, 1, 0); PG8_STAGE(PG8_SA(0, 1), a2 + hstepA, voffA);
      PG8_WAIT_L(8); PG8_BAR; PG8_WAIT_L(0); PG8_MMA(0, 0, At, B0); PG8_BAR; PG8_SCHED;
      PG8_LDB(B1, 1, 1); PG8_STAGE(PG8_SB(1, 0), b3, voffB);
      PG8_BAR; PG8_WAIT_L(0); PG8_MMA(0, 1, At, B1); PG8_BAR;
      PG8_LDA(At, 1, 1); PG8_STAGE(PG8_SA(1, 0), a3, voffA);
      PG8_BAR; PG8_WAIT_L(0); PG8_MMA(1, 0, At, B0); PG8_BAR; PG8_SCHED;
      PG8_STAGE(PG8_SB(1, 1), b3 + hstep, voffB);
      PG8_WAIT_V(6); PG8_BAR; PG8_MMA(1, 1, At, B1); PG8_BAR;
    }
    E(acc, pm, pn, wr, wc, fr, fq);
    if (!has_next) break;
#pragma unroll
    for (int a = 0; a < 2; ++a)
#pragma unroll
      for (int b = 0; b < 2; ++b)
#pragma unroll
        for (int m = 0; m < 4; ++m)
#pragma unroll
          for (int n = 0; n < 2; ++n) acc[a][b][m][n] = (f32x4){0.f, 0.f, 0.f, 0.f};
    pm = npm; pn = npn; cA = nA; cB = nB; ++ui;
  }
  PG8_WAIT_V(0);
  if (wr == 0) PG8_BAR;
  PG8_BAR;
#undef PG8_SA
#undef PG8_SB
#undef PG8_STAGE
#undef PG8_LDA
#undef PG8_LDB
#undef PG8_MMA
#undef PG8_WAIT_V
#undef PG8_WAIT_L
#undef PG8_BAR
#undef PG8_SCHED
}

#define PROBE_STAMP_ONCE(k, base) do { if (PROBE_K == (k) && threadIdx.x == 0) { volatile LAS unsigned long long* _s = (volatile LAS unsigned long long*)((LAS unsigned char*)(base) - 8); \
    if (*_s == 0ull) *_s = __builtin_amdgcn_s_memrealtime(); } } while (0)
struct EpiProj {
  bf16_t* proj; bf16_t* ubuf; _Float16* lgf; const float* hg_lb;
  __device__ __forceinline__ void operator()(const f32x4 (&acc)[2][2][4][2], int pm, int pn, int wr, int wc, int fr, int fq) const {
    const int sec = pn >> 1;
    if (sec == 1) {
#pragma unroll
      for (int b = 0; b < 2; ++b) {
        const int c8 = 256 * pn + 128 * b + 32 * wc + 8 * fq;
        float lb[8];
#pragma unroll
        for (int n = 0; n < 2; ++n) {
          const float4 h0 = *(const float4*)(hg_lb + (c8 - 512) + 4 * n), h1 = *(const float4*)(hg_lb + c8 + 4 * n);
          lb[4 * n + 0] = __builtin_amdgcn_rcpf(1.f + __expf(h1.x - h0.x)); lb[4 * n + 1] = __builtin_amdgcn_rcpf(1.f + __expf(h1.y - h0.y));
          lb[4 * n + 2] = __builtin_amdgcn_rcpf(1.f + __expf(h1.z - h0.z)); lb[4 * n + 3] = __builtin_amdgcn_rcpf(1.f + __expf(h1.w - h0.w));
        }
#pragma unroll
        for (int a = 0; a < 2; ++a)
#pragma unroll
          for (int m = 0; m < 4; ++m) {
            const int row = 256 * pm + 128 * a + 64 * wr + 16 * m + fr;
            typedef _Float16 f16x8 __attribute__((ext_vector_type(8)));
            f16x8 lh; float kk[8];
#pragma unroll
            for (int n = 0; n < 2; ++n)
#pragma unroll
              for (int r = 0; r < 4; ++r) {
                const float l = lb[4 * n + r], x = acc[a][b][m][n][r];
                const float sg = __builtin_amdgcn_rcpf(1.f + __expf(-x));
                lh[4 * n + r] = (_Float16)__logf(l + (1.f - l) * sg);
                kk[4 * n + r] = (1.f - l) * __builtin_amdgcn_rcpf(1.f + __expf(x));
              }
            *(f16x8*)(lgf + (size_t)row * 512 + (c8 - 512)) = lh;
            *(uint4*)(proj + (size_t)row * 2048 + c8) = make_uint4(pack2(kk[0], kk[1]), pack2(kk[2], kk[3]), pack2(kk[4], kk[5]), pack2(kk[6], kk[7]));
          }
      }
    } else {
#pragma unroll
      for (int a = 0; a < 2; ++a)
#pragma unroll
        for (int m = 0; m < 4; ++m) {
          const int row = 256 * pm + 128 * a + 64 * wr + 16 * m + fr;
#pragma unroll
          for (int b = 0; b < 2; ++b) {
            const int c8 = 256 * pn + 128 * b + 32 * wc + 8 * fq;
            const f32x4 v0 = acc[a][b][m][0], v1 = acc[a][b][m][1];
            const uint4 o = make_uint4(pack2(v0[0], v0[1]), pack2(v0[2], v0[3]), pack2(v1[0], v1[1]), pack2(v1[2], v1[3]));
            if (sec == 4) *(uint4*)(ubuf + ((size_t)((c8 - 2048) >> 4) * T + row) * 16 + (c8 & 15)) = o;
            else *(uint4*)(proj + (size_t)row * 2048 + c8) = o;
          }
        }
    }
  }
};

struct EpiGlu {
  const bf16_t* ybuf; const float* b_glu; bf16_t* mix;
  __device__ __forceinline__ void operator()(const f32x4 (&acc)[2][2][4][2], int pm, int pn, int wr, int wc, int fr, int fq) const {
#pragma unroll
    for (int a = 0; a < 2; ++a)
#pragma unroll
      for (int m = 0; m < 4; ++m) {
        const int row = 256 * pm + 128 * a + 64 * wr + 16 * m + fr;
#pragma unroll
        for (int b = 0; b < 2; ++b) {
          const int c8 = 256 * pn + 128 * b + 32 * wc + 8 * fq;
          const f32x4 v0 = acc[a][b][m][0], v1 = acc[a][b][m][1];
          const float4 b0 = *(const float4*)(b_glu + c8), b1 = *(const float4*)(b_glu + c8 + 4);
          const uint4 yw = *(const uint4*)(ybuf + ((size_t)(c8 >> 4) * T + row) * 16 + (c8 & 15));
          const float o0 = lo2f(yw.x) * sigm(v0[0] + b0.x), o1 = hi2f(yw.x) * sigm(v0[1] + b0.y), o2 = lo2f(yw.y) * sigm(v0[2] + b0.z), o3 = hi2f(yw.y) * sigm(v0[3] + b0.w);
          const float o4 = lo2f(yw.z) * sigm(v1[0] + b1.x), o5 = hi2f(yw.z) * sigm(v1[1] + b1.y), o6 = lo2f(yw.w) * sigm(v1[2] + b1.z), o7 = hi2f(yw.w) * sigm(v1[3] + b1.w);
          *(uint4*)(mix + (size_t)row * 1024 + 512 + c8) = make_uint4(pack2(o0, o1), pack2(o2, o3), pack2(o4, o5), pack2(o6, o7));
        }
      }
  }
};

typedef unsigned u32x2 __attribute__((ext_vector_type(2)));
__device__ __forceinline__ void st_nt8(void* p, unsigned a, unsigned b) { u32x2 v; v.x = a; v.y = b; __builtin_nontemporal_store(v, (u32x2*)p); }
__device__ __forceinline__ void st_nt16(void* p, f32x4 v) { __builtin_nontemporal_store(v, (f32x4*)p); }

struct EpiOut {
  const float* x; bf16_t* hb; float* rsq;
  __device__ __forceinline__ void operator()(const f32x4 (&acc)[2][2][4][2], int pm, int pn, int wr, int wc, int fr, int fq) const {
#pragma unroll
    for (int a = 0; a < 2; ++a)
#pragma unroll
      for (int m = 0; m < 4; ++m) {
        const int row = 256 * pm + 128 * a + 64 * wr + 16 * m + fr;
        float ss = 0.f;
#pragma unroll
        for (int b = 0; b < 2; ++b) {
          const int c8 = 256 * pn + 128 * b + 32 * wc + 8 * fq;
          const f32x4 v0 = acc[a][b][m][0], v1 = acc[a][b][m][1];
          const float4 x0 = *(const float4*)(x + (size_t)row * 1024 + c8), x1 = *(const float4*)(x + (size_t)row * 1024 + c8 + 4);
          const float h0 = x0.x + v0[0], h1 = x0.y + v0[1], h2 = x0.z + v0[2], h3 = x0.w + v0[3];
          const float h4 = x1.x + v1[0], h5 = x1.y + v1[1], h6 = x1.z + v1[2], h7 = x1.w + v1[3];
          *(uint4*)(hb + (size_t)row * 1024 + c8) = make_uint4(pack2(h0, h1), pack2(h2, h3), pack2(h4, h5), pack2(h6, h7));
          ss += (h0 * h0 + h1 * h1) + (h2 * h2 + h3 * h3) + (h4 * h4 + h5 * h5) + (h6 * h6 + h7 * h7);
        }
        ss += __shfl_xor(ss, 16); ss += __shfl_xor(ss, 32);
        if (fq == 0) unsafeAtomicAdd(rsq + row, ss);
      }
  }
};

template <int CTRL> __device__ __forceinline__ float dpp_upd(float old, float src) {
  return __int_as_float(__builtin_amdgcn_update_dpp(__float_as_int(old), __float_as_int(src), CTRL, 0xf, 0xf, false));
}
struct EpiUpConv {
  bf16_t* act; const float* rsq; const float* conv_w; const float* conv_b; LAS float* xb;
  __device__ __forceinline__ void operator()(f32x4 (&acc)[2][2][4][2], int pm, int pn, int wr, int wc, int fr, int fq) const {
    PROBE_STAMP_ONCE(31, xb);
    const int seq = pm / 17, it = pm - seq * 17, l0 = 254 * it - 2;
#pragma unroll
    for (int a = 0; a < 2; ++a)
#pragma unroll
      for (int m = 0; m < 4; ++m) {
        const int l = l0 + 128 * a + 64 * wr + 4 * fr + m;
        int tok = seq * 4096 + l; tok = tok < 0 ? 0 : (tok > T - 1 ? T - 1 : tok);
        float rstd = rsqrtf(rsq[tok] * (1.f / 1024.f) + 1e-6f);
#pragma unroll
        for (int b = 0; b < 2; ++b)
#pragma unroll
          for (int n = 0; n < 2; ++n) {
            f32x4 v = acc[a][b][m][n] * rstd;
            if (a == 0 && m < 2 && l < 0) v = (f32x4){0.f, 0.f, 0.f, 0.f};
            acc[a][b][m][n] = v;
          }
      }
    if (fr == 15) {
#pragma unroll
      for (int a = 0; a < 2; ++a) {
        const int bd = 2 * a + wr;
        if (bd < 3) {
#pragma unroll
          for (int q = 0; q < 2; ++q)
#pragma unroll
            for (int b = 0; b < 2; ++b)
#pragma unroll
              for (int n = 0; n < 2; ++n) *(LAS f32x4*)(xb + ((bd * 2 + q) * 2 + b) * 128 + 32 * wc + 16 * n + 4 * fq) = acc[a][b][2 + q][n];
        }
      }
    }
    asm volatile("s_waitcnt lgkmcnt(0)" ::: "memory");
    __builtin_amdgcn_s_barrier(); asm volatile("" ::: "memory");
    __builtin_amdgcn_s_barrier(); asm volatile("" ::: "memory");
#pragma unroll
    for (int n = 0; n < 2; ++n) {
      const int c = pn * 128 + 32 * wc + 16 * n + 4 * fq;
      const f32x4 wg0 = *(const f32x4*)(conv_w + c), wg1 = *(const f32x4*)(conv_w + 5632 + c), wg2 = *(const f32x4*)(conv_w + 2 * 5632 + c);
      const f32x4 wv0 = *(const f32x4*)(conv_w + 2816 + c), wv1 = *(const f32x4*)(conv_w + 5632 + 2816 + c), wv2 = *(const f32x4*)(conv_w + 2 * 5632 + 2816 + c);
      const f32x4 bg = *(const f32x4*)(conv_b + c), bv = *(const f32x4*)(conv_b + 2816 + c);
#pragma unroll
      for (int a = 0; a < 2; ++a) {
        const int bdp = 2 * a + wr - 1;
        f32x4 g2b = (f32x4){0.f, 0.f, 0.f, 0.f}, g1b = g2b, v2b = g2b, v1b = g2b;
        if (bdp >= 0 && fr == 0) {
          g2b = *(const LAS f32x4*)(xb + ((bdp * 2 + 0) * 2 + 0) * 128 + 32 * wc + 16 * n + 4 * fq);
          v2b = *(const LAS f32x4*)(xb + ((bdp * 2 + 0) * 2 + 1) * 128 + 32 * wc + 16 * n + 4 * fq);
          g1b = *(const LAS f32x4*)(xb + ((bdp * 2 + 1) * 2 + 0) * 128 + 32 * wc + 16 * n + 4 * fq);
          v1b = *(const LAS f32x4*)(xb + ((bdp * 2 + 1) * 2 + 1) * 128 + 32 * wc + 16 * n + 4 * fq);
        }
        f32x4 pg3, pg2, pv3, pv2;
#pragma unroll
        for (int r = 0; r < 4; ++r) {
          pg3[r] = dpp_upd<0x111>(g1b[r], acc[a][0][3][n][r]); pg2[r] = dpp_upd<0x111>(g2b[r], acc[a][0][2][n][r]);
          pv3[r] = dpp_upd<0x111>(v1b[r], acc[a][1][3][n][r]); pv2[r] = dpp_upd<0x111>(v2b[r], acc[a][1][2][n][r]);
        }
#pragma unroll
        for (int m = 0; m < 4; ++m) {
          const f32x4 cg = acc[a][0][m][n], cv = acc[a][1][m][n];
          const f32x4 s1g = m == 0 ? pg3 : acc[a][0][m == 0 ? 0 : m - 1][n], s2g = m == 0 ? pg2 : (m == 1 ? pg3 : acc[a][0][m < 2 ? 0 : m - 2][n]);
          const f32x4 s1v = m == 0 ? pv3 : acc[a][1][m == 0 ? 0 : m - 1][n], s2v = m == 0 ? pv2 : (m == 1 ? pv3 : acc[a][1][m < 2 ? 0 : m - 2][n]);
          const f32x4 G = bg + wg0 * s2g + wg1 * s1g + wg2 * cg;
          const f32x4 V = bv + wv0 * s2v + wv1 * s1v + wv2 * cv;
          const int rr = 128 * a + 64 * wr + 4 * fr + m, l = l0 + rr;
          if (rr >= 2 && l < 4096) {
            uint2 ow; ow.x = pack2(G[0] * sigm(G[0]) * V[0], G[1] * sigm(G[1]) * V[1]); ow.y = pack2(G[2] * sigm(G[2]) * V[2], G[3] * sigm(G[3]) * V[3]);
            *(uint2*)(act + (size_t)(seq * 4096 + l) * 2816 + c) = ow;
          }
        }
      }
    }
    PROBE_STAMP_ONCE(32, xb);
  }
};

struct EpiDown {
  float* out; const bf16_t* hb; float* rsq; unsigned* cnt; const float* g; LAS float* red; bool fused;
  __device__ __forceinline__ void operator()(f32x4 (&acc)[2][2][4][2], int pm, int pn, int wr, int wc, int fr, int fq) const {
    PROBE_STAMP_ONCE(30, red);
#pragma unroll
    for (int a = 0; a < 2; ++a)
#pragma unroll
      for (int m = 0; m < 4; ++m) {
        const int row = 256 * pm + 128 * a + 64 * wr + 16 * m + fr;
        float ss = 0.f;
#pragma unroll
        for (int b = 0; b < 2; ++b)
#pragma unroll
          for (int n = 0; n < 2; ++n) {
            const int col = 256 * pn + 128 * b + 32 * wc + 16 * n + 4 * fq;
            const uint2 hw = *(const uint2*)(hb + (size_t)row * 1024 + col);
            f32x4 v = acc[a][b][m][n];
            v[0] += lo2f(hw.x); v[1] += hi2f(hw.x); v[2] += lo2f(hw.y); v[3] += hi2f(hw.y);
            acc[a][b][m][n] = v;
            ss += v[0] * v[0] + v[1] * v[1] + v[2] * v[2] + v[3] * v[3];
          }
        ss += __shfl_xor(ss, 16); ss += __shfl_xor(ss, 32);
        if (fused) { if (fq == 0) red[(128 * a + 64 * wr + 16 * m + fr) * 4 + wc] = ss; }
        else if (fq == 0) unsafeAtomicAdd(rsq + row, ss);
      }
    if (!fused) {
#pragma unroll
      for (int a = 0; a < 2; ++a)
#pragma unroll
        for (int m = 0; m < 4; ++m) {
          const int row = 256 * pm + 128 * a + 64 * wr + 16 * m + fr;
#pragma unroll
          for (int b = 0; b < 2; ++b)
#pragma unroll
            for (int n = 0; n < 2; ++n) {
              const int col = 256 * pn + 128 * b + 32 * wc + 16 * n + 4 * fq;
              const f32x4 v = acc[a][b][m][n];
              *(float4*)(out + (size_t)row * 1024 + col) = make_float4(v[0], v[1], v[2], v[3]);
            }
        }
      return;
    }
    asm volatile("s_waitcnt lgkmcnt(0)" ::: "memory");
    __builtin_amdgcn_s_barrier(); asm volatile("" ::: "memory");
    __builtin_amdgcn_s_barrier(); asm volatile("" ::: "memory");
    const int wid = wr * 4 + wc, lane = fq * 16 + fr;
    unsigned* c = cnt + pm * 64;
    if (wid < 4) {
      const int r = wid * 64 + lane;
      const f32x4 q = *(const LAS f32x4*)(red + r * 4);
      const float old = unsafeAtomicAdd(rsq + 256 * pm + r, (q[0] + q[1]) + (q[2] + q[3]));
      asm volatile("s_waitcnt vmcnt(0)" :: "v"(old) : "memory");
      if (lane == 0) __hip_atomic_fetch_add(c, 1u, __ATOMIC_RELAXED, __HIP_MEMORY_SCOPE_AGENT);
    }
    {
      unsigned spins = 0;
      while ((unsigned)__builtin_amdgcn_readfirstlane((int)__hip_atomic_load(c, __ATOMIC_RELAXED, __HIP_MEMORY_SCOPE_AGENT)) < 16u) {
        __builtin_amdgcn_s_sleep(2);
        if (++spins > (1u << 22)) break;
      }
    }
#pragma unroll
    for (int a = 0; a < 2; ++a)
#pragma unroll
      for (int m = 0; m < 4; ++m) {
        const int row = 256 * pm + 128 * a + 64 * wr + 16 * m + fr;
        const float rstd = rsqrtf(__hip_atomic_load(rsq + row, __ATOMIC_RELAXED, __HIP_MEMORY_SCOPE_AGENT) * (1.f / 1024.f) + 1e-6f);
#pragma unroll
        for (int b = 0; b < 2; ++b)
#pragma unroll
          for (int n = 0; n < 2; ++n) {
            const int col = 256 * pn + 128 * b + 32 * wc + 16 * n + 4 * fq;
            const float4 gv = *(const float4*)(g + col);
            const f32x4 v = acc[a][b][m][n];
            st_nt16(out + (size_t)row * 1024 + col, (f32x4){v[0] * rstd * gv.x, v[1] * rstd * gv.y, v[2] * rstd * gv.z, v[3] * rstd * gv.w});
          }
      }
  }
};

__device__ void hg_a_item(const Params& p, int item, char* smem) {
  bf16_t* kT = (bf16_t*)smem;
  bf16_t* vT = kT + 128 * 72;
  float* tot = (float*)(vT + 128 * 72);
  const int tid = otid(), lane = tid & 63, wid = tid >> 6, fr = lane & 15, fq = lane >> 4;
  const int b = item >> 8, h = (item >> 6) & 3, n = item & 63;
  const int t0 = b * 4096 + n * 64;
  const int k = tid & 127, seg = tid >> 7;
  float bc[16]; bf16_t kr[16], vr[16];
  {
    const _Float16* lp = p.logf + (size_t)(t0 + seg * 16) * 512 + h * 128 + k;
    const bf16_t* kp = p.proj + (size_t)(t0 + seg * 16) * 2048 + 512 + h * 128 + k;
#pragma unroll
    for (int i = 0; i < 16; ++i) { bc[i] = (float)lp[(size_t)i * 512]; kr[i] = kp[(size_t)i * 2048]; vr[i] = kp[(size_t)i * 2048 + 512]; }
    float a = 0.f;
#pragma unroll
    for (int i = 0; i < 16; ++i) { a += bc[i]; bc[i] = a; }
    tot[seg * 128 + k] = a;
  }
  __syncthreads();
  float pre = 0.f, all = 0.f;
#pragma unroll
  for (int s4 = 0; s4 < 4; ++s4) { float tv = tot[s4 * 128 + k]; if (s4 < seg) pre += tv; all += tv; }
  unsigned kw[8], vw[8];
#pragma unroll
  for (int i = 0; i < 8; ++i) {
    float k0 = bf2f(kr[2 * i]) * __expf(all - (bc[2 * i] + pre));
    float k1 = bf2f(kr[2 * i + 1]) * __expf(all - (bc[2 * i + 1] + pre));
    kw[i] = pack2(k0, k1);
    vw[i] = (unsigned)vr[2 * i] | ((unsigned)vr[2 * i + 1] << 16);
  }
  *(uint4*)(kT + k * 72 + seg * 16) = make_uint4(kw[0], kw[1], kw[2], kw[3]);
  *(uint4*)(kT + k * 72 + seg * 16 + 8) = make_uint4(kw[4], kw[5], kw[6], kw[7]);
  *(uint4*)(vT + k * 72 + seg * 16) = make_uint4(vw[0], vw[1], vw[2], vw[3]);
  *(uint4*)(vT + k * 72 + seg * 16 + 8) = make_uint4(vw[4], vw[5], vw[6], vw[7]);
  if (seg == 0) p.decay[(size_t)item * 128 + k] = __expf(all);
  __syncthreads();
  bf16x8 af[2];
#pragma unroll
  for (int ks = 0; ks < 2; ++ks) af[ks] = *(const bf16x8*)(kT + (16 * wid + fr) * 72 + 32 * ks + 8 * fq);
#pragma unroll
  for (int j = 0; j < 8; ++j) {
    f32x4 acc = (f32x4){0.f, 0.f, 0.f, 0.f};
#pragma unroll
    for (int ks = 0; ks < 2; ++ks) {
      bf16x8 bfr = *(const bf16x8*)(vT + (16 * j + fr) * 72 + 32 * ks + 8 * fq);
      acc = __builtin_amdgcn_mfma_f32_16x16x32_bf16(af[ks], bfr, acc, 0, 0, 0);
    }
    *(uint2*)(p.dstate + (size_t)item * 16384 + (16 * j + fr) * 128 + 16 * wid + 4 * fq) = make_uint2(pack2(acc[0], acc[1]), pack2(acc[2], acc[3]));
  }
  __syncthreads();
}

__device__ void hg_c_item(const Params& p, int item, char* smem) {
  bf16_t* qd = (bf16_t*)smem;
  bf16_t* kd = qd + 64 * 136;
  bf16_t* vT = kd + 64 * 136;
  bf16_t* att = vT + 128 * 72;
  float* tot = (float*)(att + 64 * 72);
  float* ssq = tot + 512;
  const int tid = otid(), lane = tid & 63, wid = tid >> 6, fr = lane & 15, fq = lane >> 4;
  const int b = item >> 8, h = (item >> 6) & 3, n = item & 63;
  const int t0 = b * 4096 + n * 64;
  const int k = tid & 127, seg = tid >> 7;
  const int rt = wid & 3, hh = wid >> 2;
  const int token = t0 + 16 * rt + fr;
  float bc[16]; bf16_t qr[16], kr[16], vr[16];
  uint2 gw[4]; float4 g4[4];
  {
    const _Float16* lp = p.logf + (size_t)(t0 + seg * 16) * 512 + h * 128 + k;
    const bf16_t* qp = p.proj + (size_t)(t0 + seg * 16) * 2048 + h * 128 + k;
#pragma unroll
    for (int i = 0; i < 16; ++i) { bc[i] = (float)lp[(size_t)i * 512]; qr[i] = qp[(size_t)i * 2048]; kr[i] = qp[(size_t)i * 2048 + 512]; vr[i] = qp[(size_t)i * 2048 + 1024]; }
#pragma unroll
    for (int j = 0; j < 4; ++j) {
      const int col = h * 128 + 16 * (4 * hh + j) + 4 * fq;
      gw[j] = *(const uint2*)(p.proj + (size_t)token * 2048 + 1536 + col);
      g4[j] = *(const float4*)(p.hg_norm_g + col);
    }
    float a = 0.f;
#pragma unroll
    for (int i = 0; i < 16; ++i) { a += bc[i]; bc[i] = a; }
    tot[seg * 128 + k] = a;
  }
  __syncthreads();
  const bf16_t* sp = p.sstart + (size_t)item * 16384;
  bf16x8 sf[4][4];
#pragma unroll
  for (int ks = 0; ks < 4; ++ks)
#pragma unroll
    for (int j = 0; j < 4; ++j) sf[ks][j] = *(const bf16x8*)(sp + (16 * (4 * hh + j) + fr) * 128 + 32 * ks + 8 * fq);
  float pre = 0.f;
#pragma unroll
  for (int s4 = 0; s4 < 4; ++s4) { float tv = tot[s4 * 128 + k]; if (s4 < seg) pre += tv; }
  unsigned vw[8];
#pragma unroll
  for (int i = 0; i < 16; ++i) {
    float bb = bc[i] + pre;
    qd[(seg * 16 + i) * 136 + k] = f2bf(bf2f(qr[i]) * __expf(bb));
    kd[(seg * 16 + i) * 136 + k] = f2bf(bf2f(kr[i]) * __expf(-bb));
    unsigned vv = (unsigned)vr[i];
    if (i & 1) vw[i >> 1] |= vv << 16; else vw[i >> 1] = vv;
  }
  *(uint4*)(vT + k * 72 + seg * 16) = make_uint4(vw[0], vw[1], vw[2], vw[3]);
  *(uint4*)(vT + k * 72 + seg * 16 + 8) = make_uint4(vw[4], vw[5], vw[6], vw[7]);
  __syncthreads();
#pragma unroll
  for (int st2 = 0; st2 < 2; ++st2) {
    const int st = 2 * hh + st2;
    f32x4 acc = (f32x4){0.f, 0.f, 0.f, 0.f};
#pragma unroll
    for (int ks = 0; ks < 4; ++ks) {
      bf16x8 a = *(const bf16x8*)(kd + (16 * st + fr) * 136 + 32 * ks + 8 * fq);
      bf16x8 bq = *(const bf16x8*)(qd + (16 * rt + fr) * 136 + 32 * ks + 8 * fq);
      acc = __builtin_amdgcn_mfma_f32_16x16x32_bf16(a, bq, acc, 0, 0, 0);
    }
    const int c = 16 * rt + fr, s0 = 16 * st + 4 * fq;
    float v0 = (s0 + 0 <= c) ? acc[0] : 0.f, v1 = (s0 + 1 <= c) ? acc[1] : 0.f, v2 = (s0 + 2 <= c) ? acc[2] : 0.f, v3 = (s0 + 3 <= c) ? acc[3] : 0.f;
    uint2 o; o.x = pack2(v0, v1); o.y = pack2(v2, v3);
    *(uint2*)(att + c * 72 + s0) = o;
  }
  __syncthreads();
  f32x4 o[4];
#pragma unroll
  for (int j = 0; j < 4; ++j) o[j] = (f32x4){0.f, 0.f, 0.f, 0.f};
#pragma unroll
  for (int ks = 0; ks < 2; ++ks) {
    bf16x8 bq = *(const bf16x8*)(att + (16 * rt + fr) * 72 + 32 * ks + 8 * fq);
#pragma unroll
    for (int j = 0; j < 4; ++j) {
      bf16x8 a = *(const bf16x8*)(vT + (16 * (4 * hh + j) + fr) * 72 + 32 * ks + 8 * fq);
      o[j] = __builtin_amdgcn_mfma_f32_16x16x32_bf16(a, bq, o[j], 0, 0, 0);
    }
  }
#pragma unroll
  for (int ks = 0; ks < 4; ++ks) {
    bf16x8 bq = *(const bf16x8*)(qd + (16 * rt + fr) * 136 + 32 * ks + 8 * fq);
#pragma unroll
    for (int j = 0; j < 4; ++j) o[j] = __builtin_amdgcn_mfma_f32_16x16x32_bf16(sf[ks][j], bq, o[j], 0, 0, 0);
  }
  float ss = 0.f;
#pragma unroll
  for (int j = 0; j < 4; ++j) ss += o[j][0] * o[j][0] + o[j][1] * o[j][1] + o[j][2] * o[j][2] + o[j][3] * o[j][3];
  ss += __shfl_xor(ss, 16); ss += __shfl_xor(ss, 32);
  if (fq == 0) ssq[hh * 64 + 16 * rt + fr] = ss;
  __syncthreads();
  const float tss = ssq[16 * rt + fr] + ssq[64 + 16 * rt + fr];
  const float rstd = rsqrtf(tss * (1.f / 128.f) + 1e-6f);
#pragma unroll
  for (int j = 0; j < 4; ++j) {
    const int col = h * 128 + 16 * (4 * hh + j) + 4 * fq;
    float z0 = lo2f(gw[j].x), z1 = hi2f(gw[j].x), z2 = lo2f(gw[j].y), z3 = hi2f(gw[j].y);
    float r0 = o[j][0] * rstd * g4[j].x * z0 * sigm(z0), r1 = o[j][1] * rstd * g4[j].y * z1 * sigm(z1);
    float r2 = o[j][2] * rstd * g4[j].z * z2 * sigm(z2), r3 = o[j][3] * rstd * g4[j].w * z3 * sigm(z3);
    uint2 ow; ow.x = pack2(r0, r1); ow.y = pack2(r2, r3);
    *(uint2*)(p.mix + (size_t)token * 1024 + col) = ow;
  }
  __syncthreads();
}

__device__ void s5_a_block(const Params& p, int g, int to, char* smem) {
  const int tid = otid(), lane = tid & 63, wid = tid >> 6, fr = lane & 15, fq = lane >> 4;
  const int tt = to * 8 + wid;
  bf16x8 U[8];
#pragma unroll
  for (int ks = 0; ks < 8; ++ks) {
    const int tok = tt * 256 + 16 * fr + 2 * ks + (fq >> 1);
    U[ks] = *(const bf16x8*)(p.ubuf + ((size_t)g * T + tok) * 16 + 8 * (fq & 1));
  }
  {
    const uint4* src = (const uint4*)(p.Ftab + (size_t)g * 128 * 256);
    uint4 v[8];
#pragma unroll
    for (int i = 0; i < 8; ++i) v[i] = src[tid + 512 * i];
#pragma unroll
    for (int i = 0; i < 8; ++i) { const int c = tid + 512 * i; *(uint4*)(smem + (c >> 5) * 528 + (c & 31) * 16) = v[i]; }
  }
  __syncthreads();
#pragma unroll
  for (int rt = 0; rt < 8; ++rt) {
    f32x4 acc = (f32x4){0.f, 0.f, 0.f, 0.f};
#pragma unroll
    for (int ks = 0; ks < 8; ++ks) {
      bf16x8 a = *(const bf16x8*)(smem + (16 * rt + fr) * 528 + 64 * ks + 16 * fq);
      acc = __builtin_amdgcn_mfma_f32_16x16x32_bf16(a, U[ks], acc, 0, 0, 0);
    }
    *(f32x4*)(p.Xend + ((size_t)(tt * 16 + fr) * 32 + g) * 128 + 16 * rt + 4 * fq) = acc;
  }
  __syncthreads();
}

__device__ void s5_c_block(const Params& p, int g, int to, char* smem) {
  const int tid = otid(), lane = tid & 63, wid = tid >> 6, fr = lane & 15, fq = lane >> 4;
  const int tt = to * 8 + wid;
  bf16x8 U[8], Kf[16], Xf[4];
#pragma unroll
  for (int ks = 0; ks < 8; ++ks) {
    const int tok = tt * 256 + 16 * fr + 2 * ks + (fq >> 1);
    U[ks] = *(const bf16x8*)(p.ubuf + ((size_t)g * T + tok) * 16 + 8 * (fq & 1));
  }
#pragma unroll
  for (int d = 0; d < 16; ++d) {
    const int tau = d - (fq >> 1);
    bf16x8 z = (bf16x8){0, 0, 0, 0, 0, 0, 0, 0};
    if (tau >= 0) z = *(const bf16x8*)(p.Ktab + (size_t)((g * 16 + tau) * 16 + fr) * 16 + 8 * (fq & 1));
    Kf[d] = z;
  }
#pragma unroll
  for (int ks = 0; ks < 4; ++ks) Xf[ks] = *(const bf16x8*)(p.Xs + ((size_t)(tt * 16 + fr) * 32 + g) * 128 + 32 * ks + 8 * fq);
  const int c0 = g * 16 + 4 * fq;
  const float4 dsk = *(const float4*)(p.s5_d + c0);
  uint2 uw[16];
#pragma unroll
  for (int t = 0; t < 16; ++t) uw[t] = *(const uint2*)(p.ubuf + ((size_t)g * T + tt * 256 + 16 * fr + t) * 16 + 4 * fq);
  {
    const uint4* src = (const uint4*)(p.Etab + (size_t)g * 256 * 128);
    uint4 v[8];
#pragma unroll
    for (int i = 0; i < 8; ++i) v[i] = src[tid + 512 * i];
#pragma unroll
    for (int i = 0; i < 8; ++i) { const int c = tid + 512 * i; *(uint4*)(smem + (c >> 4) * 272 + (c & 15) * 16) = v[i]; }
  }
  __syncthreads();
#pragma unroll
  for (int t = 0; t < 16; ++t) {
    f32x4 acc = (f32x4){0.f, 0.f, 0.f, 0.f};
#pragma unroll
    for (int ks = 0; ks <= t / 2; ++ks) acc = __builtin_amdgcn_mfma_f32_16x16x32_bf16(Kf[t - 2 * ks], U[ks], acc, 0, 0, 0);
#pragma unroll
    for (int ks = 0; ks < 4; ++ks) {
      bf16x8 a = *(const bf16x8*)(smem + (t * 16 + fr) * 272 + 64 * ks + 16 * fq);
      acc = __builtin_amdgcn_mfma_f32_16x16x32_bf16(a, Xf[ks], acc, 0, 0, 0);
    }
    const int token = tt * 256 + 16 * fr + t;
    float y0 = acc[0] + dsk.x * lo2f(uw[t].x), y1 = acc[1] + dsk.y * hi2f(uw[t].x), y2 = acc[2] + dsk.z * lo2f(uw[t].y), y3 = acc[3] + dsk.w * hi2f(uw[t].y);
    uint2 ow; ow.x = pack2(gelu_tanh(y0), gelu_tanh(y1)); ow.y = pack2(gelu_tanh(y2), gelu_tanh(y3));
    *(uint2*)(p.ybuf + ((size_t)g * T + token) * 16 + 4 * fq) = ow;
  }
  __syncthreads();
}

#define XB_TMO      128
#define XB_XCNT(j)  (256  + 64 * (j))
#define XB_XSUB(j)  (1280 + 64 * (j))
#define XB_XGEN(j)  (2304 + 64 * (j))
#define XB_TOP      3328
#define XB_TOPGEN   3392
#define XCD_BAR_WORDS 3456
#define XB_SPIN_CAP (1u << 20)
__device__ __forceinline__ unsigned xb_ld(unsigned* p) { return __hip_atomic_load(p, __ATOMIC_RELAXED, __HIP_MEMORY_SCOPE_AGENT); }
__device__ __forceinline__ unsigned xb_add(unsigned* p, unsigned v) { return __hip_atomic_fetch_add(p, v, __ATOMIC_RELAXED, __HIP_MEMORY_SCOPE_AGENT); }
__device__ __forceinline__ unsigned xb_xcc_id() { return (unsigned)__builtin_amdgcn_s_getreg((3 << 11) | 20) & 0xFu; }
#define XB_SPIN(cond, bar) do { unsigned _sp = 0; while (cond) { __builtin_amdgcn_s_sleep(1); \
    if ((++_sp & 255u) == 0u) { if (xb_ld(&(bar)[XB_TMO])) break; if (_sp > XB_SPIN_CAP) { atomicAdd(&(bar)[XB_TMO], 1u); break; } } } } while (0)
struct XcdBarrier { unsigned* bar; unsigned x; volatile LAS unsigned* st; };
__device__ __forceinline__ XcdBarrier xcd_barrier_post(unsigned* bar, volatile LAS unsigned* st) {
  XcdBarrier b; b.bar = bar; b.x = xb_xcc_id(); b.st = st;
  if (threadIdx.x == 0) (void)xb_add(&bar[XB_XCNT(b.x)], 1u);
  return b;
}
__device__ __forceinline__ void xcd_barrier_complete(unsigned* bar, unsigned x, unsigned& nloc, unsigned& nx) {
  const unsigned G = gridDim.x * gridDim.y * gridDim.z;
  unsigned sum, cnt, mine, sp = 0u;
  for (;;) {
    sum = 0u; cnt = 0u; mine = 0u;
#pragma unroll
    for (unsigned j = 0; j < 16; ++j) { const unsigned c = xb_ld(&bar[XB_XCNT(j)]); sum += c; cnt += (c > 0u) ? 1u : 0u; mine = (j == x) ? c : mine; }
    if (sum == G) break;
    __builtin_amdgcn_s_sleep(1);
    if ((++sp & 255u) == 0u) { if (xb_ld(&bar[XB_TMO])) break; if (sp > XB_SPIN_CAP) { atomicAdd(&bar[XB_TMO], 1u); break; } }
  }
  nloc = mine > 0u ? mine : 1u; nx = cnt > 0u ? cnt : 1u;
}
__device__ __forceinline__ void xcd_barrier(const XcdBarrier& b) {
  asm volatile("s_waitcnt vmcnt(0)" ::: "memory");
  __syncthreads();
  if (threadIdx.x == 0) {
    unsigned* bar = b.bar;
    __builtin_amdgcn_s_waitcnt(0);
    unsigned nloc = b.st[0], nx = b.st[1];
    if (nloc == 0u) { xcd_barrier_complete(bar, b.x, nloc, nx); b.st[0] = nloc; b.st[1] = nx; }
    const unsigned old = xb_add(&bar[XB_XSUB(b.x)], 1u);
    const unsigned gen = old / nloc;
    if (old + 1u == (gen + 1u) * nloc) {
      __builtin_amdgcn_fence(__ATOMIC_RELEASE, "agent");
      asm volatile("s_waitcnt vmcnt(0)" ::: "memory");
      const unsigned og = xb_add(&bar[XB_TOP], 1u);
      const unsigned tg = og / nx;
      if (og + 1u == (tg + 1u) * nx) xb_add(&bar[XB_TOPGEN], 1u);
      else XB_SPIN(xb_ld(&bar[XB_TOPGEN]) == tg, bar);
      __builtin_amdgcn_fence(__ATOMIC_ACQUIRE, "agent");
      xb_add(&bar[XB_XGEN(b.x)], 1u);
      asm volatile("s_waitcnt vmcnt(0)" ::: "memory");
    } else {
      XB_SPIN(xb_ld(&bar[XB_XGEN(b.x)]) == gen, bar);
      __builtin_amdgcn_fence(__ATOMIC_ACQUIRE, "agent");
      asm volatile("s_waitcnt vmcnt(0)" ::: "memory");
    }
  }
  __syncthreads();
}

__device__ void phase_mix_a(const Params& p, char* smem, int part) {
  if (part == 0) { for (int it = blockIdx.x; it < 1024; it += gridDim.x) hg_a_item(p, it, smem); }
  else { for (int u = blockIdx.x; u < 256; u += gridDim.x) s5_a_block(p, u & 31, u >> 5, smem); }
}

__device__ void phase_scan(const Params& p) {
  int tid = otid();
  if (tid < 128) {
    for (int it = blockIdx.x * 128 + tid; it < 32768; it += gridDim.x * 128) {
      const int seg = it & 3, ch = it >> 2;
      const int bt = ch >> 11, g = (ch >> 6) & 31, n = ch & 63;
      const float2 a = p.Pw[g * 64 + n];
      const size_t base = ((size_t)(bt * 256 + seg * 64) * 32 + g) * 128 + n;
      const float* __restrict__ xe = p.Xend + base;
      bf16_t* __restrict__ xs = p.Xs + base;
      float xr = 0.f, xi = 0.f;
#pragma unroll 1
      for (int h = 0; h < 2; ++h) {
        float er[32], ei[32];
#pragma unroll
        for (int j = 0; j < 32; ++j) { er[j] = xe[(size_t)(h * 32 + j) * 4096]; ei[j] = xe[(size_t)(h * 32 + j) * 4096 + 64]; }
#pragma unroll
        for (int j = 0; j < 32; ++j) { const float nr = a.x * xr - a.y * xi + er[j], ni = a.x * xi + a.y * xr + ei[j]; xr = nr; xi = ni; }
      }
      float Ar = a.x, Ai = a.y;
#pragma unroll
      for (int q = 0; q < 6; ++q) { const float t = Ar * Ar - Ai * Ai; Ai = 2.f * Ar * Ai; Ar = t; }
      const int lb = (tid & 63) & ~3;
      const float e0r = __shfl(xr, lb), e0i = __shfl(xi, lb), e1r = __shfl(xr, lb + 1), e1i = __shfl(xi, lb + 1), e2r = __shfl(xr, lb + 2), e2i = __shfl(xi, lb + 2);
      const float s2r = Ar * e0r - Ai * e0i + e1r, s2i = Ar * e0i + Ai * e0r + e1i;
      const float s3r = Ar * s2r - Ai * s2i + e2r, s3i = Ar * s2i + Ai * s2r + e2i;
      xr = seg == 0 ? 0.f : (seg == 1 ? e0r : (seg == 2 ? s2r : s3r));
      xi = seg == 0 ? 0.f : (seg == 1 ? e0i : (seg == 2 ? s2i : s3i));
#pragma unroll 1
      for (int h = 0; h < 2; ++h) {
        float er[32], ei[32];
#pragma unroll
        for (int j = 0; j < 32; ++j) { er[j] = xe[(size_t)(h * 32 + j) * 4096]; ei[j] = xe[(size_t)(h * 32 + j) * 4096 + 64]; }
#pragma unroll
        for (int j = 0; j < 32; ++j) {
          xs[(size_t)(h * 32 + j) * 4096] = f2bf(xr); xs[(size_t)(h * 32 + j) * 4096 + 64] = f2bf(xi);
          const float nr = a.x * xr - a.y * xi + er[j], ni = a.x * xi + a.y * xr + ei[j]; xr = nr; xi = ni;
        }
      }
    }
  }
  const int gtid = blockIdx.x * NTHR + tid, gthr = gridDim.x * NTHR;
  for (int e2 = gtid; e2 < 16 * 8192; e2 += gthr) {
    const int bh = e2 >> 13, e = (e2 & 8191) * 2, k = e & 127;
    const bf16_t* __restrict__ dsp = p.dstate + (size_t)bh * 64 * 16384 + e;
    const float* __restrict__ dcp = p.decay + (size_t)bh * 64 * 128 + k;
    bf16_t* __restrict__ sp = p.sstart + (size_t)bh * 64 * 16384 + e;
    float sx = 0.f, sy = 0.f;
#pragma unroll 1
    for (int n0 = 0; n0 < 64; n0 += 16) {
      unsigned ds[16]; float2 dc[16];
#pragma unroll
      for (int j = 0; j < 16; ++j) { ds[j] = *(const unsigned*)(dsp + (size_t)(n0 + j) * 16384); dc[j] = *(const float2*)(dcp + (n0 + j) * 128); }
#pragma unroll
      for (int j = 0; j < 16; ++j) {
        *(unsigned*)(sp + (size_t)(n0 + j) * 16384) = pack2(sx, sy);
        sx = dc[j].x * sx + lo2f(ds[j]); sy = dc[j].y * sy + hi2f(ds[j]);
      }
    }
  }
}

__device__ void phase_mix_c(const Params& p, char* smem, int part) {
  if (part == 0) {
    if (gridDim.x == 256) {
      const int b = blockIdx.x, first = b < 128 ? b * 3 : 384 + (b - 128) * 5, cnt = b < 128 ? 3 : 5;
      for (int j = 0; j < cnt; ++j) hg_c_item(p, first + j, smem);
    } else { for (int it = blockIdx.x; it < 1024; it += gridDim.x) hg_c_item(p, it, smem); }
  }
  else { for (int u = blockIdx.x; u < 256; u += gridDim.x) s5_c_block(p, u & 31, u >> 5, smem); }
}

__device__ void phase_final(const Params& p) {
  int tid_ = otid();
  const int lane = tid_ & 63, wid = tid_ >> 6;
  for (int row0 = (blockIdx.x * 8 + wid) * 4; row0 < T; row0 += gridDim.x * 32) {
    float4 v[4][4]; float rs[4];
#pragma unroll
    for (int r = 0; r < 4; ++r) {
      const float4* op = (const float4*)(p.out + (size_t)(row0 + r) * 1024);
#pragma unroll
      for (int i = 0; i < 4; ++i) v[r][i] = op[lane + 64 * i];
      rs[r] = rsqrtf(p.rsq2[row0 + r] * (1.f / 1024.f) + 1e-6f);
    }
#pragma unroll
    for (int i = 0; i < 4; ++i) {
      const float4 g = ((const float4*)p.final_g)[lane + 64 * i];
#pragma unroll
      for (int r = 0; r < 4; ++r) {
        float4 w = v[r][i];
        w.x *= rs[r] * g.x; w.y *= rs[r] * g.y; w.z *= rs[r] * g.z; w.w *= rs[r] * g.w;
        ((float4*)(p.out + (size_t)(row0 + r) * 1024))[lane + 64 * i] = w;
      }
    }
  }
}

template <int PH>
__device__ __forceinline__ void run_phase(const Params& p, char* smem) {
  if (PH == 0) phase_prep(p, smem);
  if (PH == 100) phase_prep_xn(p);
  if (PH == 1) {
    EpiProj e{p.proj, p.ubuf, p.logf, p.hg_lb}; gemm_phase(p.xn, p.Wt_in, T, 2560, 1024, e, smem);
    if (gridDim.x == 256 && blockIdx.x >= 128)
      for (int t = 160 + ((int)blockIdx.x - 128); t < 768; t += 128) transpose_any(p, t, (float*)smem);
  }
  if (PH == 2) phase_mix_a(p, smem, 0);
  if (PH == 102) phase_mix_a(p, smem, 1);
  if (PH == 3) phase_scan(p);
  if (PH == 4) phase_mix_c(p, smem, 1);
  if (PH == 104) { }
  if (PH == 5) { EpiGlu e{p.ybuf, p.b_glu, p.mix}; gemm_phase(p.ybuf, p.Wt_glu, T, 512, 512, e, smem, RowMapGroupMajor()); phase_mix_c(p, smem, 0); }
  if (PH == 6) { EpiOut e{p.x, p.hb, p.rsq1}; gemm_phase(p.mix, p.Wt_out, T, 1024, 1024, e, smem); }
  if (PH == 7) { EpiUpConv e{p.act, p.rsq1, p.conv_w, p.conv_b, (LAS float*)((LAS unsigned char*)smem + 131088)}; gemm_phase(p.hb, p.Wt_up, 68 * 256, 5632, 1024, e, smem, RowMapConv()); }
  if (PH == 8) { EpiDown e{p.out, p.hb, p.rsq2, p.bar + XCD_BAR_WORDS, p.final_g, (LAS float*)((LAS unsigned char*)smem + 131088), gridDim.x >= 256}; gemm_phase(p.act, p.Wt_down, T, 1024, 2816, e, smem); }
  if (PH == 9) { if (gridDim.x < 256) phase_final(p); }
}

#if MK_FUSED
#define PROBE_MARK(k) do { if (PROBE_K == (k)) t_mark = __builtin_amdgcn_s_memrealtime(); } while (0)
__global__ void __launch_bounds__(NTHR) fwd_megakernel(Params p) {
  extern __shared__ __attribute__((aligned(16))) char smem[];
  volatile LAS unsigned* st = (volatile LAS unsigned*)((LAS unsigned char*)smem + 131072);
  if (threadIdx.x == 0) { st[0] = 0u; st[1] = 0u; st[2] = 0u; st[3] = 0u; }
  __syncthreads();
  const XcdBarrier xb = xcd_barrier_post(p.bar, st);
  unsigned long long t_start = 0, t_mark = 0;
  if (PROBE_K >= 0) { t_start = __builtin_amdgcn_s_memrealtime(); t_mark = t_start; }
  run_phase<0>(p, smem); PROBE_MARK(21); run_phase<100>(p, smem); PROBE_MARK(20);
  cg::this_grid().sync(); PROBE_MARK(0);
  run_phase<1>(p, smem); xcd_barrier(xb); PROBE_MARK(1);
  run_phase<2>(p, smem); PROBE_MARK(23); run_phase<102>(p, smem); xcd_barrier(xb); PROBE_MARK(2);
  run_phase<3>(p, smem); PROBE_MARK(40); xcd_barrier(xb); PROBE_MARK(3);
  run_phase<4>(p, smem); PROBE_MARK(22); run_phase<104>(p, smem); xcd_barrier(xb); PROBE_MARK(4);
  run_phase<5>(p, smem); xcd_barrier(xb); PROBE_MARK(5);
  run_phase<6>(p, smem); xcd_barrier(xb); PROBE_MARK(6);
  run_phase<7>(p, smem); PROBE_MARK(41); xcd_barrier(xb); PROBE_MARK(7);
  run_phase<8>(p, smem);
  if (gridDim.x < 256) { xcd_barrier(xb); run_phase<9>(p, smem); }
  if (PROBE_K >= 30 && PROBE_K < 40) t_mark = *(volatile LAS unsigned long long*)((LAS unsigned char*)smem + 131080);
  if (PROBE_K >= 0) {
    const unsigned long long t_end = __builtin_amdgcn_s_memrealtime();
    const unsigned long long until = t_end + 4ull * (t_mark - t_start);
    while (__builtin_amdgcn_s_memrealtime() < until) __builtin_amdgcn_s_sleep(8);
  }
}
#else
template <int PH>
__global__ void __launch_bounds__(NTHR) phase_kernel(Params p) {
  extern __shared__ __attribute__((aligned(16))) char smem[];
  run_phase<PH>(p, smem);
}
template <int PH>
static void launch_phase(const Params& p, int grid, hipStream_t stream) {
  (void)hipFuncSetAttribute((const void*)phase_kernel<PH>, hipFuncAttributeMaxDynamicSharedMemorySize, LDS_BYTES);
  hipLaunchKernelGGL(phase_kernel<PH>, dim3(grid), dim3(NTHR), LDS_BYTES, stream, p);
}
#endif

extern "C" void kernel_launch(void* const* d_in, const int* in_sizes, int n_in, void* d_out, int out_size, void* d_ws,
                              size_t ws_size, hipStream_t stream) {
  Params p{};
  p.x = (const float*)d_in[0]; p.in_norm_g = (const float*)d_in[1]; p.w_in = (const float*)d_in[2]; p.hg_lb = (const float*)d_in[3];
  p.hg_norm_g = (const float*)d_in[4]; p.a_re = (const float*)d_in[5]; p.a_im = (const float*)d_in[6]; p.log_dt = (const float*)d_in[7];
  p.b_re = (const float*)d_in[8]; p.b_im = (const float*)d_in[9]; p.c_re = (const float*)d_in[10]; p.c_im = (const float*)d_in[11];
  p.s5_d = (const float*)d_in[12]; p.w_glu = (const float*)d_in[13]; p.b_glu = (const float*)d_in[14]; p.w_out = (const float*)d_in[15];
  p.ffn_norm_g = (const float*)d_in[16]; p.w_up = (const float*)d_in[17]; p.conv_w = (const float*)d_in[18]; p.conv_b = (const float*)d_in[19];
  p.w_down = (const float*)d_in[20]; p.final_g = (const float*)d_in[21];
  p.out = (float*)d_out;
  char* ws = (char*)d_ws;
  size_t off = 0;
  auto take = [&](size_t bytes) { char* r = ws + off; off += (bytes + 255) & ~(size_t)255; return r; };
  p.Wt_in = (bf16_t*)take((size_t)2560 * 1024 * 2);
  p.Wt_glu = (bf16_t*)take((size_t)512 * 512 * 2);
  p.Wt_out = (bf16_t*)take((size_t)1024 * 1024 * 2);
  p.Wt_up = (bf16_t*)take((size_t)5632 * 1024 * 2);
  p.Wt_down = (bf16_t*)take((size_t)1024 * 2816 * 2);
  p.Ktab = (bf16_t*)take((size_t)32 * 16 * 256 * 2);
  p.Etab = (bf16_t*)take((size_t)32 * 256 * 128 * 2);
  p.Ftab = (bf16_t*)take((size_t)32 * 128 * 256 * 2);
  p.Pw = (float2*)take((size_t)32 * 17 * 64 * 8);
  p.Bbar = (float2*)take((size_t)32 * 64 * 16 * 8);
  p.rsq1 = (float*)take((size_t)T * 16 * 4);
  p.rsq2 = (float*)take((size_t)T * 16 * 4);
  p.decay = (float*)take((size_t)1024 * 128 * 4);
  p.bar = (unsigned*)take((size_t)(XCD_BAR_WORDS + 64 * 64) * 4);
  const size_t dyn0 = off;
  p.xn = (bf16_t*)take((size_t)T * 1024 * 2);
  p.sstart = p.xn; p.hb = p.xn;
  const size_t r2 = off;
  p.proj = (bf16_t*)take((size_t)T * 2048 * 2);
  p.ubuf = (bf16_t*)take((size_t)T * 512 * 2);
  p.logf = (_Float16*)take((size_t)T * 512 * 4);
  p.mix = (bf16_t*)take((size_t)T * 1024 * 2);
  p.ybuf = (bf16_t*)take((size_t)T * 512 * 2);
  p.Xend = (float*)take((size_t)1024 * 32 * 128 * 4);
  p.Xs = (bf16_t*)take((size_t)1024 * 32 * 128 * 2);
  const size_t endA = off;
  p.dstate = (bf16_t*)d_out;
  off = r2;
  p.act = (bf16_t*)take((size_t)T * 2816 * 2);
  const size_t endB = off;
  (void)dyn0;
  if (endA > ws_size || endB > ws_size) fprintf(stderr, "workspace too small: need %zu / %zu have %zu\n", endA, endB, ws_size);

  static int grid_blocks = 0;
#if MK_FUSED
  if (!grid_blocks) {
    int dev = 0, cus = 0, per_cu = 0;
    (void)hipGetDevice(&dev);
    (void)hipDeviceGetAttribute(&cus, hipDeviceAttributeMultiprocessorCount, dev);
    (void)hipFuncSetAttribute((const void*)fwd_megakernel, hipFuncAttributeMaxDynamicSharedMemorySize, LDS_BYTES);
    (void)hipOccupancyMaxActiveBlocksPerMultiprocessor(&per_cu, fwd_megakernel, NTHR, LDS_BYTES);
    if (per_cu > 1) per_cu = 1;
    grid_blocks = cus * per_cu;
  }
  (void)hipMemsetAsync(p.bar, 0, (size_t)(XCD_BAR_WORDS + 64 * 64) * 4, stream);
  void* args[] = {&p};
  hipError_t e = hipLaunchCooperativeKernel((void*)fwd_megakernel, dim3(grid_blocks), dim3(NTHR), args, LDS_BYTES, stream);
  if (e != hipSuccess) fprintf(stderr, "cooperative launch failed: %s (grid %d)\n", hipGetErrorString(e), grid_blocks);
#else
  if (!grid_blocks) {
    int dev = 0, cus = 0;
    (void)hipGetDevice(&dev);
    (void)hipDeviceGetAttribute(&cus, hipDeviceAttributeMultiprocessorCount, dev);
    grid_blocks = cus;
  }
  launch_phase<0>(p, grid_blocks, stream);
  launch_phase<100>(p, grid_blocks, stream);
  launch_phase<1>(p, grid_blocks, stream);
  launch_phase<2>(p, grid_blocks, stream);
  launch_phase<102>(p, grid_blocks, stream);
  launch_phase<3>(p, grid_blocks, stream);
  launch_phase<4>(p, grid_blocks, stream);
  launch_phase<104>(p, grid_blocks, stream);
  launch_phase<5>(p, grid_blocks, stream);
  launch_phase<6>(p, grid_blocks, stream);
  launch_phase<7>(p, grid_blocks, stream);
  launch_phase<8>(p, grid_blocks, stream);
  launch_phase<9>(p, grid_blocks, stream);
#endif
}
```

```cpp
#include <hip/hip_runtime.h>
#include <hip/hip_cooperative_groups.h>
#include <stdint.h>
#include <cstdio>
namespace cg = cooperative_groups;

#ifndef PROBE_K
#define PROBE_K -1
#endif
#ifndef MK_FUSED
#define MK_FUSED 1
#endif

typedef unsigned short bf16_t;
typedef short bf16x8 __attribute__((ext_vector_type(8)));
typedef float f32x4 __attribute__((ext_vector_type(4)));

constexpr int T = 16384;
constexpr int NTHR = 512;
constexpr int LDS_BYTES = 128 * 1024 + 16 + 6144;

struct Params {
  const float *x, *in_norm_g, *w_in, *hg_lb, *hg_norm_g, *a_re, *a_im, *log_dt, *b_re, *b_im, *c_re, *c_im, *s5_d,
      *w_glu, *b_glu, *w_out, *ffn_norm_g, *w_up, *conv_w, *conv_b, *w_down, *final_g;
  float* out;
  bf16_t *Wt_in, *Wt_glu, *Wt_out, *Wt_up, *Wt_down, *xn, *proj, *sstart, *Xs, *mix, *ybuf, *ubuf, *hb, *hid, *act, *Ktab, *Etab, *Ftab;
  _Float16* logf; bf16_t* dstate;
  float *decay, *Xend, *rsq1, *rsq2;
  float2 *Pw, *Bbar;
  unsigned* bar;
};

__device__ __forceinline__ int otid() { int t = threadIdx.x; asm volatile("" : "+v"(t)); return t; }
typedef float f32x2_t __attribute__((ext_vector_type(2)));
typedef __bf16 bf16x2_t __attribute__((ext_vector_type(2)));
__device__ __forceinline__ unsigned pack2(float a, float b) { f32x2_t v = {a, b}; bf16x2_t h = __builtin_convertvector(v, bf16x2_t); return __builtin_bit_cast(unsigned, h); }
__device__ __forceinline__ bf16_t f2bf(float f) { return (bf16_t)(pack2(f, f) & 0xffffu); }
__device__ __forceinline__ float bf2f(bf16_t h) { return __uint_as_float(((unsigned)h) << 16); }
__device__ __forceinline__ float lo2f(unsigned w) { return __uint_as_float(w << 16); }
__device__ __forceinline__ float hi2f(unsigned w) { return __uint_as_float(w & 0xffff0000u); }
__device__ __forceinline__ float sigm(float x) { return __builtin_amdgcn_rcpf(1.f + __expf(-x)); }
__device__ __forceinline__ float gelu_tanh(float y) {
  float u = 0.7978845608028654f * (y + 0.044715f * y * y * y);
  return y * sigm(2.f * u);
}

typedef unsigned u32x2 __attribute__((ext_vector_type(2)));
typedef unsigned u32x4_t __attribute__((ext_vector_type(4)));
__device__ __forceinline__ void st_nt8(void* p, unsigned a, unsigned b) { u32x2 v; v.x = a; v.y = b; *(u32x2*)p = v; }
__device__ __forceinline__ void st_nt8(void* p, uint2 w) { st_nt8(p, w.x, w.y); }
__device__ __forceinline__ void st_nt16(void* p, f32x4 v) { __builtin_nontemporal_store(v, (f32x4*)p); }
__device__ __forceinline__ void st_nt16(void* p, uint4 w) { *(uint4*)p = w; }
__device__ __forceinline__ float4 ld_nt16f(const void* p) { const f32x4 t = __builtin_nontemporal_load((const f32x4*)p); return make_float4(t[0], t[1], t[2], t[3]); }
__device__ __forceinline__ uint4 ld_nt16(const void* p) { const u32x4_t t = __builtin_nontemporal_load((const u32x4_t*)p); return make_uint4(t.x, t.y, t.z, t.w); }
__device__ __forceinline__ uint2 ld_nt8(const void* p) { const u32x2 t = __builtin_nontemporal_load((const u32x2*)p); return make_uint2(t.x, t.y); }
__device__ __forceinline__ unsigned ld_nt4(const void* p) { return __builtin_nontemporal_load((const unsigned*)p); }

__device__ double exp_d(double x) {
  double k = rint(x * 1.4426950408889634);
  double r = fma(-k, 0.6931471805599453, x);
  r = fma(-k, 2.3190468138462996e-17, r);
  double p = 1.0;
#pragma unroll
  for (int i = 16; i >= 1; --i) p = fma(r * p, 1.0 / (double)i, 1.0);
  return ldexp(p, (int)k);
}
__device__ void sincos_d(double x, double& s, double& c) {
  double q = rint(x * 0.6366197723675814);
  double r = fma(-q, 1.5707963267948966, x);
  r = fma(-q, 6.123233995736766e-17, r);
  int iq = ((int)q) & 3;
  double r2 = r * r;
  double sp = 1.0, cp = 1.0;
#pragma unroll
  for (int i = 9; i >= 1; --i) sp = fma(-r2 * sp, 1.0 / (double)((2 * i) * (2 * i + 1)), 1.0);
  sp *= r;
#pragma unroll
  for (int i = 10; i >= 1; --i) cp = fma(-r2 * cp, 1.0 / (double)((2 * i - 1) * (2 * i)), 1.0);
  if (iq == 0) { s = sp; c = cp; }
  else if (iq == 1) { s = cp; c = -sp; }
  else if (iq == 2) { s = -sp; c = -cp; }
  else { s = -cp; c = sp; }
}

__device__ __forceinline__ int perm32_row(int n) { const int j = n & 31; return (n & ~31) + 16 * ((j >> 2) & 1) + 4 * (j >> 3) + (j & 3); }
__device__ __forceinline__ int up_dst_row(int n) { const int isv = n >= 2816, nn = isv ? n - 2816 : n; return ((nn >> 7) << 8) + isv * 128 + (nn & 127); }

__device__ void transpose_big(const float* __restrict__ src, bf16_t* __restrict__ dst, int K, int N, int tk, int tn,
                              const float* __restrict__ rowscale, bool perm, float* tile, bool permB = false) {
  const int tid = otid();
  const int k0 = tk * 64, n0 = tn * 256;
  float4 v[8];
#pragma unroll
  for (int i = 0; i < 8; ++i) { const int r = (tid >> 6) + 8 * i, c4 = (tid & 63) * 4; v[i] = *(const float4*)(src + (size_t)(k0 + r) * N + n0 + c4); }
#pragma unroll
  for (int i = 0; i < 8; ++i) {
    const int r = (tid >> 6) + 8 * i, c4 = (tid & 63) * 4;
    const float sc = rowscale ? rowscale[k0 + r] : 1.f;
    tile[r * 257 + c4 + 0] = v[i].x * sc; tile[r * 257 + c4 + 1] = v[i].y * sc; tile[r * 257 + c4 + 2] = v[i].z * sc; tile[r * 257 + c4 + 3] = v[i].w * sc;
  }
  __syncthreads();
  const int n = tid >> 1, kh = (tid & 1) * 32;
  int drow = perm ? up_dst_row(n0 + n) : (n0 + n);
  if (permB) drow = perm32_row(drow);
#pragma unroll
  for (int q = 0; q < 4; ++q) {
    uint4 o;
    o.x = pack2(tile[(kh + 8 * q + 0) * 257 + n], tile[(kh + 8 * q + 1) * 257 + n]);
    o.y = pack2(tile[(kh + 8 * q + 2) * 257 + n], tile[(kh + 8 * q + 3) * 257 + n]);
    o.z = pack2(tile[(kh + 8 * q + 4) * 257 + n], tile[(kh + 8 * q + 5) * 257 + n]);
    o.w = pack2(tile[(kh + 8 * q + 6) * 257 + n], tile[(kh + 8 * q + 7) * 257 + n]);
    *(uint4*)(dst + (size_t)drow * K + k0 + kh + 8 * q) = o;
  }
  __syncthreads();
}

__device__ void transpose_any(const Params& p, int t, float* tile) {
  if (t < 160) transpose_big(p.w_in, p.Wt_in, 1024, 2560, t / 10, t % 10, nullptr, false, tile, true);
  else if (t < 176) { int u = t - 160; transpose_big(p.w_glu, p.Wt_glu, 512, 512, u / 2, u % 2, nullptr, false, tile, true); }
  else if (t < 240) { int u = t - 176; transpose_big(p.w_out, p.Wt_out, 1024, 1024, u / 4, u % 4, nullptr, false, tile, true); }
  else if (t < 592) { int u = t - 240; transpose_big(p.w_up, p.Wt_up, 1024, 5632, u / 22, u % 22, p.ffn_norm_g, true, tile); }
  else { int u = t - 592; transpose_big(p.w_down, p.Wt_down, 2816, 1024, u / 4, u % 4, nullptr, false, tile); }
}

__device__ void s5_tables_block(const Params& p, int bi, char* smem) {
  float* Cr = (float*)smem; float* Ci = Cr + 1024; float* Br = Ci + 1024; float* Bi = Br + 1024;
  float2* Pj = (float2*)(Bi + 1024);
  float2* PZ = Pj + 64;
  const int tid = otid();
  const int g = bi & 31, jb = bi >> 5;
  for (int i = tid; i < 1024; i += NTHR) { Cr[i] = p.c_re[g * 1024 + i]; Ci[i] = p.c_im[g * 1024 + i]; Br[i] = p.b_re[g * 1024 + i]; Bi[i] = p.b_im[g * 1024 + i]; }
  for (int jj = 0; jj < 3; ++jj) {
    const int j = jb + 8 * jj;
    if (j > 16) break;
    __syncthreads();
    if (tid < 64) {
      const int n = tid;
      const double dt = exp_d((double)p.log_dt[g]);
      const double ar = (double)p.a_re[g * 64 + n], ai = (double)p.a_im[g * 64 + n];
      double sj, cj, s1, c1;
      const double mj = exp_d((double)j * dt * ar); sincos_d((double)j * dt * ai, sj, cj);
      const double m1 = exp_d(dt * ar); sincos_d(dt * ai, s1, c1);
      const double pr = mj * cj, pi = mj * sj;
      const double nr = m1 * c1 - 1.0, ni = m1 * s1, den = ar * ar + ai * ai;
      const double zr = (nr * ar + ni * ai) / den, zi = (ni * ar - nr * ai) / den;
      Pj[n] = make_float2((float)pr, (float)pi);
      PZ[n] = make_float2((float)(pr * zr - pi * zi), (float)(pr * zi + pi * zr));
      if (j == 16) p.Pw[g * 64 + n] = make_float2((float)pr, (float)pi);
    }
    __syncthreads();
    if (j >= 1) {
      const int t = j - 1;
#pragma unroll
      for (int i = 0; i < 4; ++i) {
        const int idx = tid + 512 * i, pp = idx >> 7, np = idx & 127, n = np & 63, part = np >> 6;
        const float2 pw = Pj[n];
        const float cr = Cr[pp * 64 + n], ci = Ci[pp * 64 + n];
        const float v = part ? -(cr * pw.y + ci * pw.x) : (cr * pw.x - ci * pw.y);
        p.Etab[(size_t)(g * 256 + t * 16 + pp) * 128 + np] = f2bf(v);
      }
    }
    if (j <= 15) {
      const int sidx = 15 - j;
#pragma unroll
      for (int i = 0; i < 4; ++i) {
        const int idx = tid + 512 * i, np = idx >> 4, pq = idx & 15, n = np & 63, part = np >> 6;
        const float2 m = PZ[n];
        const float br = Br[n * 16 + pq], bi2 = Bi[n * 16 + pq];
        const float v = part ? (m.x * bi2 + m.y * br) : (m.x * br - m.y * bi2);
        p.Ftab[(size_t)(g * 128 + np) * 256 + sidx * 16 + pq] = f2bf(v);
      }
      if (tid < 256) {
        const int pp = tid >> 4, pq = tid & 15;
        float acc = 0.f;
#pragma unroll 8
        for (int n = 0; n < 64; ++n) {
          const float2 m = PZ[n];
          const float br = Br[n * 16 + pq], bi2 = Bi[n * 16 + pq];
          const float cr = Cr[pp * 64 + n], ci = Ci[pp * 64 + n];
          const float mr = m.x * br - m.y * bi2, mi = m.x * bi2 + m.y * br;
          acc += cr * mr - ci * mi;
        }
        p.Ktab[(size_t)((g * 16 + j) * 16 + pp) * 16 + pq] = f2bf(acc);
      }
    }
  }
  __syncthreads();
}

__device__ void phase_prep(const Params& p, char* smem) {
  float* tile = (float*)smem;
  const int tid = otid(), lane = tid & 63, wid = tid >> 6;
  const int gtid = blockIdx.x * NTHR + tid, gthr = gridDim.x * NTHR;
  for (int idx = gtid; idx < T; idx += gthr) { p.rsq1[idx] = 0.f; p.rsq2[idx] = 0.f; }
  const int ntr = (gridDim.x == 256) ? 160 : 768;
  for (int t = blockIdx.x; t < ntr; t += gridDim.x) transpose_any(p, t, tile);
  for (int t = blockIdx.x; t < 256; t += gridDim.x) s5_tables_block(p, t, smem);
}
__device__ void phase_prep_xn(const Params& p) {
  const int tid = otid(), lane = tid & 63, wid = tid >> 6;
  for (int row0 = (blockIdx.x * 8 + wid) * 8; row0 < T; row0 += gridDim.x * 64) {
    float4 v[8][4]; float ss[8];
#pragma unroll
    for (int r = 0; r < 8; ++r) {
      const float4* xr = (const float4*)(p.x + (size_t)(row0 + r) * 1024);
#pragma unroll
      for (int i = 0; i < 4; ++i) { const f32x4 t = __builtin_nontemporal_load((const f32x4*)xr + lane + 64 * i); v[r][i] = make_float4(t[0], t[1], t[2], t[3]); }
    }
#pragma unroll
    for (int r = 0; r < 8; ++r) {
      float a = 0.f;
#pragma unroll
      for (int i = 0; i < 4; ++i) a += v[r][i].x * v[r][i].x + v[r][i].y * v[r][i].y + v[r][i].z * v[r][i].z + v[r][i].w * v[r][i].w;
#pragma unroll
      for (int o = 32; o >= 1; o >>= 1) a += __shfl_xor(a, o);
      ss[r] = rsqrtf(a * (1.f / 1024.f) + 1e-6f);
    }
#pragma unroll
    for (int i = 0; i < 4; ++i) {
      const float4 g = ((const float4*)p.in_norm_g)[lane + 64 * i];
#pragma unroll
      for (int r = 0; r < 8; ++r) {
        uint2 o; o.x = pack2(v[r][i].x * ss[r] * g.x, v[r][i].y * ss[r] * g.y); o.y = pack2(v[r][i].z * ss[r] * g.z, v[r][i].w * ss[r] * g.w);
        *(uint2*)(p.xn + (size_t)(row0 + r) * 1024 + (lane + 64 * i) * 4) = o;
      }
    }
  }
}

struct TileMap {
  int nM, nN, nwg;
  __device__ void init(int M, int N) { nM = M / 256; nN = N / 256; nwg = nM * nN; }
  __device__ void get(int L, int& pm, int& pn) const {
    int wgid = L;
    { const int q = nwg / 8, r = nwg % 8, xcd = wgid % 8, off = wgid / 8; wgid = (xcd < r ? xcd * (q + 1) : r * (q + 1) + (xcd - r) * q) + off; }
    const int nig = 8 * nN, gid = wgid / nig, fm = gid * 8, gsz = (nM - fm) < 8 ? (nM - fm) : 8;
    pm = fm + ((wgid % nig) % gsz); pn = (wgid % nig) / gsz;
  }
};

#define LAS __attribute__((address_space(3)))
constexpr int G_BK = 64, G_HALF = 128, G_HTB = G_HALF * G_BK * 2;
__device__ __forceinline__ int lds_byte(int r, int c) {
  const int st = (r >> 4) * 2 + (c >> 5), rr = r & 15, cc = c & 31, ob = rr * 64 + cc * 2;
  return st * 1024 + (ob ^ (((ob >> 9) & 1) << 5));
}
__device__ __forceinline__ void stage_rc(int b, int& R, int& C) {
  const int st = b / 1024, sb = b % 1024, swz = sb ^ (((sb >> 9) & 1) << 5);
  R = (st >> 1) * 16 + swz / 64; C = (st & 1) * 32 + (swz % 64) / 2;
}

struct RowMapLinear { static constexpr bool PERMA = false, GMAJ = false; __device__ __forceinline__ long operator()(int pm) const { return (long)pm * 256; } };
struct RowMapGroupMajor { static constexpr bool PERMA = false, GMAJ = true; __device__ __forceinline__ long operator()(int pm) const { return (long)pm * 256; } };
struct RowMapConv { static constexpr bool PERMA = true, GMAJ = false; __device__ __forceinline__ long operator()(int pm) const { return (long)(pm / 17) * 4096 + 254 * (pm % 17) - 2; } };

template <class Epi, class RowMap = RowMapLinear>
__device__ __forceinline__ void gemm_phase(const bf16_t* __restrict__ A, const bf16_t* __restrict__ Bt, int M, int N, int K,
                                           const Epi& E, char* smem, const RowMap rmap = RowMap()) {
  LAS unsigned char* lds = (LAS unsigned char*)smem;
  const int tid = otid(), wid = __builtin_amdgcn_readfirstlane(tid >> 6), lane = tid & 63, wr = wid >> 2, wc = wid & 3, fr = lane & 15, fq = lane >> 4;
  const int nt = K / G_BK;
  TileMap tm; tm.init(M, N);
  if ((int)blockIdx.x >= tm.nwg) return;
  unsigned voffA[2], voffB[2];
#pragma unroll
  for (int i = 0; i < 2; ++i) {
    int R, C; stage_rc(tid * 16 + i * 8192, R, C);
    voffB[i] = (unsigned)(R * K + C) * 2u;
    const int Ra = RowMap::PERMA ? ((R & ~63) + 4 * (R & 15) + ((R >> 4) & 3)) : R;
    voffA[i] = RowMap::GMAJ ? (unsigned)((((C >> 4) * M + Ra) * 16 + (C & 15)) * 2) : (unsigned)(Ra * K + C) * 2u;
  }
  const size_t kstep = (size_t)(G_BK * 2);
  const size_t kstepA = RowMap::GMAJ ? (size_t)4 * M * 32 : kstep;
  const size_t hstepA = RowMap::GMAJ ? (size_t)G_HALF * 32 : (size_t)G_HALF * K * 2;
  const size_t hstep = (size_t)G_HALF * K * 2;
  const size_t tstep = 2 * hstep;
  const unsigned ldsw = (unsigned)wid * 1024u;
  const int aoff = lds_byte(wr * 64 + fr, fq * 8), boff = lds_byte(wc * 32 + fr, fq * 8);
#define PG8_SA(b, h) (((b) * 2 + (h)) * G_HTB)
#define PG8_SB(b, h) ((4 + (b) * 2 + (h)) * G_HTB)
#define PG8_STAGE(bufoff, gbase, voff) do { _Pragma("unroll") for (int _i = 0; _i < 2; ++_i) \
    __builtin_amdgcn_global_load_lds((const unsigned*)((const char*)(gbase) + (voff)[_i]), (LAS unsigned*)(lds + (bufoff) + ldsw + _i * 8192), 16, 0, 0); } while (0)
#define PG8_LDA(dst, b, h) do { _Pragma("unroll") for (int m = 0; m < 4; ++m) _Pragma("unroll") for (int k = 0; k < 2; ++k) dst[m][k] = *(const LAS bf16x8*)(lds + PG8_SA(b, h) + aoff + m * 2048 + k * 1024); } while (0)
#define PG8_LDB(dst, b, h) do { _Pragma("unroll") for (int n = 0; n < 2; ++n) _Pragma("unroll") for (int k = 0; k < 2; ++k) dst[n][k] = *(const LAS bf16x8*)(lds + PG8_SB(b, h) + boff + n * 2048 + k * 1024); } while (0)
#define PG8_MMA(ai, bj, At_, Bt_) do { __builtin_amdgcn_s_setprio(1); _Pragma("unroll") for (int m = 0; m < 4; ++m) _Pragma("unroll") for (int n = 0; n < 2; ++n) _Pragma("unroll") for (int k = 0; k < 2; ++k) \
    acc[ai][bj][m][n] = __builtin_amdgcn_mfma_f32_16x16x32_bf16(Bt_[n][k], At_[m][k], acc[ai][bj][m][n], 0, 0, 0); __builtin_amdgcn_s_setprio(0); } while (0)
#define PG8_WAIT_V(n) asm volatile("s_waitcnt vmcnt(" #n ")" ::: "memory")
#define PG8_WAIT_L(n) asm volatile("s_waitcnt lgkmcnt(" #n ")" ::: "memory")
#define PG8_BAR __builtin_amdgcn_s_barrier()
#define PG8_SCHED __builtin_amdgcn_sched_barrier(0)
  int pm, pn, npm = 0, npn = 0, ui = 0;
  tm.get((int)blockIdx.x, pm, pn);
  f32x4 acc[2][2][4][2];
#pragma unroll
  for (int a = 0; a < 2; ++a)
#pragma unroll
    for (int b = 0; b < 2; ++b)
#pragma unroll
      for (int m = 0; m < 4; ++m)
#pragma unroll
        for (int n = 0; n < 2; ++n) acc[a][b][m][n] = (f32x4){0.f, 0.f, 0.f, 0.f};
  bf16x8 At[4][2], B0[2][2], B1[2][2];
  const size_t rstep = RowMap::GMAJ ? (size_t)32 : (size_t)K * 2;
  const char* cA = (const char*)A + rmap(pm) * (long)rstep; const char* cB = (const char*)Bt + (size_t)pn * tstep;
  PG8_WAIT_V(0); __syncthreads();
  PG8_STAGE(PG8_SB(0, 0), cB, voffB); PG8_STAGE(PG8_SA(0, 0), cA, voffA); PG8_STAGE(PG8_SB(0, 1), cB + hstep, voffB); PG8_STAGE(PG8_SA(0, 1), cA + hstepA, voffA);
  if (wr == 1) PG8_BAR;
  PG8_WAIT_V(4); PG8_BAR;
  PG8_STAGE(PG8_SB(1, 0), cB + kstep, voffB); PG8_STAGE(PG8_SA(1, 0), cA + kstepA, voffA); PG8_STAGE(PG8_SB(1, 1), cB + hstep + kstep, voffB);
  PG8_WAIT_V(6); PG8_BAR;
  for (;;) {
    const int Ln = (ui + 1) * (int)gridDim.x + (int)blockIdx.x;
    const bool has_next = Ln < tm.nwg;
    if (has_next) tm.get(Ln, npm, npn);
    const char* nA = has_next ? (const char*)A + rmap(npm) * (long)rstep : cA; const char* nB = has_next ? (const char*)Bt + (size_t)npn * tstep : cB;
    for (int t = 0; t < nt; t += 2) {
      const bool last = (t == nt - 2);
      const char* a1 = cA + (size_t)(t + 1) * kstepA;
      const char* a2 = last ? nA : cA + (size_t)(t + 2) * kstepA; const char* b2 = last ? nB : cB + (size_t)(t + 2) * kstep;
      const char* a3 = a2 + kstepA; const char* b3 = b2 + kstep;
      PG8_LDB(B0, 0, 0); PG8_SCHED; PG8_LDA(At, 0, 0); PG8_STAGE(PG8_SA(1, 1), a1 + hstepA, voffA);
      PG8_WAIT_L(8); PG8_BAR; PG8_WAIT_L(0); PG8_MMA(0, 0, At, B0); PG8_BAR; PG8_SCHED;
      PG8_LDB(B1, 0, 1); PG8_STAGE(PG8_SB(0, 0), b2, voffB);
      PG8_BAR; PG8_WAIT_L(0); PG8_MMA(0, 1, At, B1); PG8_BAR;
      PG8_LDA(At, 0, 1); PG8_STAGE(PG8_SA(0, 0), a2, voffA);
      PG8_BAR; PG8_WAIT_L(0); PG8_MMA(1, 0, At, B0); PG8_BAR; PG8_SCHED;
      PG8_STAGE(PG8_SB(0, 1), b2 + hstep, voffB);
      PG8_WAIT_V(6); PG8_BAR; PG8_MMA(1, 1, At, B1); PG8_BAR;
      PG8_LDB(B0, 1, 0); PG8_SCHED; PG8_LDA(At, 1, 0); PG8_STAGE(PG8_SA(0, 1), a2 + hstepA, voffA);
      PG8_WAIT_L(8); PG8_BAR; PG8_WAIT_L(0); PG8_MMA(0, 0, At, B0); PG8_BAR; PG8_SCHED;
      PG8_LDB(B1, 1, 1); PG8_STAGE(PG8_SB(1, 0), b3, voffB);
      PG8_BAR; PG8_WAIT_L(0); PG8_MMA(0, 1, At, B1); PG8_BAR;
      PG8_LDA(At, 1, 1); PG8_STAGE(PG8_SA(1, 0), a3, voffA);
      PG8_BAR; PG8_WAIT_L(0); PG8_MMA(1, 0, At, B0); PG8_BAR; PG8_SCHED;
      PG8_STAGE(PG8_SB(1, 1), b3 + hstep, voffB);
      PG8_WAIT_V(6); PG8_BAR; PG8_MMA(1, 1, At, B1); PG8_BAR;
    }
    E(acc, pm, pn, wr, wc, fr, fq);
    if (!has_next) break;
#pragma unroll
    for (int a = 0; a < 2; ++a)
#pragma unroll
      for (int b = 0; b < 2; ++b)
#pragma unroll
        for (int m = 0; m < 4; ++m)
#pragma unroll
          for (int n = 0; n < 2; ++n) acc[a][b][m][n] = (f32x4){0.f, 0.f, 0.f, 0.f};
    pm = npm; pn = npn; cA = nA; cB = nB; ++ui;
  }
  PG8_WAIT_V(0);
  if (wr == 0) PG8_BAR;
  PG8_BAR;
#undef PG8_SA
#undef PG8_SB
#undef PG8_STAGE
#undef PG8_LDA
#undef PG8_LDB
#undef PG8_MMA
#undef PG8_WAIT_V
#undef PG8_WAIT_L
#undef PG8_BAR
#undef PG8_SCHED
}

#define PROBE_STAMP_ONCE(k, base) do { if (PROBE_K == (k) && threadIdx.x == 0) { volatile LAS unsigned long long* _s = (volatile LAS unsigned long long*)((LAS unsigned char*)(base) - 8); \
    if (*_s == 0ull) *_s = __builtin_amdgcn_s_memrealtime(); } } while (0)
struct EpiProj {
  bf16_t* proj; bf16_t* ubuf; _Float16* lgf; const float* hg_lb;
  __device__ __forceinline__ void operator()(const f32x4 (&acc)[2][2][4][2], int pm, int pn, int wr, int wc, int fr, int fq) const {
    const int sec = pn >> 1;
    if (sec == 1) {
#pragma unroll
      for (int b = 0; b < 2; ++b) {
        const int c8 = 256 * pn + 128 * b + 32 * wc + 8 * fq;
        float lb[8];
#pragma unroll
        for (int n = 0; n < 2; ++n) {
          const float4 h0 = *(const float4*)(hg_lb + (c8 - 512) + 4 * n), h1 = *(const float4*)(hg_lb + c8 + 4 * n);
          lb[4 * n + 0] = __builtin_amdgcn_rcpf(1.f + __expf(h1.x - h0.x)); lb[4 * n + 1] = __builtin_amdgcn_rcpf(1.f + __expf(h1.y - h0.y));
          lb[4 * n + 2] = __builtin_amdgcn_rcpf(1.f + __expf(h1.z - h0.z)); lb[4 * n + 3] = __builtin_amdgcn_rcpf(1.f + __expf(h1.w - h0.w));
        }
#pragma unroll
        for (int a = 0; a < 2; ++a)
#pragma unroll
          for (int m = 0; m < 4; ++m) {
            const int row = 256 * pm + 128 * a + 64 * wr + 16 * m + fr;
            typedef _Float16 f16x8 __attribute__((ext_vector_type(8)));
            f16x8 lh; float kk[8];
#pragma unroll
            for (int n = 0; n < 2; ++n)
#pragma unroll
              for (int r = 0; r < 4; ++r) {
                const float l = lb[4 * n + r], x = acc[a][b][m][n][r];
                const float sg = __builtin_amdgcn_rcpf(1.f + __expf(-x));
                lh[4 * n + r] = (_Float16)__logf(l + (1.f - l) * sg);
                kk[4 * n + r] = (1.f - l) * __builtin_amdgcn_rcpf(1.f + __expf(x));
              }
            *(f16x8*)(lgf + (size_t)row * 512 + (c8 - 512)) = lh;
            st_nt16(proj + (size_t)row * 2048 + c8, make_uint4(pack2(kk[0], kk[1]), pack2(kk[2], kk[3]), pack2(kk[4], kk[5]), pack2(kk[6], kk[7])));
          }
      }
    } else {
#pragma unroll
      for (int a = 0; a < 2; ++a)
#pragma unroll
        for (int m = 0; m < 4; ++m) {
          const int row = 256 * pm + 128 * a + 64 * wr + 16 * m + fr;
#pragma unroll
          for (int b = 0; b < 2; ++b) {
            const int c8 = 256 * pn + 128 * b + 32 * wc + 8 * fq;
            const f32x4 v0 = acc[a][b][m][0], v1 = acc[a][b][m][1];
            const uint4 o = make_uint4(pack2(v0[0], v0[1]), pack2(v0[2], v0[3]), pack2(v1[0], v1[1]), pack2(v1[2], v1[3]));
            if (sec == 4) st_nt16(ubuf + ((size_t)((c8 - 2048) >> 4) * T + row) * 16 + (c8 & 15), o);
            else st_nt16(proj + (size_t)row * 2048 + c8, o);
          }
        }
    }
  }
};

struct EpiGlu {
  const bf16_t* ybuf; const float* b_glu; bf16_t* mix;
  __device__ __forceinline__ void operator()(const f32x4 (&acc)[2][2][4][2], int pm, int pn, int wr, int wc, int fr, int fq) const {
#pragma unroll
    for (int a = 0; a < 2; ++a)
#pragma unroll
      for (int m = 0; m < 4; ++m) {
        const int row = 256 * pm + 128 * a + 64 * wr + 16 * m + fr;
#pragma unroll
        for (int b = 0; b < 2; ++b) {
          const int c8 = 256 * pn + 128 * b + 32 * wc + 8 * fq;
          const f32x4 v0 = acc[a][b][m][0], v1 = acc[a][b][m][1];
          const float4 b0 = *(const float4*)(b_glu + c8), b1 = *(const float4*)(b_glu + c8 + 4);
          const uint4 yw = ld_nt16(ybuf + ((size_t)(c8 >> 4) * T + row) * 16 + (c8 & 15));
          const float o0 = lo2f(yw.x) * sigm(v0[0] + b0.x), o1 = hi2f(yw.x) * sigm(v0[1] + b0.y), o2 = lo2f(yw.y) * sigm(v0[2] + b0.z), o3 = hi2f(yw.y) * sigm(v0[3] + b0.w);
          const float o4 = lo2f(yw.z) * sigm(v1[0] + b1.x), o5 = hi2f(yw.z) * sigm(v1[1] + b1.y), o6 = lo2f(yw.w) * sigm(v1[2] + b1.z), o7 = hi2f(yw.w) * sigm(v1[3] + b1.w);
          st_nt16(mix + (size_t)row * 1024 + 512 + c8, make_uint4(pack2(o0, o1), pack2(o2, o3), pack2(o4, o5), pack2(o6, o7)));
        }
      }
  }
};


struct EpiOut {
  const float* x; bf16_t* hb; float* rsq;
  __device__ __forceinline__ void operator()(const f32x4 (&acc)[2][2][4][2], int pm, int pn, int wr, int wc, int fr, int fq) const {
#pragma unroll
    for (int a = 0; a < 2; ++a)
#pragma unroll
      for (int m = 0; m < 4; ++m) {
        const int row = 256 * pm + 128 * a + 64 * wr + 16 * m + fr;
        float ss = 0.f;
#pragma unroll
        for (int b = 0; b < 2; ++b) {
          const int c8 = 256 * pn + 128 * b + 32 * wc + 8 * fq;
          const f32x4 v0 = acc[a][b][m][0], v1 = acc[a][b][m][1];
          const float4 x0 = ld_nt16f(x + (size_t)row * 1024 + c8), x1 = ld_nt16f(x + (size_t)row * 1024 + c8 + 4);
          const float h0 = x0.x + v0[0], h1 = x0.y + v0[1], h2 = x0.z + v0[2], h3 = x0.w + v0[3];
          const float h4 = x1.x + v1[0], h5 = x1.y + v1[1], h6 = x1.z + v1[2], h7 = x1.w + v1[3];
          st_nt16(hb + (size_t)row * 1024 + c8, make_uint4(pack2(h0, h1), pack2(h2, h3), pack2(h4, h5), pack2(h6, h7)));
          ss += (h0 * h0 + h1 * h1) + (h2 * h2 + h3 * h3) + (h4 * h4 + h5 * h5) + (h6 * h6 + h7 * h7);
        }
        ss += __shfl_xor(ss, 16); ss += __shfl_xor(ss, 32);
        if (fq == 0) unsafeAtomicAdd(rsq + row, ss);
      }
  }
};

template <int CTRL> __device__ __forceinline__ float dpp_upd(float old, float src) {
  return __int_as_float(__builtin_amdgcn_update_dpp(__float_as_int(old), __float_as_int(src), CTRL, 0xf, 0xf, false));
}
struct EpiUpConv {
  bf16_t* act; const float* rsq; const float* conv_w; const float* conv_b; LAS float* xb;
  __device__ __forceinline__ void operator()(f32x4 (&acc)[2][2][4][2], int pm, int pn, int wr, int wc, int fr, int fq) const {
    PROBE_STAMP_ONCE(31, xb);
    const int seq = pm / 17, it = pm - seq * 17, l0 = 254 * it - 2;
#pragma unroll
    for (int a = 0; a < 2; ++a)
#pragma unroll
      for (int m = 0; m < 4; ++m) {
        const int l = l0 + 128 * a + 64 * wr + 4 * fr + m;
        int tok = seq * 4096 + l; tok = tok < 0 ? 0 : (tok > T - 1 ? T - 1 : tok);
        float rstd = rsqrtf(rsq[tok] * (1.f / 1024.f) + 1e-6f);
#pragma unroll
        for (int b = 0; b < 2; ++b)
#pragma unroll
          for (int n = 0; n < 2; ++n) {
            f32x4 v = acc[a][b][m][n] * rstd;
            if (a == 0 && m < 2 && l < 0) v = (f32x4){0.f, 0.f, 0.f, 0.f};
            acc[a][b][m][n] = v;
          }
      }
    if (fr == 15) {
#pragma unroll
      for (int a = 0; a < 2; ++a) {
        const int bd = 2 * a + wr;
        if (bd < 3) {
#pragma unroll
          for (int q = 0; q < 2; ++q)
#pragma unroll
            for (int b = 0; b < 2; ++b)
#pragma unroll
              for (int n = 0; n < 2; ++n) *(LAS f32x4*)(xb + ((bd * 2 + q) * 2 + b) * 128 + 32 * wc + 16 * n + 4 * fq) = acc[a][b][2 + q][n];
        }
      }
    }
    asm volatile("s_waitcnt lgkmcnt(0)" ::: "memory");
    __builtin_amdgcn_s_barrier(); asm volatile("" ::: "memory");
    __builtin_amdgcn_s_barrier(); asm volatile("" ::: "memory");
#pragma unroll
    for (int n = 0; n < 2; ++n) {
      const int c = pn * 128 + 32 * wc + 16 * n + 4 * fq;
      const f32x4 wg0 = *(const f32x4*)(conv_w + c), wg1 = *(const f32x4*)(conv_w + 5632 + c), wg2 = *(const f32x4*)(conv_w + 2 * 5632 + c);
      const f32x4 wv0 = *(const f32x4*)(conv_w + 2816 + c), wv1 = *(const f32x4*)(conv_w + 5632 + 2816 + c), wv2 = *(const f32x4*)(conv_w + 2 * 5632 + 2816 + c);
      const f32x4 bg = *(const f32x4*)(conv_b + c), bv = *(const f32x4*)(conv_b + 2816 + c);
#pragma unroll
      for (int a = 0; a < 2; ++a) {
        const int bdp = 2 * a + wr - 1;
        f32x4 g2b = (f32x4){0.f, 0.f, 0.f, 0.f}, g1b = g2b, v2b = g2b, v1b = g2b;
        if (bdp >= 0 && fr == 0) {
          g2b = *(const LAS f32x4*)(xb + ((bdp * 2 + 0) * 2 + 0) * 128 + 32 * wc + 16 * n + 4 * fq);
          v2b = *(const LAS f32x4*)(xb + ((bdp * 2 + 0) * 2 + 1) * 128 + 32 * wc + 16 * n + 4 * fq);
          g1b = *(const LAS f32x4*)(xb + ((bdp * 2 + 1) * 2 + 0) * 128 + 32 * wc + 16 * n + 4 * fq);
          v1b = *(const LAS f32x4*)(xb + ((bdp * 2 + 1) * 2 + 1) * 128 + 32 * wc + 16 * n + 4 * fq);
        }
        f32x4 pg3, pg2, pv3, pv2;
#pragma unroll
        for (int r = 0; r < 4; ++r) {
          pg3[r] = dpp_upd<0x111>(g1b[r], acc[a][0][3][n][r]); pg2[r] = dpp_upd<0x111>(g2b[r], acc[a][0][2][n][r]);
          pv3[r] = dpp_upd<0x111>(v1b[r], acc[a][1][3][n][r]); pv2[r] = dpp_upd<0x111>(v2b[r], acc[a][1][2][n][r]);
        }
#pragma unroll
        for (int m = 0; m < 4; ++m) {
          const f32x4 cg = acc[a][0][m][n], cv = acc[a][1][m][n];
          const f32x4 s1g = m == 0 ? pg3 : acc[a][0][m == 0 ? 0 : m - 1][n], s2g = m == 0 ? pg2 : (m == 1 ? pg3 : acc[a][0][m < 2 ? 0 : m - 2][n]);
          const f32x4 s1v = m == 0 ? pv3 : acc[a][1][m == 0 ? 0 : m - 1][n], s2v = m == 0 ? pv2 : (m == 1 ? pv3 : acc[a][1][m < 2 ? 0 : m - 2][n]);
          const f32x4 G = bg + wg0 * s2g + wg1 * s1g + wg2 * cg;
          const f32x4 V = bv + wv0 * s2v + wv1 * s1v + wv2 * cv;
          const int rr = 128 * a + 64 * wr + 4 * fr + m, l = l0 + rr;
          if (rr >= 2 && l < 4096) {
            uint2 ow; ow.x = pack2(G[0] * sigm(G[0]) * V[0], G[1] * sigm(G[1]) * V[1]); ow.y = pack2(G[2] * sigm(G[2]) * V[2], G[3] * sigm(G[3]) * V[3]);
            st_nt8(act + (size_t)(seq * 4096 + l) * 2816 + c, ow);
          }
        }
      }
    }
    PROBE_STAMP_ONCE(32, xb);
  }
};

struct EpiDown {
  float* out; const bf16_t* hb; float* rsq; unsigned* cnt; const float* g; LAS float* red; bool fused;
  __device__ __forceinline__ void operator()(f32x4 (&acc)[2][2][4][2], int pm, int pn, int wr, int wc, int fr, int fq) const {
    PROBE_STAMP_ONCE(30, red);
#pragma unroll
    for (int a = 0; a < 2; ++a)
#pragma unroll
      for (int m = 0; m < 4; ++m) {
        const int row = 256 * pm + 128 * a + 64 * wr + 16 * m + fr;
        float ss = 0.f;
#pragma unroll
        for (int b = 0; b < 2; ++b)
#pragma unroll
          for (int n = 0; n < 2; ++n) {
            const int col = 256 * pn + 128 * b + 32 * wc + 16 * n + 4 * fq;
            const uint2 hw = ld_nt8(hb + (size_t)row * 1024 + col);
            f32x4 v = acc[a][b][m][n];
            v[0] += lo2f(hw.x); v[1] += hi2f(hw.x); v[2] += lo2f(hw.y); v[3] += hi2f(hw.y);
            acc[a][b][m][n] = v;
            ss += v[0] * v[0] + v[1] * v[1] + v[2] * v[2] + v[3] * v[3];
          }
        ss += __shfl_xor(ss, 16); ss += __shfl_xor(ss, 32);
        if (fused) { if (fq == 0) red[(128 * a + 64 * wr + 16 * m + fr) * 4 + wc] = ss; }
        else if (fq == 0) unsafeAtomicAdd(rsq + row, ss);
      }
    if (!fused) {
#pragma unroll
      for (int a = 0; a < 2; ++a)
#pragma unroll
        for (int m = 0; m < 4; ++m) {
          const int row = 256 * pm + 128 * a + 64 * wr + 16 * m + fr;
#pragma unroll
          for (int b = 0; b < 2; ++b)
#pragma unroll
            for (int n = 0; n < 2; ++n) {
              const int col = 256 * pn + 128 * b + 32 * wc + 16 * n + 4 * fq;
              const f32x4 v = acc[a][b][m][n];
              *(float4*)(out + (size_t)row * 1024 + col) = make_float4(v[0], v[1], v[2], v[3]);
            }
        }
      return;
    }
    asm volatile("s_waitcnt lgkmcnt(0)" ::: "memory");
    __builtin_amdgcn_s_barrier(); asm volatile("" ::: "memory");
    __builtin_amdgcn_s_barrier(); asm volatile("" ::: "memory");
    const int wid = wr * 4 + wc, lane = fq * 16 + fr;
    unsigned* c = cnt + pm * 64;
    if (wid < 4) {
      const int r = wid * 64 + lane;
      const f32x4 q = *(const LAS f32x4*)(red + r * 4);
      const float old = unsafeAtomicAdd(rsq + 256 * pm + r, (q[0] + q[1]) + (q[2] + q[3]));
      asm volatile("s_waitcnt vmcnt(0)" :: "v"(old) : "memory");
      if (lane == 0) __hip_atomic_fetch_add(c, 1u, __ATOMIC_RELAXED, __HIP_MEMORY_SCOPE_AGENT);
    }
    {
      unsigned spins = 0;
      while ((unsigned)__builtin_amdgcn_readfirstlane((int)__hip_atomic_load(c, __ATOMIC_RELAXED, __HIP_MEMORY_SCOPE_AGENT)) < 16u) {
        __builtin_amdgcn_s_sleep(2);
        if (++spins > (1u << 22)) break;
      }
    }
#pragma unroll
    for (int a = 0; a < 2; ++a)
#pragma unroll
      for (int m = 0; m < 4; ++m) {
        const int row = 256 * pm + 128 * a + 64 * wr + 16 * m + fr;
        const float rstd = rsqrtf(__hip_atomic_load(rsq + row, __ATOMIC_RELAXED, __HIP_MEMORY_SCOPE_AGENT) * (1.f / 1024.f) + 1e-6f);
#pragma unroll
        for (int b = 0; b < 2; ++b)
#pragma unroll
          for (int n = 0; n < 2; ++n) {
            const int col = 256 * pn + 128 * b + 32 * wc + 16 * n + 4 * fq;
            const float4 gv = *(const float4*)(g + col);
            const f32x4 v = acc[a][b][m][n];
            st_nt16(out + (size_t)row * 1024 + col, (f32x4){v[0] * rstd * gv.x, v[1] * rstd * gv.y, v[2] * rstd * gv.z, v[3] * rstd * gv.w});
          }
      }
  }
};

typedef _Float16 f16x2_t __attribute__((ext_vector_type(2)));
__device__ void hg_a_item(const Params& p, int item, char* smem) {
  bf16_t* kT = (bf16_t*)smem;
  bf16_t* vT = kT + 128 * 72;
  float* tot = (float*)(vT + 128 * 72);
  _Float16* Lf = (_Float16*)(smem + 40960); bf16_t* Kr = (bf16_t*)(Lf + 8192); bf16_t* Vr = Kr + 8192;
  const int tid = otid(), lane = tid & 63, wid = tid >> 6, fr = lane & 15, fq = lane >> 4;
  const int b = item >> 8, h = (item >> 6) & 3, n = item & 63;
  const int t0 = b * 4096 + n * 64;
  const int kp = tid & 63, seg = tid >> 6;
  {
    uint4 rw[6];
#pragma unroll
    for (int i = 0; i < 2; ++i) {
      const int c = tid + 512 * i, row = c >> 4, cc = c & 15;
      rw[i] = ld_nt16(p.logf + (size_t)(t0 + row) * 512 + h * 128 + cc * 8);
      rw[2 + i] = ld_nt16(p.proj + (size_t)(t0 + row) * 2048 + 512 + h * 128 + cc * 8);
      rw[4 + i] = ld_nt16(p.proj + (size_t)(t0 + row) * 2048 + 1024 + h * 128 + cc * 8);
    }
#pragma unroll
    for (int i = 0; i < 2; ++i) {
      const int c = tid + 512 * i, row = c >> 4, cc = c & 15;
      *(uint4*)(Lf + row * 128 + cc * 8) = rw[i]; *(uint4*)(Kr + row * 128 + cc * 8) = rw[2 + i]; *(uint4*)(Vr + row * 128 + cc * 8) = rw[4 + i];
    }
  }
  __syncthreads();
  float b0[8], b1[8];
  {
    float a0 = 0.f, a1 = 0.f;
#pragma unroll
    for (int i = 0; i < 8; ++i) {
      const f16x2_t l2 = *(const f16x2_t*)(Lf + (seg * 8 + i) * 128 + 2 * kp);
      a0 += (float)l2[0]; a1 += (float)l2[1]; b0[i] = a0; b1[i] = a1;
    }
    *(float2*)(tot + seg * 128 + 2 * kp) = make_float2(a0, a1);
  }
  __syncthreads();
  float pre0 = 0.f, pre1 = 0.f, all0 = 0.f, all1 = 0.f;
#pragma unroll
  for (int s8 = 0; s8 < 8; ++s8) { const float2 tv = *(const float2*)(tot + s8 * 128 + 2 * kp); if (s8 < seg) { pre0 += tv.x; pre1 += tv.y; } all0 += tv.x; all1 += tv.y; }
  {
    float k0[8], k1[8]; unsigned v0[4], v1[4];
#pragma unroll
    for (int i = 0; i < 8; ++i) {
      const unsigned kw = *(const unsigned*)(Kr + (seg * 8 + i) * 128 + 2 * kp), vw = *(const unsigned*)(Vr + (seg * 8 + i) * 128 + 2 * kp);
      k0[i] = lo2f(kw) * __expf(all0 - (b0[i] + pre0)); k1[i] = hi2f(kw) * __expf(all1 - (b1[i] + pre1));
      if (i & 1) { v0[i >> 1] |= vw << 16; v1[i >> 1] |= vw & 0xffff0000u; } else { v0[i >> 1] = vw & 0xffffu; v1[i >> 1] = vw >> 16; }
    }
    *(uint4*)(kT + (2 * kp) * 72 + seg * 8) = make_uint4(pack2(k0[0], k0[1]), pack2(k0[2], k0[3]), pack2(k0[4], k0[5]), pack2(k0[6], k0[7]));
    *(uint4*)(kT + (2 * kp + 1) * 72 + seg * 8) = make_uint4(pack2(k1[0], k1[1]), pack2(k1[2], k1[3]), pack2(k1[4], k1[5]), pack2(k1[6], k1[7]));
    *(uint4*)(vT + (2 * kp) * 72 + seg * 8) = make_uint4(v0[0], v0[1], v0[2], v0[3]);
    *(uint4*)(vT + (2 * kp + 1) * 72 + seg * 8) = make_uint4(v1[0], v1[1], v1[2], v1[3]);
    if (seg == 0) *(float2*)(p.decay + (size_t)item * 128 + 2 * kp) = make_float2(__expf(all0), __expf(all1));
  }
  __syncthreads();
  bf16x8 af[2];
#pragma unroll
  for (int ks = 0; ks < 2; ++ks) af[ks] = *(const bf16x8*)(kT + (16 * wid + fr) * 72 + 32 * ks + 8 * fq);
#pragma unroll
  for (int j = 0; j < 8; ++j) {
    f32x4 acc = (f32x4){0.f, 0.f, 0.f, 0.f};
#pragma unroll
    for (int ks = 0; ks < 2; ++ks) {
      bf16x8 bfr = *(const bf16x8*)(vT + (16 * j + fr) * 72 + 32 * ks + 8 * fq);
      acc = __builtin_amdgcn_mfma_f32_16x16x32_bf16(af[ks], bfr, acc, 0, 0, 0);
    }
    st_nt8(p.dstate + (size_t)item * 16384 + (16 * j + fr) * 128 + 16 * wid + 4 * fq, pack2(acc[0], acc[1]), pack2(acc[2], acc[3]));
  }
  __syncthreads();
}

__device__ void hg_c_item(const Params& p, int item, char* smem) {
  bf16_t* qd = (bf16_t*)smem;
  bf16_t* kd = qd + 64 * 136;
  bf16_t* vT = kd + 64 * 136;
  float* tot = (float*)(vT + 128 * 72);
  float* ssq = tot + 1024;
  _Float16* Lf = (_Float16*)(ssq + 128); bf16_t* Qr = (bf16_t*)(Lf + 8192); bf16_t* Kr = Qr + 8192; bf16_t* Vr = Kr + 8192;
  bf16_t* att = (bf16_t*)Lf;
  const int tid = otid(), lane = tid & 63, wid = tid >> 6, fr = lane & 15, fq = lane >> 4;
  const int b = item >> 8, h = (item >> 6) & 3, n = item & 63;
  const int t0 = b * 4096 + n * 64;
  const int kp = tid & 63, seg = tid >> 6;
  const int rt = wid & 3, hh = wid >> 2;
  const int token = t0 + 16 * rt + fr;
  uint2 gw[4]; float4 g4[4];
  {
    uint4 rw[8];
#pragma unroll
    for (int i = 0; i < 2; ++i) {
      const int c = tid + 512 * i, row = c >> 4, cc = c & 15;
      rw[i] = ld_nt16(p.logf + (size_t)(t0 + row) * 512 + h * 128 + cc * 8);
      rw[2 + i] = ld_nt16(p.proj + (size_t)(t0 + row) * 2048 + h * 128 + cc * 8);
      rw[4 + i] = ld_nt16(p.proj + (size_t)(t0 + row) * 2048 + 512 + h * 128 + cc * 8);
      rw[6 + i] = ld_nt16(p.proj + (size_t)(t0 + row) * 2048 + 1024 + h * 128 + cc * 8);
    }
#pragma unroll
    for (int j = 0; j < 4; ++j) {
      const int col = h * 128 + 16 * (4 * hh + j) + 4 * fq;
      gw[j] = ld_nt8(p.proj + (size_t)token * 2048 + 1536 + col);
      g4[j] = *(const float4*)(p.hg_norm_g + col);
    }
#pragma unroll
    for (int i = 0; i < 2; ++i) {
      const int c = tid + 512 * i, row = c >> 4, cc = c & 15;
      *(uint4*)(Lf + row * 128 + cc * 8) = rw[i]; *(uint4*)(Qr + row * 128 + cc * 8) = rw[2 + i]; *(uint4*)(Kr + row * 128 + cc * 8) = rw[4 + i]; *(uint4*)(Vr + row * 128 + cc * 8) = rw[6 + i];
    }
  }
  __syncthreads();
  float b0[8], b1[8];
  {
    float a0 = 0.f, a1 = 0.f;
#pragma unroll
    for (int i = 0; i < 8; ++i) {
      const f16x2_t l2 = *(const f16x2_t*)(Lf + (seg * 8 + i) * 128 + 2 * kp);
      a0 += (float)l2[0]; a1 += (float)l2[1]; b0[i] = a0; b1[i] = a1;
    }
    *(float2*)(tot + seg * 128 + 2 * kp) = make_float2(a0, a1);
  }
  __syncthreads();
  const bf16_t* sp = p.sstart + (size_t)item * 16384;
  bf16x8 sf[4][4];
#pragma unroll
  for (int ks = 0; ks < 4; ++ks)
#pragma unroll
    for (int j = 0; j < 4; ++j) sf[ks][j] = *(const bf16x8*)(sp + (16 * (4 * hh + j) + fr) * 128 + 32 * ks + 8 * fq);
  float pre0 = 0.f, pre1 = 0.f;
#pragma unroll
  for (int s8 = 0; s8 < 8; ++s8) { const float2 tv = *(const float2*)(tot + s8 * 128 + 2 * kp); if (s8 < seg) { pre0 += tv.x; pre1 += tv.y; } }
  {
    unsigned v0[4], v1[4];
#pragma unroll
    for (int i = 0; i < 8; ++i) {
      const int r = seg * 8 + i;
      const unsigned qw = *(const unsigned*)(Qr + r * 128 + 2 * kp), kw = *(const unsigned*)(Kr + r * 128 + 2 * kp), vw = *(const unsigned*)(Vr + r * 128 + 2 * kp);
      const float bb0 = b0[i] + pre0, bb1 = b1[i] + pre1;
      *(unsigned*)(qd + r * 136 + 2 * kp) = pack2(lo2f(qw) * __expf(bb0), hi2f(qw) * __expf(bb1));
      *(unsigned*)(kd + r * 136 + 2 * kp) = pack2(lo2f(kw) * __expf(-bb0), hi2f(kw) * __expf(-bb1));
      if (i & 1) { v0[i >> 1] |= vw << 16; v1[i >> 1] |= vw & 0xffff0000u; } else { v0[i >> 1] = vw & 0xffffu; v1[i >> 1] = vw >> 16; }
    }
    *(uint4*)(vT + (2 * kp) * 72 + seg * 8) = make_uint4(v0[0], v0[1], v0[2], v0[3]);
    *(uint4*)(vT + (2 * kp + 1) * 72 + seg * 8) = make_uint4(v1[0], v1[1], v1[2], v1[3]);
  }
  __syncthreads();
#pragma unroll
  for (int st2 = 0; st2 < 2; ++st2) {
    const int st = 2 * hh + st2;
    f32x4 acc = (f32x4){0.f, 0.f, 0.f, 0.f};
#pragma unroll
    for (int ks = 0; ks < 4; ++ks) {
      bf16x8 a = *(const bf16x8*)(kd + (16 * st + fr) * 136 + 32 * ks + 8 * fq);
      bf16x8 bq = *(const bf16x8*)(qd + (16 * rt + fr) * 136 + 32 * ks + 8 * fq);
      acc = __builtin_amdgcn_mfma_f32_16x16x32_bf16(a, bq, acc, 0, 0, 0);
    }
    const int c = 16 * rt + fr, s0 = 16 * st + 4 * fq;
    float v0 = (s0 + 0 <= c) ? acc[0] : 0.f, v1 = (s0 + 1 <= c) ? acc[1] : 0.f, v2 = (s0 + 2 <= c) ? acc[2] : 0.f, v3 = (s0 + 3 <= c) ? acc[3] : 0.f;
    uint2 o; o.x = pack2(v0, v1); o.y = pack2(v2, v3);
    *(uint2*)(att + c * 72 + s0) = o;
  }
  __syncthreads();
  f32x4 o[4];
#pragma unroll
  for (int j = 0; j < 4; ++j) o[j] = (f32x4){0.f, 0.f, 0.f, 0.f};
#pragma unroll
  for (int ks = 0; ks < 2; ++ks) {
    bf16x8 bq = *(const bf16x8*)(att + (16 * rt + fr) * 72 + 32 * ks + 8 * fq);
#pragma unroll
    for (int j = 0; j < 4; ++j) {
      bf16x8 a = *(const bf16x8*)(vT + (16 * (4 * hh + j) + fr) * 72 + 32 * ks + 8 * fq);
      o[j] = __builtin_amdgcn_mfma_f32_16x16x32_bf16(a, bq, o[j], 0, 0, 0);
    }
  }
#pragma unroll
  for (int ks = 0; ks < 4; ++ks) {
    bf16x8 bq = *(const bf16x8*)(qd + (16 * rt + fr) * 136 + 32 * ks + 8 * fq);
#pragma unroll
    for (int j = 0; j < 4; ++j) o[j] = __builtin_amdgcn_mfma_f32_16x16x32_bf16(sf[ks][j], bq, o[j], 0, 0, 0);
  }
  float ss = 0.f;
#pragma unroll
  for (int j = 0; j < 4; ++j) ss += o[j][0] * o[j][0] + o[j][1] * o[j][1] + o[j][2] * o[j][2] + o[j][3] * o[j][3];
  ss += __shfl_xor(ss, 16); ss += __shfl_xor(ss, 32);
  if (fq == 0) ssq[hh * 64 + 16 * rt + fr] = ss;
  __syncthreads();
  const float tss = ssq[16 * rt + fr] + ssq[64 + 16 * rt + fr];
  const float rstd = rsqrtf(tss * (1.f / 128.f) + 1e-6f);
#pragma unroll
  for (int j = 0; j < 4; ++j) {
    const int col = h * 128 + 16 * (4 * hh + j) + 4 * fq;
    float z0 = lo2f(gw[j].x), z1 = hi2f(gw[j].x), z2 = lo2f(gw[j].y), z3 = hi2f(gw[j].y);
    float r0 = o[j][0] * rstd * g4[j].x * z0 * sigm(z0), r1 = o[j][1] * rstd * g4[j].y * z1 * sigm(z1);
    float r2 = o[j][2] * rstd * g4[j].z * z2 * sigm(z2), r3 = o[j][3] * rstd * g4[j].w * z3 * sigm(z3);
    uint2 ow; ow.x = pack2(r0, r1); ow.y = pack2(r2, r3);
    st_nt8(p.mix + (size_t)token * 1024 + col, ow);
  }
  __syncthreads();
}

__device__ void s5_a_block(const Params& p, int g, int to, char* smem) {
  const int tid = otid(), lane = tid & 63, wid = tid >> 6, fr = lane & 15, fq = lane >> 4;
  const int tt = to * 8 + wid;
  bf16x8 U[8];
#pragma unroll
  for (int ks = 0; ks < 8; ++ks) {
    const int tok = tt * 256 + 16 * fr + 2 * ks + (fq >> 1);
    U[ks] = *(const bf16x8*)(p.ubuf + ((size_t)g * T + tok) * 16 + 8 * (fq & 1));
  }
  {
    const uint4* src = (const uint4*)(p.Ftab + (size_t)g * 128 * 256);
    uint4 v[8];
#pragma unroll
    for (int i = 0; i < 8; ++i) v[i] = src[tid + 512 * i];
#pragma unroll
    for (int i = 0; i < 8; ++i) { const int c = tid + 512 * i; *(uint4*)(smem + (c >> 5) * 528 + (c & 31) * 16) = v[i]; }
  }
  __syncthreads();
#pragma unroll
  for (int rt = 0; rt < 8; ++rt) {
    f32x4 acc = (f32x4){0.f, 0.f, 0.f, 0.f};
#pragma unroll
    for (int ks = 0; ks < 8; ++ks) {
      bf16x8 a = *(const bf16x8*)(smem + (16 * rt + fr) * 528 + 64 * ks + 16 * fq);
      acc = __builtin_amdgcn_mfma_f32_16x16x32_bf16(a, U[ks], acc, 0, 0, 0);
    }
    *(f32x4*)(p.Xend + ((size_t)(tt * 16 + fr) * 32 + g) * 128 + 16 * rt + 4 * fq) = acc;
  }
  __syncthreads();
}

__device__ void s5_c_block(const Params& p, int g, int to, char* smem) {
  const int tid = otid(), lane = tid & 63, wid = tid >> 6, fr = lane & 15, fq = lane >> 4;
  const int tt = to * 8 + wid;
  bf16x8 U[8], Kf[16], Xf[4];
#pragma unroll
  for (int ks = 0; ks < 8; ++ks) {
    const int tok = tt * 256 + 16 * fr + 2 * ks + (fq >> 1);
    U[ks] = *(const bf16x8*)(p.ubuf + ((size_t)g * T + tok) * 16 + 8 * (fq & 1));
  }
#pragma unroll
  for (int d = 0; d < 16; ++d) {
    const int tau = d - (fq >> 1);
    bf16x8 z = (bf16x8){0, 0, 0, 0, 0, 0, 0, 0};
    if (tau >= 0) z = *(const bf16x8*)(p.Ktab + (size_t)((g * 16 + tau) * 16 + fr) * 16 + 8 * (fq & 1));
    Kf[d] = z;
  }
#pragma unroll
  for (int ks = 0; ks < 4; ++ks) Xf[ks] = *(const bf16x8*)(p.Xs + ((size_t)(tt * 16 + fr) * 32 + g) * 128 + 32 * ks + 8 * fq);
  const int c0 = g * 16 + 4 * fq;
  const float4 dsk = *(const float4*)(p.s5_d + c0);
  uint2 uw[16];
#pragma unroll
  for (int t = 0; t < 16; ++t) uw[t] = *(const uint2*)(p.ubuf + ((size_t)g * T + tt * 256 + 16 * fr + t) * 16 + 4 * fq);
  {
    const uint4* src = (const uint4*)(p.Etab + (size_t)g * 256 * 128);
    uint4 v[8];
#pragma unroll
    for (int i = 0; i < 8; ++i) v[i] = src[tid + 512 * i];
#pragma unroll
    for (int i = 0; i < 8; ++i) { const int c = tid + 512 * i; *(uint4*)(smem + (c >> 4) * 272 + (c & 15) * 16) = v[i]; }
  }
  __syncthreads();
#pragma unroll
  for (int t = 0; t < 16; ++t) {
    f32x4 acc = (f32x4){0.f, 0.f, 0.f, 0.f};
#pragma unroll
    for (int ks = 0; ks <= t / 2; ++ks) acc = __builtin_amdgcn_mfma_f32_16x16x32_bf16(Kf[t - 2 * ks], U[ks], acc, 0, 0, 0);
#pragma unroll
    for (int ks = 0; ks < 4; ++ks) {
      bf16x8 a = *(const bf16x8*)(smem + (t * 16 + fr) * 272 + 64 * ks + 16 * fq);
      acc = __builtin_amdgcn_mfma_f32_16x16x32_bf16(a, Xf[ks], acc, 0, 0, 0);
    }
    const int token = tt * 256 + 16 * fr + t;
    float y0 = acc[0] + dsk.x * lo2f(uw[t].x), y1 = acc[1] + dsk.y * hi2f(uw[t].x), y2 = acc[2] + dsk.z * lo2f(uw[t].y), y3 = acc[3] + dsk.w * hi2f(uw[t].y);
    uint2 ow; ow.x = pack2(gelu_tanh(y0), gelu_tanh(y1)); ow.y = pack2(gelu_tanh(y2), gelu_tanh(y3));
    st_nt8(p.ybuf + ((size_t)g * T + token) * 16 + 4 * fq, ow);
  }
  __syncthreads();
}

#define XB_TMO      128
#define XB_XCNT(j)  (256  + 64 * (j))
#define XB_XSUB(j)  (1280 + 64 * (j))
#define XB_XGEN(j)  (2304 + 64 * (j))
#define XB_TOP      3328
#define XB_TOPGEN   3392
#define XCD_BAR_WORDS 3456
#define XB_SPIN_CAP (1u << 20)
__device__ __forceinline__ unsigned xb_ld(unsigned* p) { return __hip_atomic_load(p, __ATOMIC_RELAXED, __HIP_MEMORY_SCOPE_AGENT); }
__device__ __forceinline__ unsigned xb_add(unsigned* p, unsigned v) { return __hip_atomic_fetch_add(p, v, __ATOMIC_RELAXED, __HIP_MEMORY_SCOPE_AGENT); }
__device__ __forceinline__ unsigned xb_xcc_id() { return (unsigned)__builtin_amdgcn_s_getreg((3 << 11) | 20) & 0xFu; }
#define XB_SPIN(cond, bar) do { unsigned _sp = 0; while (cond) { __builtin_amdgcn_s_sleep(1); \
    if ((++_sp & 255u) == 0u) { if (xb_ld(&(bar)[XB_TMO])) break; if (_sp > XB_SPIN_CAP) { atomicAdd(&(bar)[XB_TMO], 1u); break; } } } } while (0)
struct XcdBarrier { unsigned* bar; unsigned x; volatile LAS unsigned* st; };
__device__ __forceinline__ XcdBarrier xcd_barrier_post(unsigned* bar, volatile LAS unsigned* st) {
  XcdBarrier b; b.bar = bar; b.x = xb_xcc_id(); b.st = st;
  if (threadIdx.x == 0) (void)xb_add(&bar[XB_XCNT(b.x)], 1u);
  return b;
}
__device__ __forceinline__ void xcd_barrier_complete(unsigned* bar, unsigned x, unsigned& nloc, unsigned& nx) {
  const unsigned G = gridDim.x * gridDim.y * gridDim.z;
  unsigned sum, cnt, mine, sp = 0u;
  for (;;) {
    sum = 0u; cnt = 0u; mine = 0u;
#pragma unroll
    for (unsigned j = 0; j < 16; ++j) { const unsigned c = xb_ld(&bar[XB_XCNT(j)]); sum += c; cnt += (c > 0u) ? 1u : 0u; mine = (j == x) ? c : mine; }
    if (sum == G) break;
    __builtin_amdgcn_s_sleep(1);
    if ((++sp & 255u) == 0u) { if (xb_ld(&bar[XB_TMO])) break; if (sp > XB_SPIN_CAP) { atomicAdd(&bar[XB_TMO], 1u); break; } }
  }
  nloc = mine > 0u ? mine : 1u; nx = cnt > 0u ? cnt : 1u;
}
__device__ __forceinline__ void xcd_barrier(const XcdBarrier& b) {
  asm volatile("s_waitcnt vmcnt(0)" ::: "memory");
  __syncthreads();
  if (threadIdx.x == 0) {
    unsigned* bar = b.bar;
    __builtin_amdgcn_s_waitcnt(0);
    unsigned nloc = b.st[0], nx = b.st[1];
    if (nloc == 0u) { xcd_barrier_complete(bar, b.x, nloc, nx); b.st[0] = nloc; b.st[1] = nx; }
    const unsigned old = xb_add(&bar[XB_XSUB(b.x)], 1u);
    const unsigned gen = old / nloc;
    if (old + 1u == (gen + 1u) * nloc) {
      __builtin_amdgcn_fence(__ATOMIC_RELEASE, "agent");
      asm volatile("s_waitcnt vmcnt(0)" ::: "memory");
      const unsigned og = xb_add(&bar[XB_TOP], 1u);
      const unsigned tg = og / nx;
      if (og + 1u == (tg + 1u) * nx) xb_add(&bar[XB_TOPGEN], 1u);
      else XB_SPIN(xb_ld(&bar[XB_TOPGEN]) == tg, bar);
      __builtin_amdgcn_fence(__ATOMIC_ACQUIRE, "agent");
      xb_add(&bar[XB_XGEN(b.x)], 1u);
      asm volatile("s_waitcnt vmcnt(0)" ::: "memory");
    } else {
      XB_SPIN(xb_ld(&bar[XB_XGEN(b.x)]) == gen, bar);
      __builtin_amdgcn_fence(__ATOMIC_ACQUIRE, "agent");
      asm volatile("s_waitcnt vmcnt(0)" ::: "memory");
    }
  }
  __syncthreads();
}

__device__ void phase_mix_a(const Params& p, char* smem, int part) {
  if (part == 0) { for (int it = blockIdx.x; it < 1024; it += gridDim.x) hg_a_item(p, it, smem); }
  else { for (int u = blockIdx.x; u < 256; u += gridDim.x) s5_a_block(p, u & 31, u >> 5, smem); }
}

__device__ void phase_scan(const Params& p) {
  int tid = otid();
  if (tid < 128) {
    for (int it = blockIdx.x * 128 + tid; it < 32768; it += gridDim.x * 128) {
      const int seg = it & 3, ch = it >> 2;
      const int bt = ch >> 11, g = (ch >> 6) & 31, n = ch & 63;
      const float2 a = p.Pw[g * 64 + n];
      const size_t base = ((size_t)(bt * 256 + seg * 64) * 32 + g) * 128 + n;
      const float* __restrict__ xe = p.Xend + base;
      bf16_t* __restrict__ xs = p.Xs + base;
      float xr = 0.f, xi = 0.f;
#pragma unroll 1
      for (int h = 0; h < 2; ++h) {
        float er[32], ei[32];
#pragma unroll
        for (int j = 0; j < 32; ++j) { er[j] = xe[(size_t)(h * 32 + j) * 4096]; ei[j] = xe[(size_t)(h * 32 + j) * 4096 + 64]; }
#pragma unroll
        for (int j = 0; j < 32; ++j) { const float nr = a.x * xr - a.y * xi + er[j], ni = a.x * xi + a.y * xr + ei[j]; xr = nr; xi = ni; }
      }
      float Ar = a.x, Ai = a.y;
#pragma unroll
      for (int q = 0; q < 6; ++q) { const float t = Ar * Ar - Ai * Ai; Ai = 2.f * Ar * Ai; Ar = t; }
      const int lb = (tid & 63) & ~3;
      const float e0r = __shfl(xr, lb), e0i = __shfl(xi, lb), e1r = __shfl(xr, lb + 1), e1i = __shfl(xi, lb + 1), e2r = __shfl(xr, lb + 2), e2i = __shfl(xi, lb + 2);
      const float s2r = Ar * e0r - Ai * e0i + e1r, s2i = Ar * e0i + Ai * e0r + e1i;
      const float s3r = Ar * s2r - Ai * s2i + e2r, s3i = Ar * s2i + Ai * s2r + e2i;
      xr = seg == 0 ? 0.f : (seg == 1 ? e0r : (seg == 2 ? s2r : s3r));
      xi = seg == 0 ? 0.f : (seg == 1 ? e0i : (seg == 2 ? s2i : s3i));
#pragma unroll 1
      for (int h = 0; h < 2; ++h) {
        float er[32], ei[32];
#pragma unroll
        for (int j = 0; j < 32; ++j) { er[j] = xe[(size_t)(h * 32 + j) * 4096]; ei[j] = xe[(size_t)(h * 32 + j) * 4096 + 64]; }
#pragma unroll
        for (int j = 0; j < 32; ++j) {
          xs[(size_t)(h * 32 + j) * 4096] = f2bf(xr); xs[(size_t)(h * 32 + j) * 4096 + 64] = f2bf(xi);
          const float nr = a.x * xr - a.y * xi + er[j], ni = a.x * xi + a.y * xr + ei[j]; xr = nr; xi = ni;
        }
      }
    }
  }
  const int gtid = blockIdx.x * NTHR + tid, gthr = gridDim.x * NTHR;
  for (int e2 = gtid; e2 < 16 * 8192; e2 += gthr) {
    const int bh = e2 >> 13, e = (e2 & 8191) * 2, k = e & 127;
    const bf16_t* __restrict__ dsp = p.dstate + (size_t)bh * 64 * 16384 + e;
    const float* __restrict__ dcp = p.decay + (size_t)bh * 64 * 128 + k;
    bf16_t* __restrict__ sp = p.sstart + (size_t)bh * 64 * 16384 + e;
    float sx = 0.f, sy = 0.f;
#pragma unroll 1
    for (int n0 = 0; n0 < 64; n0 += 32) {
      unsigned ds[32]; float2 dc[32];
#pragma unroll
      for (int j = 0; j < 32; ++j) { ds[j] = ld_nt4(dsp + (size_t)(n0 + j) * 16384); dc[j] = *(const float2*)(dcp + (n0 + j) * 128); }
#pragma unroll
      for (int j = 0; j < 32; ++j) {
        *(unsigned*)(sp + (size_t)(n0 + j) * 16384) = pack2(sx, sy);
        sx = dc[j].x * sx + lo2f(ds[j]); sy = dc[j].y * sy + hi2f(ds[j]);
      }
    }
  }
}

__device__ void phase_mix_c(const Params& p, char* smem, int part) {
  if (part == 0) {
    if (gridDim.x == 256) {
      const int b = blockIdx.x, first = b < 128 ? b * 3 : 384 + (b - 128) * 5, cnt = b < 128 ? 3 : 5;
      for (int j = 0; j < cnt; ++j) hg_c_item(p, first + j, smem);
    } else { for (int it = blockIdx.x; it < 1024; it += gridDim.x) hg_c_item(p, it, smem); }
  }
  else { for (int u = blockIdx.x; u < 256; u += gridDim.x) s5_c_block(p, u & 31, u >> 5, smem); }
}

__device__ void phase_final(const Params& p) {
  int tid_ = otid();
  const int lane = tid_ & 63, wid = tid_ >> 6;
  for (int row0 = (blockIdx.x * 8 + wid) * 4; row0 < T; row0 += gridDim.x * 32) {
    float4 v[4][4]; float rs[4];
#pragma unroll
    for (int r = 0; r < 4; ++r) {
      const float4* op = (const float4*)(p.out + (size_t)(row0 + r) * 1024);
#pragma unroll
      for (int i = 0; i < 4; ++i) v[r][i] = op[lane + 64 * i];
      rs[r] = rsqrtf(p.rsq2[row0 + r] * (1.f / 1024.f) + 1e-6f);
    }
#pragma unroll
    for (int i = 0; i < 4; ++i) {
      const float4 g = ((const float4*)p.final_g)[lane + 64 * i];
#pragma unroll
      for (int r = 0; r < 4; ++r) {
        float4 w = v[r][i];
        w.x *= rs[r] * g.x; w.y *= rs[r] * g.y; w.z *= rs[r] * g.z; w.w *= rs[r] * g.w;
        ((float4*)(p.out + (size_t)(row0 + r) * 1024))[lane + 64 * i] = w;
      }
    }
  }
}

template <int PH>
__device__ __forceinline__ void run_phase(const Params& p, char* smem) {
  if (PH == 0) phase_prep(p, smem);
  if (PH == 100) phase_prep_xn(p);
  if (PH == 1) {
    EpiProj e{p.proj, p.ubuf, p.logf, p.hg_lb}; gemm_phase(p.xn, p.Wt_in, T, 2560, 1024, e, smem);
    if (gridDim.x == 256 && blockIdx.x >= 128)
      for (int t = 160 + ((int)blockIdx.x - 128); t < 768; t += 128) transpose_any(p, t, (float*)smem);
  }
  if (PH == 2) phase_mix_a(p, smem, 0);
  if (PH == 102) phase_mix_a(p, smem, 1);
  if (PH == 3) phase_scan(p);
  if (PH == 4) phase_mix_c(p, smem, 1);
  if (PH == 104) { }
  if (PH == 5) { EpiGlu e{p.ybuf, p.b_glu, p.mix}; gemm_phase(p.ybuf, p.Wt_glu, T, 512, 512, e, smem, RowMapGroupMajor()); phase_mix_c(p, smem, 0); }
  if (PH == 6) { EpiOut e{p.x, p.hb, p.rsq1}; gemm_phase(p.mix, p.Wt_out, T, 1024, 1024, e, smem); }
  if (PH == 7) { EpiUpConv e{p.act, p.rsq1, p.conv_w, p.conv_b, (LAS float*)((LAS unsigned char*)smem + 131088)}; gemm_phase(p.hb, p.Wt_up, 68 * 256, 5632, 1024, e, smem, RowMapConv()); }
  if (PH == 8) { EpiDown e{p.out, p.hb, p.rsq2, p.bar + XCD_BAR_WORDS, p.final_g, (LAS float*)((LAS unsigned char*)smem + 131088), gridDim.x >= 256}; gemm_phase(p.act, p.Wt_down, T, 1024, 2816, e, smem); }
  if (PH == 9) { if (gridDim.x < 256) phase_final(p); }
}

#if MK_FUSED
#define PROBE_MARK(k) do { if (PROBE_K == (k)) t_mark = __builtin_amdgcn_s_memrealtime(); } while (0)
__global__ void __launch_bounds__(NTHR) fwd_megakernel(Params p) {
  extern __shared__ __attribute__((aligned(16))) char smem[];
  volatile LAS unsigned* st = (volatile LAS unsigned*)((LAS unsigned char*)smem + 131072);
  if (threadIdx.x == 0) { st[0] = 0u; st[1] = 0u; st[2] = 0u; st[3] = 0u; }
  __syncthreads();
  const XcdBarrier xb = xcd_barrier_post(p.bar, st);
  unsigned long long t_start = 0, t_mark = 0;
  if (PROBE_K >= 0) { t_start = __builtin_amdgcn_s_memrealtime(); t_mark = t_start; }
  run_phase<0>(p, smem); PROBE_MARK(21); run_phase<100>(p, smem); PROBE_MARK(20);
  cg::this_grid().sync(); PROBE_MARK(0);
  run_phase<1>(p, smem); xcd_barrier(xb); PROBE_MARK(1);
  run_phase<2>(p, smem); PROBE_MARK(23); run_phase<102>(p, smem); xcd_barrier(xb); PROBE_MARK(2);
  run_phase<3>(p, smem); PROBE_MARK(40); xcd_barrier(xb); PROBE_MARK(3);
  run_phase<4>(p, smem); PROBE_MARK(22); run_phase<104>(p, smem); xcd_barrier(xb); PROBE_MARK(4);
  run_phase<5>(p, smem); xcd_barrier(xb); PROBE_MARK(5);
  run_phase<6>(p, smem); xcd_barrier(xb); PROBE_MARK(6);
  run_phase<7>(p, smem); PROBE_MARK(41); xcd_barrier(xb); PROBE_MARK(7);
  run_phase<8>(p, smem);
  if (gridDim.x < 256) { xcd_barrier(xb); run_phase<9>(p, smem); }
  if (PROBE_K >= 30 && PROBE_K < 40) t_mark = *(volatile LAS unsigned long long*)((LAS unsigned char*)smem + 131080);
  if (PROBE_K >= 0) {
    const unsigned long long t_end = __builtin_amdgcn_s_memrealtime();
    const unsigned long long until = t_end + 4ull * (t_mark - t_start);
    while (__builtin_amdgcn_s_memrealtime() < until) __builtin_amdgcn_s_sleep(8);
  }
}
#else
template <int PH>
__global__ void __launch_bounds__(NTHR) phase_kernel(Params p) {
  extern __shared__ __attribute__((aligned(16))) char smem[];
  run_phase<PH>(p, smem);
}
template <int PH>
static void launch_phase(const Params& p, int grid, hipStream_t stream) {
  (void)hipFuncSetAttribute((const void*)phase_kernel<PH>, hipFuncAttributeMaxDynamicSharedMemorySize, LDS_BYTES);
  hipLaunchKernelGGL(phase_kernel<PH>, dim3(grid), dim3(NTHR), LDS_BYTES, stream, p);
}
#endif

extern "C" void kernel_launch(void* const* d_in, const int* in_sizes, int n_in, void* d_out, int out_size, void* d_ws,
                              size_t ws_size, hipStream_t stream) {
  Params p{};
  p.x = (const float*)d_in[0]; p.in_norm_g = (const float*)d_in[1]; p.w_in = (const float*)d_in[2]; p.hg_lb = (const float*)d_in[3];
  p.hg_norm_g = (const float*)d_in[4]; p.a_re = (const float*)d_in[5]; p.a_im = (const float*)d_in[6]; p.log_dt = (const float*)d_in[7];
  p.b_re = (const float*)d_in[8]; p.b_im = (const float*)d_in[9]; p.c_re = (const float*)d_in[10]; p.c_im = (const float*)d_in[11];
  p.s5_d = (const float*)d_in[12]; p.w_glu = (const float*)d_in[13]; p.b_glu = (const float*)d_in[14]; p.w_out = (const float*)d_in[15];
  p.ffn_norm_g = (const float*)d_in[16]; p.w_up = (const float*)d_in[17]; p.conv_w = (const float*)d_in[18]; p.conv_b = (const float*)d_in[19];
  p.w_down = (const float*)d_in[20]; p.final_g = (const float*)d_in[21];
  p.out = (float*)d_out;
  char* ws = (char*)d_ws;
  size_t off = 0;
  auto take = [&](size_t bytes) { char* r = ws + off; off += (bytes + 255) & ~(size_t)255; return r; };
  p.Wt_in = (bf16_t*)take((size_t)2560 * 1024 * 2);
  p.Wt_glu = (bf16_t*)take((size_t)512 * 512 * 2);
  p.Wt_out = (bf16_t*)take((size_t)1024 * 1024 * 2);
  p.Wt_up = (bf16_t*)take((size_t)5632 * 1024 * 2);
  p.Wt_down = (bf16_t*)take((size_t)1024 * 2816 * 2);
  p.Ktab = (bf16_t*)take((size_t)32 * 16 * 256 * 2);
  p.Etab = (bf16_t*)take((size_t)32 * 256 * 128 * 2);
  p.Ftab = (bf16_t*)take((size_t)32 * 128 * 256 * 2);
  p.Pw = (float2*)take((size_t)32 * 17 * 64 * 8);
  p.Bbar = (float2*)take((size_t)32 * 64 * 16 * 8);
  p.rsq1 = (float*)take((size_t)T * 16 * 4);
  p.rsq2 = (float*)take((size_t)T * 16 * 4);
  p.decay = (float*)take((size_t)1024 * 128 * 4);
  p.bar = (unsigned*)take((size_t)(XCD_BAR_WORDS + 64 * 64) * 4);
  const size_t dyn0 = off;
  p.xn = (bf16_t*)take((size_t)T * 1024 * 2);
  p.sstart = p.xn; p.hb = p.xn;
  const size_t r2 = off;
  p.proj = (bf16_t*)take((size_t)T * 2048 * 2);
  p.ubuf = (bf16_t*)take((size_t)T * 512 * 2);
  p.logf = (_Float16*)take((size_t)T * 512 * 4);
  p.mix = (bf16_t*)take((size_t)T * 1024 * 2);
  p.ybuf = (bf16_t*)take((size_t)T * 512 * 2);
  p.Xend = (float*)take((size_t)1024 * 32 * 128 * 4);
  p.Xs = (bf16_t*)take((size_t)1024 * 32 * 128 * 2);
  const size_t endA = off;
  p.dstate = (bf16_t*)d_out;
  off = r2;
  p.act = (bf16_t*)take((size_t)T * 2816 * 2);
  const size_t endB = off;
  (void)dyn0;
  if (endA > ws_size || endB > ws_size) fprintf(stderr, "workspace too small: need %zu / %zu have %zu\n", endA, endB, ws_size);

  static int grid_blocks = 0;
#if MK_FUSED
  if (!grid_blocks) {
    int dev = 0, cus = 0, per_cu = 0;
    (void)hipGetDevice(&dev);
    (void)hipDeviceGetAttribute(&cus, hipDeviceAttributeMultiprocessorCount, dev);
    (void)hipFuncSetAttribute((const void*)fwd_megakernel, hipFuncAttributeMaxDynamicSharedMemorySize, LDS_BYTES);
    (void)hipOccupancyMaxActiveBlocksPerMultiprocessor(&per_cu, fwd_megakernel, NTHR, LDS_BYTES);
    if (per_cu > 1) per_cu = 1;
    grid_blocks = cus * per_cu;
  }
  (void)hipMemsetAsync(p.bar, 0, (size_t)(XCD_BAR_WORDS + 64 * 64) * 4, stream);
  void* args[] = {&p};
  hipError_t e = hipLaunchCooperativeKernel((void*)fwd_megakernel, dim3(grid_blocks), dim3(NTHR), args, LDS_BYTES, stream);
  if (e != hipSuccess) fprintf(stderr, "cooperative launch failed: %s (grid %d)\n", hipGetErrorString(e), grid_blocks);
#else
  if (!grid_blocks) {
    int dev = 0, cus = 0;
    (void)hipGetDevice(&dev);
    (void)hipDeviceGetAttribute(&cus, hipDeviceAttributeMultiprocessorCount, dev);
    grid_blocks = cus;
  }
  launch_phase<0>(p, grid_blocks, stream);
  launch_phase<100>(p, grid_blocks, stream);
  launch_phase<1>(p, grid_blocks, stream);
  launch_phase<2>(p, grid_blocks, stream);
  launch_phase<102>(p, grid_blocks, stream);
  launch_phase<3>(p, grid_blocks, stream);
  launch_phase<4>(p, grid_blocks, stream);
  launch_phase<104>(p, grid_blocks, stream);
  launch_phase<5>(p, grid_blocks, stream);
  launch_phase<6>(p, grid_blocks, stream);
  launch_phase<7>(p, grid_blocks, stream);
  launch_phase<8>(p, grid_blocks, stream);
  launch_phase<9>(p, grid_blocks, stream);
#endif
}
```

```cpp
#include <hip/hip_runtime.h>
#include <hip/hip_cooperative_groups.h>
#include <stdint.h>
#include <cstdio>
namespace cg = cooperative_groups;

#ifndef PROBE_K
#define PROBE_K -1
#endif
#ifndef MK_FUSED
#define MK_FUSED 1
#endif

typedef unsigned short bf16_t;
typedef short bf16x8 __attribute__((ext_vector_type(8)));
typedef float f32x4 __attribute__((ext_vector_type(4)));

constexpr int T = 16384;
constexpr int NTHR = 512;
constexpr int LDS_BYTES = 128 * 1024 + 16 + 6144;

struct Params {
  const float *x, *in_norm_g, *w_in, *hg_lb, *hg_norm_g, *a_re, *a_im, *log_dt, *b_re, *b_im, *c_re, *c_im, *s5_d,
      *w_glu, *b_glu, *w_out, *ffn_norm_g, *w_up, *conv_w, *conv_b, *w_down, *final_g;
  float* out;
  bf16_t *Wt_in, *Wt_glu, *Wt_out, *Wt_up, *Wt_down, *xn, *proj, *sstart, *Xs, *mix, *ybuf, *ubuf, *hb, *hid, *act, *Ktab, *Etab, *Ftab;
  _Float16* logf; bf16_t* dstate;
  float *decay, *Xend, *rsq1, *rsq2;
  float2 *Pw, *Bbar;
  unsigned* bar;
};

__device__ __forceinline__ int otid() { int t = threadIdx.x; asm volatile("" : "+v"(t)); return t; }
typedef float f32x2_t __attribute__((ext_vector_type(2)));
typedef __bf16 bf16x2_t __attribute__((ext_vector_type(2)));
__device__ __forceinline__ unsigned pack2(float a, float b) { f32x2_t v = {a, b}; bf16x2_t h = __builtin_convertvector(v, bf16x2_t); return __builtin_bit_cast(unsigned, h); }
__device__ __forceinline__ bf16_t f2bf(float f) { return (bf16_t)(pack2(f, f) & 0xffffu); }
__device__ __forceinline__ float bf2f(bf16_t h) { return __uint_as_float(((unsigned)h) << 16); }
__device__ __forceinline__ float lo2f(unsigned w) { return __uint_as_float(w << 16); }
__device__ __forceinline__ float hi2f(unsigned w) { return __uint_as_float(w & 0xffff0000u); }
__device__ __forceinline__ float sigm(float x) { return __builtin_amdgcn_rcpf(1.f + __expf(-x)); }
__device__ __forceinline__ float gelu_tanh(float y) {
  float u = 0.7978845608028654f * (y + 0.044715f * y * y * y);
  return y * sigm(2.f * u);
}

typedef unsigned u32x2 __attribute__((ext_vector_type(2)));
typedef unsigned u32x4_t __attribute__((ext_vector_type(4)));
__device__ __forceinline__ void st_nt8(void* p, unsigned a, unsigned b) { u32x2 v; v.x = a; v.y = b; *(u32x2*)p = v; }
__device__ __forceinline__ void st_nt8(void* p, uint2 w) { st_nt8(p, w.x, w.y); }
__device__ __forceinline__ void st_nt16(void* p, f32x4 v) { __builtin_nontemporal_store(v, (f32x4*)p); }
__device__ __forceinline__ void st_nt16(void* p, uint4 w) { *(uint4*)p = w; }
__device__ __forceinline__ float4 ld_nt16f(const void* p) { const f32x4 t = __builtin_nontemporal_load((const f32x4*)p); return make_float4(t[0], t[1], t[2], t[3]); }
__device__ __forceinline__ uint4 ld_nt16(const void* p) { const u32x4_t t = __builtin_nontemporal_load((const u32x4_t*)p); return make_uint4(t.x, t.y, t.z, t.w); }
__device__ __forceinline__ uint2 ld_nt8(const void* p) { const u32x2 t = __builtin_nontemporal_load((const u32x2*)p); return make_uint2(t.x, t.y); }
__device__ __forceinline__ unsigned ld_nt4(const void* p) { return __builtin_nontemporal_load((const unsigned*)p); }

__device__ double exp_d(double x) {
  double k = rint(x * 1.4426950408889634);
  double r = fma(-k, 0.6931471805599453, x);
  r = fma(-k, 2.3190468138462996e-17, r);
  double p = 1.0;
#pragma unroll
  for (int i = 16; i >= 1; --i) p = fma(r * p, 1.0 / (double)i, 1.0);
  return ldexp(p, (int)k);
}
__device__ void sincos_d(double x, double& s, double& c) {
  double q = rint(x * 0.6366197723675814);
  double r = fma(-q, 1.5707963267948966, x);
  r = fma(-q, 6.123233995736766e-17, r);
  int iq = ((int)q) & 3;
  double r2 = r * r;
  double sp = 1.0, cp = 1.0;
#pragma unroll
  for (int i = 9; i >= 1; --i) sp = fma(-r2 * sp, 1.0 / (double)((2 * i) * (2 * i + 1)), 1.0);
  sp *= r;
#pragma unroll
  for (int i = 10; i >= 1; --i) cp = fma(-r2 * cp, 1.0 / (double)((2 * i - 1) * (2 * i)), 1.0);
  if (iq == 0) { s = sp; c = cp; }
  else if (iq == 1) { s = cp; c = -sp; }
  else if (iq == 2) { s = -sp; c = -cp; }
  else { s = -cp; c = sp; }
}

__device__ __forceinline__ int perm32_row(int n) { const int j = n & 31; return (n & ~31) + 16 * ((j >> 2) & 1) + 4 * (j >> 3) + (j & 3); }
__device__ __forceinline__ int up_dst_row(int n) { const int isv = n >= 2816, nn = isv ? n - 2816 : n; return ((nn >> 7) << 8) + isv * 128 + (nn & 127); }

__device__ void transpose_big(const float* __restrict__ src, bf16_t* __restrict__ dst, int K, int N, int tk, int tn,
                              const float* __restrict__ rowscale, bool perm, float* tile, bool permB = false) {
  const int tid = otid();
  const int k0 = tk * 64, n0 = tn * 256;
  float4 v[8];
#pragma unroll
  for (int i = 0; i < 8; ++i) { const int r = (tid >> 6) + 8 * i, c4 = (tid & 63) * 4; v[i] = ld_nt16f(src + (size_t)(k0 + r) * N + n0 + c4); }
#pragma unroll
  for (int i = 0; i < 8; ++i) {
    const int r = (tid >> 6) + 8 * i, c4 = (tid & 63) * 4;
    const float sc = rowscale ? rowscale[k0 + r] : 1.f;
    tile[r * 257 + c4 + 0] = v[i].x * sc; tile[r * 257 + c4 + 1] = v[i].y * sc; tile[r * 257 + c4 + 2] = v[i].z * sc; tile[r * 257 + c4 + 3] = v[i].w * sc;
  }
  __syncthreads();
  const int n = tid >> 1, kh = (tid & 1) * 32;
  int drow = perm ? up_dst_row(n0 + n) : (n0 + n);
  if (permB) drow = perm32_row(drow);
#pragma unroll
  for (int q = 0; q < 4; ++q) {
    uint4 o;
    o.x = pack2(tile[(kh + 8 * q + 0) * 257 + n], tile[(kh + 8 * q + 1) * 257 + n]);
    o.y = pack2(tile[(kh + 8 * q + 2) * 257 + n], tile[(kh + 8 * q + 3) * 257 + n]);
    o.z = pack2(tile[(kh + 8 * q + 4) * 257 + n], tile[(kh + 8 * q + 5) * 257 + n]);
    o.w = pack2(tile[(kh + 8 * q + 6) * 257 + n], tile[(kh + 8 * q + 7) * 257 + n]);
    *(uint4*)(dst + (size_t)drow * K + k0 + kh + 8 * q) = o;
  }
  __syncthreads();
}

__device__ void transpose_any(const Params& p, int t, float* tile) {
  if (t < 160) transpose_big(p.w_in, p.Wt_in, 1024, 2560, t / 10, t % 10, nullptr, false, tile, true);
  else if (t < 176) { int u = t - 160; transpose_big(p.w_glu, p.Wt_glu, 512, 512, u / 2, u % 2, nullptr, false, tile, true); }
  else if (t < 240) { int u = t - 176; transpose_big(p.w_out, p.Wt_out, 1024, 1024, u / 4, u % 4, nullptr, false, tile, true); }
  else if (t < 592) { int u = t - 240; transpose_big(p.w_up, p.Wt_up, 1024, 5632, u / 22, u % 22, p.ffn_norm_g, true, tile); }
  else { int u = t - 592; transpose_big(p.w_down, p.Wt_down, 2816, 1024, u / 4, u % 4, nullptr, false, tile); }
}

__device__ void s5_tables_block(const Params& p, int bi, char* smem) {
  float* Cr = (float*)smem; float* Ci = Cr + 1024; float* Br = Ci + 1024; float* Bi = Br + 1024;
  float2* Pj = (float2*)(Bi + 1024);
  float2* PZ = Pj + 64;
  const int tid = otid();
  const int g = bi & 31, jb = bi >> 5;
  for (int i = tid; i < 1024; i += NTHR) { Cr[i] = p.c_re[g * 1024 + i]; Ci[i] = p.c_im[g * 1024 + i]; Br[i] = p.b_re[g * 1024 + i]; Bi[i] = p.b_im[g * 1024 + i]; }
  for (int jj = 0; jj < 3; ++jj) {
    const int j = jb + 8 * jj;
    if (j > 16) break;
    __syncthreads();
    if (tid < 64) {
      const int n = tid;
      const double dt = exp_d((double)p.log_dt[g]);
      const double ar = (double)p.a_re[g * 64 + n], ai = (double)p.a_im[g * 64 + n];
      double sj, cj, s1, c1;
      const double mj = exp_d((double)j * dt * ar); sincos_d((double)j * dt * ai, sj, cj);
      const double m1 = exp_d(dt * ar); sincos_d(dt * ai, s1, c1);
      const double pr = mj * cj, pi = mj * sj;
      const double nr = m1 * c1 - 1.0, ni = m1 * s1, den = ar * ar + ai * ai;
      const double zr = (nr * ar + ni * ai) / den, zi = (ni * ar - nr * ai) / den;
      Pj[n] = make_float2((float)pr, (float)pi);
      PZ[n] = make_float2((float)(pr * zr - pi * zi), (float)(pr * zi + pi * zr));
      if (j == 16) p.Pw[g * 64 + n] = make_float2((float)pr, (float)pi);
    }
    __syncthreads();
    if (j >= 1) {
      const int t = j - 1;
#pragma unroll
      for (int i = 0; i < 4; ++i) {
        const int idx = tid + 512 * i, pp = idx >> 7, np = idx & 127, n = np & 63, part = np >> 6;
        const float2 pw = Pj[n];
        const float cr = Cr[pp * 64 + n], ci = Ci[pp * 64 + n];
        const float v = part ? -(cr * pw.y + ci * pw.x) : (cr * pw.x - ci * pw.y);
        p.Etab[(size_t)(g * 256 + t * 16 + pp) * 128 + np] = f2bf(v);
      }
    }
    if (j <= 15) {
      const int sidx = 15 - j;
#pragma unroll
      for (int i = 0; i < 4; ++i) {
        const int idx = tid + 512 * i, np = idx >> 4, pq = idx & 15, n = np & 63, part = np >> 6;
        const float2 m = PZ[n];
        const float br = Br[n * 16 + pq], bi2 = Bi[n * 16 + pq];
        const float v = part ? (m.x * bi2 + m.y * br) : (m.x * br - m.y * bi2);
        p.Ftab[(size_t)(g * 128 + np) * 256 + sidx * 16 + pq] = f2bf(v);
      }
      if (tid < 256) {
        const int pp = tid >> 4, pq = tid & 15;
        float acc = 0.f;
#pragma unroll 8
        for (int n = 0; n < 64; ++n) {
          const float2 m = PZ[n];
          const float br = Br[n * 16 + pq], bi2 = Bi[n * 16 + pq];
          const float cr = Cr[pp * 64 + n], ci = Ci[pp * 64 + n];
          const float mr = m.x * br - m.y * bi2, mi = m.x * bi2 + m.y * br;
          acc += cr * mr - ci * mi;
        }
        p.Ktab[(size_t)((g * 16 + j) * 16 + pp) * 16 + pq] = f2bf(acc);
      }
    }
  }
  __syncthreads();
}

__device__ void phase_prep(const Params& p, char* smem) {
  float* tile = (float*)smem;
  const int tid = otid(), lane = tid & 63, wid = tid >> 6;
  const int gtid = blockIdx.x * NTHR + tid, gthr = gridDim.x * NTHR;
  for (int idx = gtid; idx < T; idx += gthr) { p.rsq1[idx] = 0.f; p.rsq2[idx] = 0.f; }
  const int ntr = (gridDim.x == 256) ? 160 : 768;
  for (int t = blockIdx.x; t < ntr; t += gridDim.x) transpose_any(p, t, tile);
  for (int t = blockIdx.x; t < 256; t += gridDim.x) s5_tables_block(p, t, smem);
}
__device__ void phase_prep_xn(const Params& p) {
  const int tid = otid(), lane = tid & 63, wid = tid >> 6;
  for (int row0 = (blockIdx.x * 8 + wid) * 8; row0 < T; row0 += gridDim.x * 64) {
    float4 v[8][4]; float ss[8];
#pragma unroll
    for (int r = 0; r < 8; ++r) {
      const float4* xr = (const float4*)(p.x + (size_t)(row0 + r) * 1024);
#pragma unroll
      for (int i = 0; i < 4; ++i) { const f32x4 t = __builtin_nontemporal_load((const f32x4*)xr + lane + 64 * i); v[r][i] = make_float4(t[0], t[1], t[2], t[3]); }
    }
#pragma unroll
    for (int r = 0; r < 8; ++r) {
      float a = 0.f;
#pragma unroll
      for (int i = 0; i < 4; ++i) a += v[r][i].x * v[r][i].x + v[r][i].y * v[r][i].y + v[r][i].z * v[r][i].z + v[r][i].w * v[r][i].w;
#pragma unroll
      for (int o = 32; o >= 1; o >>= 1) a += __shfl_xor(a, o);
      ss[r] = rsqrtf(a * (1.f / 1024.f) + 1e-6f);
    }
#pragma unroll
    for (int i = 0; i < 4; ++i) {
      const float4 g = ((const float4*)p.in_norm_g)[lane + 64 * i];
#pragma unroll
      for (int r = 0; r < 8; ++r) {
        uint2 o; o.x = pack2(v[r][i].x * ss[r] * g.x, v[r][i].y * ss[r] * g.y); o.y = pack2(v[r][i].z * ss[r] * g.z, v[r][i].w * ss[r] * g.w);
        *(uint2*)(p.xn + (size_t)(row0 + r) * 1024 + (lane + 64 * i) * 4) = o;
      }
    }
  }
}

struct TileMap {
  int nM, nN, nwg;
  __device__ void init(int M, int N) { nM = M / 256; nN = N / 256; nwg = nM * nN; }
  __device__ void get(int L, int& pm, int& pn) const {
    int wgid = L;
    { const int q = nwg / 8, r = nwg % 8, xcd = wgid % 8, off = wgid / 8; wgid = (xcd < r ? xcd * (q + 1) : r * (q + 1) + (xcd - r) * q) + off; }
    const int nig = 8 * nN, gid = wgid / nig, fm = gid * 8, gsz = (nM - fm) < 8 ? (nM - fm) : 8;
    pm = fm + ((wgid % nig) % gsz); pn = (wgid % nig) / gsz;
  }
};

#define LAS __attribute__((address_space(3)))
constexpr int G_BK = 64, G_HALF = 128, G_HTB = G_HALF * G_BK * 2;
__device__ __forceinline__ int lds_byte(int r, int c) {
  const int st = (r >> 4) * 2 + (c >> 5), rr = r & 15, cc = c & 31, ob = rr * 64 + cc * 2;
  return st * 1024 + (ob ^ (((ob >> 9) & 1) << 5));
}
__device__ __forceinline__ void stage_rc(int b, int& R, int& C) {
  const int st = b / 1024, sb = b % 1024, swz = sb ^ (((sb >> 9) & 1) << 5);
  R = (st >> 1) * 16 + swz / 64; C = (st & 1) * 32 + (swz % 64) / 2;
}

struct RowMapLinear { static constexpr bool PERMA = false, GMAJ = false; __device__ __forceinline__ long operator()(int pm) const { return (long)pm * 256; } };
struct RowMapGroupMajor { static constexpr bool PERMA = false, GMAJ = true; __device__ __forceinline__ long operator()(int pm) const { return (long)pm * 256; } };
struct RowMapConv { static constexpr bool PERMA = true, GMAJ = false; __device__ __forceinline__ long operator()(int pm) const { return (long)(pm / 17) * 4096 + 254 * (pm % 17) - 2; } };

template <class Epi, class RowMap = RowMapLinear>
__device__ __forceinline__ void gemm_phase(const bf16_t* __restrict__ A, const bf16_t* __restrict__ Bt, int M, int N, int K,
                                           const Epi& E, char* smem, const RowMap rmap = RowMap()) {
  LAS unsigned char* lds = (LAS unsigned char*)smem;
  const int tid = otid(), wid = __builtin_amdgcn_readfirstlane(tid >> 6), lane = tid & 63, wr = wid >> 2, wc = wid & 3, fr = lane & 15, fq = lane >> 4;
  const int nt = K / G_BK;
  TileMap tm; tm.init(M, N);
  if ((int)blockIdx.x >= tm.nwg) return;
  unsigned voffA[2], voffB[2];
#pragma unroll
  for (int i = 0; i < 2; ++i) {
    int R, C; stage_rc(tid * 16 + i * 8192, R, C);
    voffB[i] = (unsigned)(R * K + C) * 2u;
    const int Ra = RowMap::PERMA ? ((R & ~63) + 4 * (R & 15) + ((R >> 4) & 3)) : R;
    voffA[i] = RowMap::GMAJ ? (unsigned)((((C >> 4) * M + Ra) * 16 + (C & 15)) * 2) : (unsigned)(Ra * K + C) * 2u;
  }
  const size_t kstep = (size_t)(G_BK * 2);
  const size_t kstepA = RowMap::GMAJ ? (size_t)4 * M * 32 : kstep;
  const size_t hstepA = RowMap::GMAJ ? (size_t)G_HALF * 32 : (size_t)G_HALF * K * 2;
  const size_t hstep = (size_t)G_HALF * K * 2;
  const size_t tstep = 2 * hstep;
  const unsigned ldsw = (unsigned)wid * 1024u;
  const int aoff = lds_byte(wr * 64 + fr, fq * 8), boff = lds_byte(wc * 32 + fr, fq * 8);
#define PG8_SA(b, h) (((b) * 2 + (h)) * G_HTB)
#define PG8_SB(b, h) ((4 + (b) * 2 + (h)) * G_HTB)
#define PG8_STAGE(bufoff, gbase, voff) do { _Pragma("unroll") for (int _i = 0; _i < 2; ++_i) \
    __builtin_amdgcn_global_load_lds((const unsigned*)((const char*)(gbase) + (voff)[_i]), (LAS unsigned*)(lds + (bufoff) + ldsw + _i * 8192), 16, 0, 0); } while (0)
#define PG8_LDA(dst, b, h) do { _Pragma("unroll") for (int m = 0; m < 4; ++m) _Pragma("unroll") for (int k = 0; k < 2; ++k) dst[m][k] = *(const LAS bf16x8*)(lds + PG8_SA(b, h) + aoff + m * 2048 + k * 1024); } while (0)
#define PG8_LDB(dst, b, h) do { _Pragma("unroll") for (int n = 0; n < 2; ++n) _Pragma("unroll") for (int k = 0; k < 2; ++k) dst[n][k] = *(const LAS bf16x8*)(lds + PG8_SB(b, h) + boff + n * 2048 + k * 1024); } while (0)
#define PG8_MMA(ai, bj, At_, Bt_) do { __builtin_amdgcn_s_setprio(1); _Pragma("unroll") for (int m = 0; m < 4; ++m) _Pragma("unroll") for (int n = 0; n < 2; ++n) _Pragma("unroll") for (int k = 0; k < 2; ++k) \
    acc[ai][bj][m][n] = __builtin_amdgcn_mfma_f32_16x16x32_bf16(Bt_[n][k], At_[m][k], acc[ai][bj][m][n], 0, 0, 0); __builtin_amdgcn_s_setprio(0); } while (0)
#define PG8_WAIT_V(n) asm volatile("s_waitcnt vmcnt(" #n ")" ::: "memory")
#define PG8_WAIT_L(n) asm volatile("s_waitcnt lgkmcnt(" #n ")" ::: "memory")
#define PG8_BAR __builtin_amdgcn_s_barrier()
#define PG8_SCHED __builtin_amdgcn_sched_barrier(0)
  int pm, pn, npm = 0, npn = 0, ui = 0;
  tm.get((int)blockIdx.x, pm, pn);
  f32x4 acc[2][2][4][2];
#pragma unroll
  for (int a = 0; a < 2; ++a)
#pragma unroll
    for (int b = 0; b < 2; ++b)
#pragma unroll
      for (int m = 0; m < 4; ++m)
#pragma unroll
        for (int n = 0; n < 2; ++n) acc[a][b][m][n] = (f32x4){0.f, 0.f, 0.f, 0.f};
  bf16x8 At[4][2], B0[2][2], B1[2][2];
  const size_t rstep = RowMap::GMAJ ? (size_t)32 : (size_t)K * 2;
  const char* cA = (const char*)A + rmap(pm) * (long)rstep; const char* cB = (const char*)Bt + (size_t)pn * tstep;
  PG8_WAIT_V(0); __syncthreads();
  PG8_STAGE(PG8_SB(0, 0), cB, voffB); PG8_STAGE(PG8_SA(0, 0), cA, voffA); PG8_STAGE(PG8_SB(0, 1), cB + hstep, voffB); PG8_STAGE(PG8_SA(0, 1), cA + hstepA, voffA);
  if (wr == 1) PG8_BAR;
  PG8_WAIT_V(4); PG8_BAR;
  PG8_STAGE(PG8_SB(1, 0), cB + kstep, voffB); PG8_STAGE(PG8_SA(1, 0), cA + kstepA, voffA); PG8_STAGE(PG8_SB(1, 1), cB + hstep + kstep, voffB);
  PG8_WAIT_V(6); PG8_BAR;
  for (;;) {
    const int Ln = (ui + 1) * (int)gridDim.x + (int)blockIdx.x;
    const bool has_next = Ln < tm.nwg;
    if (has_next) tm.get(Ln, npm, npn);
    const char* nA = has_next ? (const char*)A + rmap(npm) * (long)rstep : cA; const char* nB = has_next ? (const char*)Bt + (size_t)npn * tstep : cB;
    for (int t = 0; t < nt; t += 2) {
      const bool last = (t == nt - 2);
      const char* a1 = cA + (size_t)(t + 1) * kstepA;
      const char* a2 = last ? nA : cA + (size_t)(t + 2) * kstepA; const char* b2 = last ? nB : cB + (size_t)(t + 2) * kstep;
      const char* a3 = a2 + kstepA; const char* b3 = b2 + kstep;
      PG8_LDB(B0, 0, 0); PG8_SCHED; PG8_LDA(At, 0, 0); PG8_STAGE(PG8_SA(1, 1), a1 + hstepA, voffA);
      PG8_WAIT_L(8); PG8_BAR; PG8_WAIT_L(0); PG8_MMA(0, 0, At, B0); PG8_BAR; PG8_SCHED;
      PG8_LDB(B1, 0, 1); PG8_STAGE(PG8_SB(0, 0), b2, voffB);
      PG8_BAR; PG8_WAIT_L(0); PG8_MMA(0, 1, At, B1); PG8_BAR;
      PG8_LDA(At, 0, 1); PG8_STAGE(PG8_SA(0, 0), a2, voffA);
      PG8_BAR; PG8_WAIT_L(0); PG8_MMA(1, 0, At, B0); PG8_BAR; PG8_SCHED;
      PG8_STAGE(PG8_SB(0, 1), b2 + hstep, voffB);
      PG8_WAIT_V(6); PG8_BAR; PG8_MMA(1, 1, At, B1); PG8_BAR;
      PG8_LDB(B0, 1, 0); PG8_SCHED; PG8_LDA(At, 1, 0); PG8_STAGE(PG8_SA(0, 1), a2 + hstepA, voffA);
      PG8_WAIT_L(8); PG8_BAR; PG8_WAIT_L(0); PG8_MMA(0, 0, At, B0); PG8_BAR; PG8_SCHED;
      PG8_LDB(B1, 1, 1); PG8_STAGE(PG8_SB(1, 0), b3, voffB);
      PG8_BAR; PG8_WAIT_L(0); PG8_MMA(0, 1, At, B1); PG8_BAR;
      PG8_LDA(At, 1, 1); PG8_STAGE(PG8_SA(1, 0), a3, voffA);
      PG8_BAR; PG8_WAIT_L(0); PG8_MMA(1, 0, At, B0); PG8_BAR; PG8_SCHED;
      PG8_STAGE(PG8_SB(1, 1), b3 + hstep, voffB);
      PG8_WAIT_V(6); PG8_BAR; PG8_MMA(1, 1, At, B1); PG8_BAR;
    }
    E(acc, pm, pn, wr, wc, fr, fq);
    if (!has_next) break;
#pragma unroll
    for (int a = 0; a < 2; ++a)
#pragma unroll
      for (int b = 0; b < 2; ++b)
#pragma unroll
        for (int m = 0; m < 4; ++m)
#pragma unroll
          for (int n = 0; n < 2; ++n) acc[a][b][m][n] = (f32x4){0.f, 0.f, 0.f, 0.f};
    pm = npm; pn = npn; cA = nA; cB = nB; ++ui;
  }
  PG8_WAIT_V(0);
  if (wr == 0) PG8_BAR;
  PG8_BAR;
#undef PG8_SA
#undef PG8_SB
#undef PG8_STAGE
#undef PG8_LDA
#undef PG8_LDB
#undef PG8_MMA
#undef PG8_WAIT_V
#undef PG8_WAIT_L
#undef PG8_BAR
#undef PG8_SCHED
}

#define PROBE_STAMP_ONCE(k, base) do { if (PROBE_K == (k) && threadIdx.x == 0) { volatile LAS unsigned long long* _s = (volatile LAS unsigned long long*)((LAS unsigned char*)(base) - 8); \
    if (*_s == 0ull) *_s = __builtin_amdgcn_s_memrealtime(); } } while (0)
struct EpiProj {
  bf16_t* proj; bf16_t* ubuf; _Float16* lgf; const float* hg_lb;
  __device__ __forceinline__ void operator()(const f32x4 (&acc)[2][2][4][2], int pm, int pn, int wr, int wc, int fr, int fq) const {
    const int sec = pn >> 1;
    if (sec == 1) {
#pragma unroll
      for (int b = 0; b < 2; ++b) {
        const int c8 = 256 * pn + 128 * b + 32 * wc + 8 * fq;
        float lb[8];
#pragma unroll
        for (int n = 0; n < 2; ++n) {
          const float4 h0 = *(const float4*)(hg_lb + (c8 - 512) + 4 * n), h1 = *(const float4*)(hg_lb + c8 + 4 * n);
          lb[4 * n + 0] = __builtin_amdgcn_rcpf(1.f + __expf(h1.x - h0.x)); lb[4 * n + 1] = __builtin_amdgcn_rcpf(1.f + __expf(h1.y - h0.y));
          lb[4 * n + 2] = __builtin_amdgcn_rcpf(1.f + __expf(h1.z - h0.z)); lb[4 * n + 3] = __builtin_amdgcn_rcpf(1.f + __expf(h1.w - h0.w));
        }
#pragma unroll
        for (int a = 0; a < 2; ++a)
#pragma unroll
          for (int m = 0; m < 4; ++m) {
            const int row = 256 * pm + 128 * a + 64 * wr + 16 * m + fr;
            typedef _Float16 f16x8 __attribute__((ext_vector_type(8)));
            f16x8 lh; float kk[8];
#pragma unroll
            for (int n = 0; n < 2; ++n)
#pragma unroll
              for (int r = 0; r < 4; ++r) {
                const float l = lb[4 * n + r], x = acc[a][b][m][n][r];
                const float sg = __builtin_amdgcn_rcpf(1.f + __expf(-x));
                lh[4 * n + r] = (_Float16)__logf(l + (1.f - l) * sg);
                kk[4 * n + r] = (1.f - l) * __builtin_amdgcn_rcpf(1.f + __expf(x));
              }
            *(f16x8*)(lgf + (size_t)row * 512 + (c8 - 512)) = lh;
            st_nt16(proj + (size_t)row * 2048 + c8, make_uint4(pack2(kk[0], kk[1]), pack2(kk[2], kk[3]), pack2(kk[4], kk[5]), pack2(kk[6], kk[7])));
          }
      }
    } else {
#pragma unroll
      for (int a = 0; a < 2; ++a)
#pragma unroll
        for (int m = 0; m < 4; ++m) {
          const int row = 256 * pm + 128 * a + 64 * wr + 16 * m + fr;
#pragma unroll
          for (int b = 0; b < 2; ++b) {
            const int c8 = 256 * pn + 128 * b + 32 * wc + 8 * fq;
            const f32x4 v0 = acc[a][b][m][0], v1 = acc[a][b][m][1];
            const uint4 o = make_uint4(pack2(v0[0], v0[1]), pack2(v0[2], v0[3]), pack2(v1[0], v1[1]), pack2(v1[2], v1[3]));
            if (sec == 4) st_nt16(ubuf + ((size_t)((c8 - 2048) >> 4) * T + row) * 16 + (c8 & 15), o);
            else st_nt16(proj + (size_t)row * 2048 + c8, o);
          }
        }
    }
  }
};

struct EpiGlu {
  const bf16_t* ybuf; const float* b_glu; bf16_t* mix;
  __device__ __forceinline__ void operator()(const f32x4 (&acc)[2][2][4][2], int pm, int pn, int wr, int wc, int fr, int fq) const {
#pragma unroll
    for (int a = 0; a < 2; ++a)
#pragma unroll
      for (int m = 0; m < 4; ++m) {
        const int row = 256 * pm + 128 * a + 64 * wr + 16 * m + fr;
#pragma unroll
        for (int b = 0; b < 2; ++b) {
          const int c8 = 256 * pn + 128 * b + 32 * wc + 8 * fq;
          const f32x4 v0 = acc[a][b][m][0], v1 = acc[a][b][m][1];
          const float4 b0 = *(const float4*)(b_glu + c8), b1 = *(const float4*)(b_glu + c8 + 4);
          const uint4 yw = ld_nt16(ybuf + ((size_t)(c8 >> 4) * T + row) * 16 + (c8 & 15));
          const float o0 = lo2f(yw.x) * sigm(v0[0] + b0.x), o1 = hi2f(yw.x) * sigm(v0[1] + b0.y), o2 = lo2f(yw.y) * sigm(v0[2] + b0.z), o3 = hi2f(yw.y) * sigm(v0[3] + b0.w);
          const float o4 = lo2f(yw.z) * sigm(v1[0] + b1.x), o5 = hi2f(yw.z) * sigm(v1[1] + b1.y), o6 = lo2f(yw.w) * sigm(v1[2] + b1.z), o7 = hi2f(yw.w) * sigm(v1[3] + b1.w);
          st_nt16(mix + (size_t)row * 1024 + 512 + c8, make_uint4(pack2(o0, o1), pack2(o2, o3), pack2(o4, o5), pack2(o6, o7)));
        }
      }
  }
};


struct EpiOut {
  const float* x; bf16_t* hb; float* rsq;
  __device__ __forceinline__ void operator()(const f32x4 (&acc)[2][2][4][2], int pm, int pn, int wr, int wc, int fr, int fq) const {
#pragma unroll
    for (int a = 0; a < 2; ++a)
#pragma unroll
      for (int m = 0; m < 4; ++m) {
        const int row = 256 * pm + 128 * a + 64 * wr + 16 * m + fr;
        float ss = 0.f;
#pragma unroll
        for (int b = 0; b < 2; ++b) {
          const int c8 = 256 * pn + 128 * b + 32 * wc + 8 * fq;
          const f32x4 v0 = acc[a][b][m][0], v1 = acc[a][b][m][1];
          const float4 x0 = ld_nt16f(x + (size_t)row * 1024 + c8), x1 = ld_nt16f(x + (size_t)row * 1024 + c8 + 4);
          const float h0 = x0.x + v0[0], h1 = x0.y + v0[1], h2 = x0.z + v0[2], h3 = x0.w + v0[3];
          const float h4 = x1.x + v1[0], h5 = x1.y + v1[1], h6 = x1.z + v1[2], h7 = x1.w + v1[3];
          st_nt16(hb + (size_t)row * 1024 + c8, make_uint4(pack2(h0, h1), pack2(h2, h3), pack2(h4, h5), pack2(h6, h7)));
          ss += (h0 * h0 + h1 * h1) + (h2 * h2 + h3 * h3) + (h4 * h4 + h5 * h5) + (h6 * h6 + h7 * h7);
        }
        ss += __shfl_xor(ss, 16); ss += __shfl_xor(ss, 32);
        if (fq == 0) unsafeAtomicAdd(rsq + row, ss);
      }
  }
};

template <int CTRL> __device__ __forceinline__ float dpp_upd(float old, float src) {
  return __int_as_float(__builtin_amdgcn_update_dpp(__float_as_int(old), __float_as_int(src), CTRL, 0xf, 0xf, false));
}
struct EpiUpConv {
  bf16_t* act; const float* rsq; const float* conv_w; const float* conv_b; LAS float* xb;
  __device__ __forceinline__ void operator()(f32x4 (&acc)[2][2][4][2], int pm, int pn, int wr, int wc, int fr, int fq) const {
    PROBE_STAMP_ONCE(31, xb);
    const int seq = pm / 17, it = pm - seq * 17, l0 = 254 * it - 2;
#pragma unroll
    for (int a = 0; a < 2; ++a)
#pragma unroll
      for (int m = 0; m < 4; ++m) {
        const int l = l0 + 128 * a + 64 * wr + 4 * fr + m;
        int tok = seq * 4096 + l; tok = tok < 0 ? 0 : (tok > T - 1 ? T - 1 : tok);
        float rstd = rsqrtf(rsq[tok] * (1.f / 1024.f) + 1e-6f);
#pragma unroll
        for (int b = 0; b < 2; ++b)
#pragma unroll
          for (int n = 0; n < 2; ++n) {
            f32x4 v = acc[a][b][m][n] * rstd;
            if (a == 0 && m < 2 && l < 0) v = (f32x4){0.f, 0.f, 0.f, 0.f};
            acc[a][b][m][n] = v;
          }
      }
    if (fr == 15) {
#pragma unroll
      for (int a = 0; a < 2; ++a) {
        const int bd = 2 * a + wr;
        if (bd < 3) {
#pragma unroll
          for (int q = 0; q < 2; ++q)
#pragma unroll
            for (int b = 0; b < 2; ++b)
#pragma unroll
              for (int n = 0; n < 2; ++n) *(LAS f32x4*)(xb + ((bd * 2 + q) * 2 + b) * 128 + 32 * wc + 16 * n + 4 * fq) = acc[a][b][2 + q][n];
        }
      }
    }
    asm volatile("s_waitcnt lgkmcnt(0)" ::: "memory");
    __builtin_amdgcn_s_barrier(); asm volatile("" ::: "memory");
    __builtin_amdgcn_s_barrier(); asm volatile("" ::: "memory");
#pragma unroll
    for (int n = 0; n < 2; ++n) {
      const int c = pn * 128 + 32 * wc + 16 * n + 4 * fq;
      const f32x4 wg0 = *(const f32x4*)(conv_w + c), wg1 = *(const f32x4*)(conv_w + 5632 + c), wg2 = *(const f32x4*)(conv_w + 2 * 5632 + c);
      const f32x4 wv0 = *(const f32x4*)(conv_w + 2816 + c), wv1 = *(const f32x4*)(conv_w + 5632 + 2816 + c), wv2 = *(const f32x4*)(conv_w + 2 * 5632 + 2816 + c);
      const f32x4 bg = *(const f32x4*)(conv_b + c), bv = *(const f32x4*)(conv_b + 2816 + c);
#pragma unroll
      for (int a = 0; a < 2; ++a) {
        const int bdp = 2 * a + wr - 1;
        f32x4 g2b = (f32x4){0.f, 0.f, 0.f, 0.f}, g1b = g2b, v2b = g2b, v1b = g2b;
        if (bdp >= 0 && fr == 0) {
          g2b = *(const LAS f32x4*)(xb + ((bdp * 2 + 0) * 2 + 0) * 128 + 32 * wc + 16 * n + 4 * fq);
          v2b = *(const LAS f32x4*)(xb + ((bdp * 2 + 0) * 2 + 1) * 128 + 32 * wc + 16 * n + 4 * fq);
          g1b = *(const LAS f32x4*)(xb + ((bdp * 2 + 1) * 2 + 0) * 128 + 32 * wc + 16 * n + 4 * fq);
          v1b = *(const LAS f32x4*)(xb + ((bdp * 2 + 1) * 2 + 1) * 128 + 32 * wc + 16 * n + 4 * fq);
        }
        f32x4 pg3, pg2, pv3, pv2;
#pragma unroll
        for (int r = 0; r < 4; ++r) {
          pg3[r] = dpp_upd<0x111>(g1b[r], acc[a][0][3][n][r]); pg2[r] = dpp_upd<0x111>(g2b[r], acc[a][0][2][n][r]);
          pv3[r] = dpp_upd<0x111>(v1b[r], acc[a][1][3][n][r]); pv2[r] = dpp_upd<0x111>(v2b[r], acc[a][1][2][n][r]);
        }
#pragma unroll
        for (int m = 0; m < 4; ++m) {
          const f32x4 cg = acc[a][0][m][n], cv = acc[a][1][m][n];
          const f32x4 s1g = m == 0 ? pg3 : acc[a][0][m == 0 ? 0 : m - 1][n], s2g = m == 0 ? pg2 : (m == 1 ? pg3 : acc[a][0][m < 2 ? 0 : m - 2][n]);
          const f32x4 s1v = m == 0 ? pv3 : acc[a][1][m == 0 ? 0 : m - 1][n], s2v = m == 0 ? pv2 : (m == 1 ? pv3 : acc[a][1][m < 2 ? 0 : m - 2][n]);
          const f32x4 G = bg + wg0 * s2g + wg1 * s1g + wg2 * cg;
          const f32x4 V = bv + wv0 * s2v + wv1 * s1v + wv2 * cv;
          const int rr = 128 * a + 64 * wr + 4 * fr + m, l = l0 + rr;
          if (rr >= 2 && l < 4096) {
            uint2 ow; ow.x = pack2(G[0] * sigm(G[0]) * V[0], G[1] * sigm(G[1]) * V[1]); ow.y = pack2(G[2] * sigm(G[2]) * V[2], G[3] * sigm(G[3]) * V[3]);
            st_nt8(act + (size_t)(seq * 4096 + l) * 2816 + c, ow);
          }
        }
      }
    }
    PROBE_STAMP_ONCE(32, xb);
  }
};

struct EpiDown {
  float* out; const bf16_t* hb; float* rsq; unsigned* cnt; const float* g; LAS float* red; bool fused;
  __device__ __forceinline__ void operator()(f32x4 (&acc)[2][2][4][2], int pm, int pn, int wr, int wc, int fr, int fq) const {
    PROBE_STAMP_ONCE(30, red);
#pragma unroll
    for (int a = 0; a < 2; ++a)
#pragma unroll
      for (int m = 0; m < 4; ++m) {
        const int row = 256 * pm + 128 * a + 64 * wr + 16 * m + fr;
        float ss = 0.f;
#pragma unroll
        for (int b = 0; b < 2; ++b)
#pragma unroll
          for (int n = 0; n < 2; ++n) {
            const int col = 256 * pn + 128 * b + 32 * wc + 16 * n + 4 * fq;
            const uint2 hw = ld_nt8(hb + (size_t)row * 1024 + col);
            f32x4 v = acc[a][b][m][n];
            v[0] += lo2f(hw.x); v[1] += hi2f(hw.x); v[2] += lo2f(hw.y); v[3] += hi2f(hw.y);
            acc[a][b][m][n] = v;
            ss += v[0] * v[0] + v[1] * v[1] + v[2] * v[2] + v[3] * v[3];
          }
        ss += __shfl_xor(ss, 16); ss += __shfl_xor(ss, 32);
        if (fused) { if (fq == 0) red[(128 * a + 64 * wr + 16 * m + fr) * 4 + wc] = ss; }
        else if (fq == 0) unsafeAtomicAdd(rsq + row, ss);
      }
    if (!fused) {
#pragma unroll
      for (int a = 0; a < 2; ++a)
#pragma unroll
        for (int m = 0; m < 4; ++m) {
          const int row = 256 * pm + 128 * a + 64 * wr + 16 * m + fr;
#pragma unroll
          for (int b = 0; b < 2; ++b)
#pragma unroll
            for (int n = 0; n < 2; ++n) {
              const int col = 256 * pn + 128 * b + 32 * wc + 16 * n + 4 * fq;
              const f32x4 v = acc[a][b][m][n];
              *(float4*)(out + (size_t)row * 1024 + col) = make_float4(v[0], v[1], v[2], v[3]);
            }
        }
      return;
    }
    asm volatile("s_waitcnt lgkmcnt(0)" ::: "memory");
    __builtin_amdgcn_s_barrier(); asm volatile("" ::: "memory");
    __builtin_amdgcn_s_barrier(); asm volatile("" ::: "memory");
    const int wid = wr * 4 + wc, lane = fq * 16 + fr;
    unsigned* c = cnt + pm * 64;
    if (wid < 4) {
      const int r = wid * 64 + lane;
      const f32x4 q = *(const LAS f32x4*)(red + r * 4);
      const float old = unsafeAtomicAdd(rsq + 256 * pm + r, (q[0] + q[1]) + (q[2] + q[3]));
      asm volatile("s_waitcnt vmcnt(0)" :: "v"(old) : "memory");
      if (lane == 0) __hip_atomic_fetch_add(c, 1u, __ATOMIC_RELAXED, __HIP_MEMORY_SCOPE_AGENT);
    }
    {
      unsigned spins = 0;
      while ((unsigned)__builtin_amdgcn_readfirstlane((int)__hip_atomic_load(c, __ATOMIC_RELAXED, __HIP_MEMORY_SCOPE_AGENT)) < 16u) {
        __builtin_amdgcn_s_sleep(2);
        if (++spins > (1u << 22)) break;
      }
    }
#pragma unroll
    for (int a = 0; a < 2; ++a)
#pragma unroll
      for (int m = 0; m < 4; ++m) {
        const int row = 256 * pm + 128 * a + 64 * wr + 16 * m + fr;
        const float rstd = rsqrtf(__hip_atomic_load(rsq + row, __ATOMIC_RELAXED, __HIP_MEMORY_SCOPE_AGENT) * (1.f / 1024.f) + 1e-6f);
#pragma unroll
        for (int b = 0; b < 2; ++b)
#pragma unroll
          for (int n = 0; n < 2; ++n) {
            const int col = 256 * pn + 128 * b + 32 * wc + 16 * n + 4 * fq;
            const float4 gv = *(const float4*)(g + col);
            const f32x4 v = acc[a][b][m][n];
            st_nt16(out + (size_t)row * 1024 + col, (f32x4){v[0] * rstd * gv.x, v[1] * rstd * gv.y, v[2] * rstd * gv.z, v[3] * rstd * gv.w});
          }
      }
  }
};

typedef _Float16 f16x2_t __attribute__((ext_vector_type(2)));
__device__ void hg_a_item(const Params& p, int item, char* smem) {
  bf16_t* kT = (bf16_t*)smem;
  bf16_t* vT = kT + 128 * 72;
  float* tot = (float*)(vT + 128 * 72);
  _Float16* Lf = (_Float16*)(smem + 40960); bf16_t* Kr = (bf16_t*)(Lf + 8192); bf16_t* Vr = Kr + 8192;
  const int tid = otid(), lane = tid & 63, wid = tid >> 6, fr = lane & 15, fq = lane >> 4;
  const int b = item >> 8, h = (item >> 6) & 3, n = item & 63;
  const int t0 = b * 4096 + n * 64;
  const int kp = tid & 63, seg = tid >> 6;
  {
    uint4 rw[6];
#pragma unroll
    for (int i = 0; i < 2; ++i) {
      const int c = tid + 512 * i, row = c >> 4, cc = c & 15;
      rw[i] = ld_nt16(p.logf + (size_t)(t0 + row) * 512 + h * 128 + cc * 8);
      rw[2 + i] = ld_nt16(p.proj + (size_t)(t0 + row) * 2048 + 512 + h * 128 + cc * 8);
      rw[4 + i] = ld_nt16(p.proj + (size_t)(t0 + row) * 2048 + 1024 + h * 128 + cc * 8);
    }
#pragma unroll
    for (int i = 0; i < 2; ++i) {
      const int c = tid + 512 * i, row = c >> 4, cc = c & 15;
      *(uint4*)(Lf + row * 128 + cc * 8) = rw[i]; *(uint4*)(Kr + row * 128 + cc * 8) = rw[2 + i]; *(uint4*)(Vr + row * 128 + cc * 8) = rw[4 + i];
    }
  }
  __syncthreads();
  float b0[8], b1[8];
  {
    float a0 = 0.f, a1 = 0.f;
#pragma unroll
    for (int i = 0; i < 8; ++i) {
      const f16x2_t l2 = *(const f16x2_t*)(Lf + (seg * 8 + i) * 128 + 2 * kp);
      a0 += (float)l2[0]; a1 += (float)l2[1]; b0[i] = a0; b1[i] = a1;
    }
    *(float2*)(tot + seg * 128 + 2 * kp) = make_float2(a0, a1);
  }
  __syncthreads();
  float pre0 = 0.f, pre1 = 0.f, all0 = 0.f, all1 = 0.f;
#pragma unroll
  for (int s8 = 0; s8 < 8; ++s8) { const float2 tv = *(const float2*)(tot + s8 * 128 + 2 * kp); if (s8 < seg) { pre0 += tv.x; pre1 += tv.y; } all0 += tv.x; all1 += tv.y; }
  {
    float k0[8], k1[8]; unsigned v0[4], v1[4];
#pragma unroll
    for (int i = 0; i < 8; ++i) {
      const unsigned kw = *(const unsigned*)(Kr + (seg * 8 + i) * 128 + 2 * kp), vw = *(const unsigned*)(Vr + (seg * 8 + i) * 128 + 2 * kp);
      k0[i] = lo2f(kw) * __expf(all0 - (b0[i] + pre0)); k1[i] = hi2f(kw) * __expf(all1 - (b1[i] + pre1));
      if (i & 1) { v0[i >> 1] |= vw << 16; v1[i >> 1] |= vw & 0xffff0000u; } else { v0[i >> 1] = vw & 0xffffu; v1[i >> 1] = vw >> 16; }
    }
    *(uint4*)(kT + (2 * kp) * 72 + seg * 8) = make_uint4(pack2(k0[0], k0[1]), pack2(k0[2], k0[3]), pack2(k0[4], k0[5]), pack2(k0[6], k0[7]));
    *(uint4*)(kT + (2 * kp + 1) * 72 + seg * 8) = make_uint4(pack2(k1[0], k1[1]), pack2(k1[2], k1[3]), pack2(k1[4], k1[5]), pack2(k1[6], k1[7]));
    *(uint4*)(vT + (2 * kp) * 72 + seg * 8) = make_uint4(v0[0], v0[1], v0[2], v0[3]);
    *(uint4*)(vT + (2 * kp + 1) * 72 + seg * 8) = make_uint4(v1[0], v1[1], v1[2], v1[3]);
    if (seg == 0) *(float2*)(p.decay + (size_t)item * 128 + 2 * kp) = make_float2(__expf(all0), __expf(all1));
  }
  __syncthreads();
  bf16x8 af[2];
#pragma unroll
  for (int ks = 0; ks < 2; ++ks) af[ks] = *(const bf16x8*)(kT + (16 * wid + fr) * 72 + 32 * ks + 8 * fq);
#pragma unroll
  for (int j = 0; j < 8; ++j) {
    f32x4 acc = (f32x4){0.f, 0.f, 0.f, 0.f};
#pragma unroll
    for (int ks = 0; ks < 2; ++ks) {
      bf16x8 bfr = *(const bf16x8*)(vT + (16 * j + fr) * 72 + 32 * ks + 8 * fq);
      acc = __builtin_amdgcn_mfma_f32_16x16x32_bf16(af[ks], bfr, acc, 0, 0, 0);
    }
    st_nt8(p.dstate + (size_t)item * 16384 + (16 * j + fr) * 128 + 16 * wid + 4 * fq, pack2(acc[0], acc[1]), pack2(acc[2], acc[3]));
  }
  __syncthreads();
}

__device__ void hg_c_item(const Params& p, int item, char* smem) {
  bf16_t* qd = (bf16_t*)smem;
  bf16_t* kd = qd + 64 * 136;
  bf16_t* vT = kd + 64 * 136;
  float* tot = (float*)(vT + 128 * 72);
  float* ssq = tot + 1024;
  _Float16* Lf = (_Float16*)(ssq + 128); bf16_t* Qr = (bf16_t*)(Lf + 8192); bf16_t* Kr = Qr + 8192; bf16_t* Vr = Kr + 8192;
  bf16_t* att = (bf16_t*)Lf;
  const int tid = otid(), lane = tid & 63, wid = tid >> 6, fr = lane & 15, fq = lane >> 4;
  const int b = item >> 8, h = (item >> 6) & 3, n = item & 63;
  const int t0 = b * 4096 + n * 64;
  const int kp = tid & 63, seg = tid >> 6;
  const int rt = wid & 3, hh = wid >> 2;
  const int token = t0 + 16 * rt + fr;
  uint2 gw[4]; float4 g4[4];
  {
    uint4 rw[8];
#pragma unroll
    for (int i = 0; i < 2; ++i) {
      const int c = tid + 512 * i, row = c >> 4, cc = c & 15;
      rw[i] = ld_nt16(p.logf + (size_t)(t0 + row) * 512 + h * 128 + cc * 8);
      rw[2 + i] = ld_nt16(p.proj + (size_t)(t0 + row) * 2048 + h * 128 + cc * 8);
      rw[4 + i] = ld_nt16(p.proj + (size_t)(t0 + row) * 2048 + 512 + h * 128 + cc * 8);
      rw[6 + i] = ld_nt16(p.proj + (size_t)(t0 + row) * 2048 + 1024 + h * 128 + cc * 8);
    }
#pragma unroll
    for (int j = 0; j < 4; ++j) {
      const int col = h * 128 + 16 * (4 * hh + j) + 4 * fq;
      gw[j] = ld_nt8(p.proj + (size_t)token * 2048 + 1536 + col);
      g4[j] = *(const float4*)(p.hg_norm_g + col);
    }
#pragma unroll
    for (int i = 0; i < 2; ++i) {
      const int c = tid + 512 * i, row = c >> 4, cc = c & 15;
      *(uint4*)(Lf + row * 128 + cc * 8) = rw[i]; *(uint4*)(Qr + row * 128 + cc * 8) = rw[2 + i]; *(uint4*)(Kr + row * 128 + cc * 8) = rw[4 + i]; *(uint4*)(Vr + row * 128 + cc * 8) = rw[6 + i];
    }
  }
  __syncthreads();
  float b0[8], b1[8];
  {
    float a0 = 0.f, a1 = 0.f;
#pragma unroll
    for (int i = 0; i < 8; ++i) {
      const f16x2_t l2 = *(const f16x2_t*)(Lf + (seg * 8 + i) * 128 + 2 * kp);
      a0 += (float)l2[0]; a1 += (float)l2[1]; b0[i] = a0; b1[i] = a1;
    }
    *(float2*)(tot + seg * 128 + 2 * kp) = make_float2(a0, a1);
  }
  __syncthreads();
  const bf16_t* sp = p.sstart + (size_t)item * 16384;
  bf16x8 sf[4][4];
#pragma unroll
  for (int ks = 0; ks < 4; ++ks)
#pragma unroll
    for (int j = 0; j < 4; ++j) sf[ks][j] = *(const bf16x8*)(sp + (16 * (4 * hh + j) + fr) * 128 + 32 * ks + 8 * fq);
  float pre0 = 0.f, pre1 = 0.f;
#pragma unroll
  for (int s8 = 0; s8 < 8; ++s8) { const float2 tv = *(const float2*)(tot + s8 * 128 + 2 * kp); if (s8 < seg) { pre0 += tv.x; pre1 += tv.y; } }
  {
    unsigned v0[4], v1[4];
#pragma unroll
    for (int i = 0; i < 8; ++i) {
      const int r = seg * 8 + i;
      const unsigned qw = *(const unsigned*)(Qr + r * 128 + 2 * kp), kw = *(const unsigned*)(Kr + r * 128 + 2 * kp), vw = *(const unsigned*)(Vr + r * 128 + 2 * kp);
      const float bb0 = b0[i] + pre0, bb1 = b1[i] + pre1;
      *(unsigned*)(qd + r * 136 + 2 * kp) = pack2(lo2f(qw) * __expf(bb0), hi2f(qw) * __expf(bb1));
      *(unsigned*)(kd + r * 136 + 2 * kp) = pack2(lo2f(kw) * __expf(-bb0), hi2f(kw) * __expf(-bb1));
      if (i & 1) { v0[i >> 1] |= vw << 16; v1[i >> 1] |= vw & 0xffff0000u; } else { v0[i >> 1] = vw & 0xffffu; v1[i >> 1] = vw >> 16; }
    }
    *(uint4*)(vT + (2 * kp) * 72 + seg * 8) = make_uint4(v0[0], v0[1], v0[2], v0[3]);
    *(uint4*)(vT + (2 * kp + 1) * 72 + seg * 8) = make_uint4(v1[0], v1[1], v1[2], v1[3]);
  }
  __syncthreads();
#pragma unroll
  for (int st2 = 0; st2 < 2; ++st2) {
    const int st = 2 * hh + st2;
    f32x4 acc = (f32x4){0.f, 0.f, 0.f, 0.f};
#pragma unroll
    for (int ks = 0; ks < 4; ++ks) {
      bf16x8 a = *(const bf16x8*)(kd + (16 * st + fr) * 136 + 32 * ks + 8 * fq);
      bf16x8 bq = *(const bf16x8*)(qd + (16 * rt + fr) * 136 + 32 * ks + 8 * fq);
      acc = __builtin_amdgcn_mfma_f32_16x16x32_bf16(a, bq, acc, 0, 0, 0);
    }
    const int c = 16 * rt + fr, s0 = 16 * st + 4 * fq;
    float v0 = (s0 + 0 <= c) ? acc[0] : 0.f, v1 = (s0 + 1 <= c) ? acc[1] : 0.f, v2 = (s0 + 2 <= c) ? acc[2] : 0.f, v3 = (s0 + 3 <= c) ? acc[3] : 0.f;
    uint2 o; o.x = pack2(v0, v1); o.y = pack2(v2, v3);
    *(uint2*)(att + c * 72 + s0) = o;
  }
  __syncthreads();
  f32x4 o[4];
#pragma unroll
  for (int j = 0; j < 4; ++j) o[j] = (f32x4){0.f, 0.f, 0.f, 0.f};
#pragma unroll
  for (int ks = 0; ks < 2; ++ks) {
    bf16x8 bq = *(const bf16x8*)(att + (16 * rt + fr) * 72 + 32 * ks + 8 * fq);
#pragma unroll
    for (int j = 0; j < 4; ++j) {
      bf16x8 a = *(const bf16x8*)(vT + (16 * (4 * hh + j) + fr) * 72 + 32 * ks + 8 * fq);
      o[j] = __builtin_amdgcn_mfma_f32_16x16x32_bf16(a, bq, o[j], 0, 0, 0);
    }
  }
#pragma unroll
  for (int ks = 0; ks < 4; ++ks) {
    bf16x8 bq = *(const bf16x8*)(qd + (16 * rt + fr) * 136 + 32 * ks + 8 * fq);
#pragma unroll
    for (int j = 0; j < 4; ++j) o[j] = __builtin_amdgcn_mfma_f32_16x16x32_bf16(sf[ks][j], bq, o[j], 0, 0, 0);
  }
  float ss = 0.f;
#pragma unroll
  for (int j = 0; j < 4; ++j) ss += o[j][0] * o[j][0] + o[j][1] * o[j][1] + o[j][2] * o[j][2] + o[j][3] * o[j][3];
  ss += __shfl_xor(ss, 16); ss += __shfl_xor(ss, 32);
  if (fq == 0) ssq[hh * 64 + 16 * rt + fr] = ss;
  __syncthreads();
  const float tss = ssq[16 * rt + fr] + ssq[64 + 16 * rt + fr];
  const float rstd = rsqrtf(tss * (1.f / 128.f) + 1e-6f);
#pragma unroll
  for (int j = 0; j < 4; ++j) {
    const int col = h * 128 + 16 * (4 * hh + j) + 4 * fq;
    float z0 = lo2f(gw[j].x), z1 = hi2f(gw[j].x), z2 = lo2f(gw[j].y), z3 = hi2f(gw[j].y);
    float r0 = o[j][0] * rstd * g4[j].x * z0 * sigm(z0), r1 = o[j][1] * rstd * g4[j].y * z1 * sigm(z1);
    float r2 = o[j][2] * rstd * g4[j].z * z2 * sigm(z2), r3 = o[j][3] * rstd * g4[j].w * z3 * sigm(z3);
    uint2 ow; ow.x = pack2(r0, r1); ow.y = pack2(r2, r3);
    st_nt8(p.mix + (size_t)token * 1024 + col, ow);
  }
  __syncthreads();
}

__device__ void s5_a_block(const Params& p, int g, int to, char* smem) {
  const int tid = otid(), lane = tid & 63, wid = tid >> 6, fr = lane & 15, fq = lane >> 4;
  const int tt = to * 8 + wid;
  bf16x8 U[8];
#pragma unroll
  for (int ks = 0; ks < 8; ++ks) {
    const int tok = tt * 256 + 16 * fr + 2 * ks + (fq >> 1);
    U[ks] = *(const bf16x8*)(p.ubuf + ((size_t)g * T + tok) * 16 + 8 * (fq & 1));
  }
  {
    const uint4* src = (const uint4*)(p.Ftab + (size_t)g * 128 * 256);
    uint4 v[8];
#pragma unroll
    for (int i = 0; i < 8; ++i) v[i] = src[tid + 512 * i];
#pragma unroll
    for (int i = 0; i < 8; ++i) { const int c = tid + 512 * i; *(uint4*)(smem + (c >> 5) * 528 + (c & 31) * 16) = v[i]; }
  }
  __syncthreads();
#pragma unroll
  for (int rt = 0; rt < 8; ++rt) {
    f32x4 acc = (f32x4){0.f, 0.f, 0.f, 0.f};
#pragma unroll
    for (int ks = 0; ks < 8; ++ks) {
      bf16x8 a = *(const bf16x8*)(smem + (16 * rt + fr) * 528 + 64 * ks + 16 * fq);
      acc = __builtin_amdgcn_mfma_f32_16x16x32_bf16(a, U[ks], acc, 0, 0, 0);
    }
    *(f32x4*)(p.Xend + ((size_t)(tt * 16 + fr) * 32 + g) * 128 + 16 * rt + 4 * fq) = acc;
  }
  __syncthreads();
}

__device__ void s5_c_block(const Params& p, int g, int to, char* smem) {
  const int tid = otid(), lane = tid & 63, wid = tid >> 6, fr = lane & 15, fq = lane >> 4;
  const int tt = to * 8 + wid;
  bf16x8 U[8], Kf[16], Xf[4];
#pragma unroll
  for (int ks = 0; ks < 8; ++ks) {
    const int tok = tt * 256 + 16 * fr + 2 * ks + (fq >> 1);
    U[ks] = *(const bf16x8*)(p.ubuf + ((size_t)g * T + tok) * 16 + 8 * (fq & 1));
  }
#pragma unroll
  for (int d = 0; d < 16; ++d) {
    const int tau = d - (fq >> 1);
    bf16x8 z = (bf16x8){0, 0, 0, 0, 0, 0, 0, 0};
    if (tau >= 0) z = *(const bf16x8*)(p.Ktab + (size_t)((g * 16 + tau) * 16 + fr) * 16 + 8 * (fq & 1));
    Kf[d] = z;
  }
#pragma unroll
  for (int ks = 0; ks < 4; ++ks) Xf[ks] = *(const bf16x8*)(p.Xs + ((size_t)(tt * 16 + fr) * 32 + g) * 128 + 32 * ks + 8 * fq);
  const int c0 = g * 16 + 4 * fq;
  const float4 dsk = *(const float4*)(p.s5_d + c0);
  uint2 uw[16];
#pragma unroll
  for (int t = 0; t < 16; ++t) uw[t] = *(const uint2*)(p.ubuf + ((size_t)g * T + tt * 256 + 16 * fr + t) * 16 + 4 * fq);
  {
    const uint4* src = (const uint4*)(p.Etab + (size_t)g * 256 * 128);
    uint4 v[8];
#pragma unroll
    for (int i = 0; i < 8; ++i) v[i] = src[tid + 512 * i];
#pragma unroll
    for (int i = 0; i < 8; ++i) { const int c = tid + 512 * i; *(uint4*)(smem + (c >> 4) * 272 + (c & 15) * 16) = v[i]; }
  }
  __syncthreads();
#pragma unroll
  for (int t = 0; t < 16; ++t) {
    f32x4 acc = (f32x4){0.f, 0.f, 0.f, 0.f};
#pragma unroll
    for (int ks = 0; ks <= t / 2; ++ks) acc = __builtin_amdgcn_mfma_f32_16x16x32_bf16(Kf[t - 2 * ks], U[ks], acc, 0, 0, 0);
#pragma unroll
    for (int ks = 0; ks < 4; ++ks) {
      bf16x8 a = *(const bf16x8*)(smem + (t * 16 + fr) * 272 + 64 * ks + 16 * fq);
      acc = __builtin_amdgcn_mfma_f32_16x16x32_bf16(a, Xf[ks], acc, 0, 0, 0);
    }
    const int token = tt * 256 + 16 * fr + t;
    float y0 = acc[0] + dsk.x * lo2f(uw[t].x), y1 = acc[1] + dsk.y * hi2f(uw[t].x), y2 = acc[2] + dsk.z * lo2f(uw[t].y), y3 = acc[3] + dsk.w * hi2f(uw[t].y);
    uint2 ow; ow.x = pack2(gelu_tanh(y0), gelu_tanh(y1)); ow.y = pack2(gelu_tanh(y2), gelu_tanh(y3));
    st_nt8(p.ybuf + ((size_t)g * T + token) * 16 + 4 * fq, ow);
  }
  __syncthreads();
}

#define XB_TMO      128
#define XB_XCNT(j)  (256  + 64 * (j))
#define XB_XSUB(j)  (1280 + 64 * (j))
#define XB_XGEN(j)  (2304 + 64 * (j))
#define XB_TOP      3328
#define XB_TOPGEN   3392
#define XCD_BAR_WORDS 3456
#define XB_SPIN_CAP (1u << 20)
__device__ __forceinline__ unsigned xb_ld(unsigned* p) { return __hip_atomic_load(p, __ATOMIC_RELAXED, __HIP_MEMORY_SCOPE_AGENT); }
__device__ __forceinline__ unsigned xb_add(unsigned* p, unsigned v) { return __hip_atomic_fetch_add(p, v, __ATOMIC_RELAXED, __HIP_MEMORY_SCOPE_AGENT); }
__device__ __forceinline__ unsigned xb_xcc_id() { return (unsigned)__builtin_amdgcn_s_getreg((3 << 11) | 20) & 0xFu; }
#define XB_SPIN(cond, bar) do { unsigned _sp = 0; while (cond) { __builtin_amdgcn_s_sleep(1); \
    if ((++_sp & 255u) == 0u) { if (xb_ld(&(bar)[XB_TMO])) break; if (_sp > XB_SPIN_CAP) { atomicAdd(&(bar)[XB_TMO], 1u); break; } } } } while (0)
struct XcdBarrier { unsigned* bar; unsigned x; volatile LAS unsigned* st; };
__device__ __forceinline__ XcdBarrier xcd_barrier_post(unsigned* bar, volatile LAS unsigned* st) {
  XcdBarrier b; b.bar = bar; b.x = xb_xcc_id(); b.st = st;
  if (threadIdx.x == 0) (void)xb_add(&bar[XB_XCNT(b.x)], 1u);
  return b;
}
__device__ __forceinline__ void xcd_barrier_complete(unsigned* bar, unsigned x, unsigned& nloc, unsigned& nx) {
  const unsigned G = gridDim.x * gridDim.y * gridDim.z;
  unsigned sum, cnt, mine, sp = 0u;
  for (;;) {
    sum = 0u; cnt = 0u; mine = 0u;
#pragma unroll
    for (unsigned j = 0; j < 16; ++j) { const unsigned c = xb_ld(&bar[XB_XCNT(j)]); sum += c; cnt += (c > 0u) ? 1u : 0u; mine = (j == x) ? c : mine; }
    if (sum == G) break;
    __builtin_amdgcn_s_sleep(1);
    if ((++sp & 255u) == 0u) { if (xb_ld(&bar[XB_TMO])) break; if (sp > XB_SPIN_CAP) { atomicAdd(&bar[XB_TMO], 1u); break; } }
  }
  nloc = mine > 0u ? mine : 1u; nx = cnt > 0u ? cnt : 1u;
}
__device__ __forceinline__ void xcd_barrier(const XcdBarrier& b) {
  asm volatile("s_waitcnt vmcnt(0)" ::: "memory");
  __syncthreads();
  if (threadIdx.x == 0) {
    unsigned* bar = b.bar;
    __builtin_amdgcn_s_waitcnt(0);
    unsigned nloc = b.st[0], nx = b.st[1];
    if (nloc == 0u) { xcd_barrier_complete(bar, b.x, nloc, nx); b.st[0] = nloc; b.st[1] = nx; }
    const unsigned old = xb_add(&bar[XB_XSUB(b.x)], 1u);
    const unsigned gen = old / nloc;
    if (old + 1u == (gen + 1u) * nloc) {
      __builtin_amdgcn_fence(__ATOMIC_RELEASE, "agent");
      asm volatile("s_waitcnt vmcnt(0)" ::: "memory");
      const unsigned og = xb_add(&bar[XB_TOP], 1u);
      const unsigned tg = og / nx;
      if (og + 1u == (tg + 1u) * nx) xb_add(&bar[XB_TOPGEN], 1u);
      else XB_SPIN(xb_ld(&bar[XB_TOPGEN]) == tg, bar);
      __builtin_amdgcn_fence(__ATOMIC_ACQUIRE, "agent");
      xb_add(&bar[XB_XGEN(b.x)], 1u);
      asm volatile("s_waitcnt vmcnt(0)" ::: "memory");
    } else {
      XB_SPIN(xb_ld(&bar[XB_XGEN(b.x)]) == gen, bar);
      __builtin_amdgcn_fence(__ATOMIC_ACQUIRE, "agent");
      asm volatile("s_waitcnt vmcnt(0)" ::: "memory");
    }
  }
  __syncthreads();
}

__device__ void phase_mix_a(const Params& p, char* smem, int part) {
  if (part == 0) { for (int it = blockIdx.x; it < 1024; it += gridDim.x) hg_a_item(p, it, smem); }
  else { for (int u = blockIdx.x; u < 256; u += gridDim.x) s5_a_block(p, u & 31, u >> 5, smem); }
}

__device__ void phase_scan(const Params& p) {
  int tid = otid();
  if (tid < 128) {
    for (int it = blockIdx.x * 128 + tid; it < 32768; it += gridDim.x * 128) {
      const int seg = it & 3, ch = it >> 2;
      const int bt = ch >> 11, g = (ch >> 6) & 31, n = ch & 63;
      const float2 a = p.Pw[g * 64 + n];
      const size_t base = ((size_t)(bt * 256 + seg * 64) * 32 + g) * 128 + n;
      const float* __restrict__ xe = p.Xend + base;
      bf16_t* __restrict__ xs = p.Xs + base;
      float xr = 0.f, xi = 0.f;
#pragma unroll 1
      for (int h = 0; h < 2; ++h) {
        float er[32], ei[32];
#pragma unroll
        for (int j = 0; j < 32; ++j) { er[j] = xe[(size_t)(h * 32 + j) * 4096]; ei[j] = xe[(size_t)(h * 32 + j) * 4096 + 64]; }
#pragma unroll
        for (int j = 0; j < 32; ++j) { const float nr = a.x * xr - a.y * xi + er[j], ni = a.x * xi + a.y * xr + ei[j]; xr = nr; xi = ni; }
      }
      float Ar = a.x, Ai = a.y;
#pragma unroll
      for (int q = 0; q < 6; ++q) { const float t = Ar * Ar - Ai * Ai; Ai = 2.f * Ar * Ai; Ar = t; }
      const int lb = (tid & 63) & ~3;
      const float e0r = __shfl(xr, lb), e0i = __shfl(xi, lb), e1r = __shfl(xr, lb + 1), e1i = __shfl(xi, lb + 1), e2r = __shfl(xr, lb + 2), e2i = __shfl(xi, lb + 2);
      const float s2r = Ar * e0r - Ai * e0i + e1r, s2i = Ar * e0i + Ai * e0r + e1i;
      const float s3r = Ar * s2r - Ai * s2i + e2r, s3i = Ar * s2i + Ai * s2r + e2i;
      xr = seg == 0 ? 0.f : (seg == 1 ? e0r : (seg == 2 ? s2r : s3r));
      xi = seg == 0 ? 0.f : (seg == 1 ? e0i : (seg == 2 ? s2i : s3i));
#pragma unroll 1
      for (int h = 0; h < 2; ++h) {
        float er[32], ei[32];
#pragma unroll
        for (int j = 0; j < 32; ++j) { er[j] = xe[(size_t)(h * 32 + j) * 4096]; ei[j] = xe[(size_t)(h * 32 + j) * 4096 + 64]; }
#pragma unroll
        for (int j = 0; j < 32; ++j) {
          xs[(size_t)(h * 32 + j) * 4096] = f2bf(xr); xs[(size_t)(h * 32 + j) * 4096 + 64] = f2bf(xi);
          const float nr = a.x * xr - a.y * xi + er[j], ni = a.x * xi + a.y * xr + ei[j]; xr = nr; xi = ni;
        }
      }
    }
  }
  const int gtid = blockIdx.x * NTHR + tid, gthr = gridDim.x * NTHR;
  for (int e2 = gtid; e2 < 16 * 8192; e2 += gthr) {
    const int bh = e2 >> 13, e = (e2 & 8191) * 2, k = e & 127;
    const bf16_t* __restrict__ dsp = p.dstate + (size_t)bh * 64 * 16384 + e;
    const float* __restrict__ dcp = p.decay + (size_t)bh * 64 * 128 + k;
    bf16_t* __restrict__ sp = p.sstart + (size_t)bh * 64 * 16384 + e;
    float sx = 0.f, sy = 0.f;
#pragma unroll 1
    for (int n0 = 0; n0 < 64; n0 += 32) {
      unsigned ds[32]; float2 dc[32];
#pragma unroll
      for (int j = 0; j < 32; ++j) { ds[j] = ld_nt4(dsp + (size_t)(n0 + j) * 16384); dc[j] = *(const float2*)(dcp + (n0 + j) * 128); }
#pragma unroll
      for (int j = 0; j < 32; ++j) {
        *(unsigned*)(sp + (size_t)(n0 + j) * 16384) = pack2(sx, sy);
        sx = dc[j].x * sx + lo2f(ds[j]); sy = dc[j].y * sy + hi2f(ds[j]);
      }
    }
  }
}

__device__ void phase_mix_c(const Params& p, char* smem, int part) {
  if (part == 0) {
    if (gridDim.x == 256) {
      const int b = blockIdx.x, first = b < 128 ? b * 3 : 384 + (b - 128) * 5, cnt = b < 128 ? 3 : 5;
      for (int j = 0; j < cnt; ++j) hg_c_item(p, first + j, smem);
    } else { for (int it = blockIdx.x; it < 1024; it += gridDim.x) hg_c_item(p, it, smem); }
  }
  else { for (int u = blockIdx.x; u < 256; u += gridDim.x) s5_c_block(p, u & 31, u >> 5, smem); }
}

__device__ void phase_final(const Params& p) {
  int tid_ = otid();
  const int lane = tid_ & 63, wid = tid_ >> 6;
  for (int row0 = (blockIdx.x * 8 + wid) * 4; row0 < T; row0 += gridDim.x * 32) {
    float4 v[4][4]; float rs[4];
#pragma unroll
    for (int r = 0; r < 4; ++r) {
      const float4* op = (const float4*)(p.out + (size_t)(row0 + r) * 1024);
#pragma unroll
      for (int i = 0; i < 4; ++i) v[r][i] = op[lane + 64 * i];
      rs[r] = rsqrtf(p.rsq2[row0 + r] * (1.f / 1024.f) + 1e-6f);
    }
#pragma unroll
    for (int i = 0; i < 4; ++i) {
      const float4 g = ((const float4*)p.final_g)[lane + 64 * i];
#pragma unroll
      for (int r = 0; r < 4; ++r) {
        float4 w = v[r][i];
        w.x *= rs[r] * g.x; w.y *= rs[r] * g.y; w.z *= rs[r] * g.z; w.w *= rs[r] * g.w;
        ((float4*)(p.out + (size_t)(row0 + r) * 1024))[lane + 64 * i] = w;
      }
    }
  }
}

template <int PH>
__device__ __forceinline__ void run_phase(const Params& p, char* smem) {
  if (PH == 0) phase_prep(p, smem);
  if (PH == 100) phase_prep_xn(p);
  if (PH == 1) {
    EpiProj e{p.proj, p.ubuf, p.logf, p.hg_lb}; gemm_phase(p.xn, p.Wt_in, T, 2560, 1024, e, smem);
    if (gridDim.x == 256 && blockIdx.x >= 128)
      for (int t = 160 + ((int)blockIdx.x - 128); t < 768; t += 128) transpose_any(p, t, (float*)smem);
  }
  if (PH == 2) phase_mix_a(p, smem, 0);
  if (PH == 102) phase_mix_a(p, smem, 1);
  if (PH == 3) phase_scan(p);
  if (PH == 4) phase_mix_c(p, smem, 1);
  if (PH == 104) { }
  if (PH == 5) { EpiGlu e{p.ybuf, p.b_glu, p.mix}; gemm_phase(p.ybuf, p.Wt_glu, T, 512, 512, e, smem, RowMapGroupMajor()); phase_mix_c(p, smem, 0); }
  if (PH == 6) { EpiOut e{p.x, p.hb, p.rsq1}; gemm_phase(p.mix, p.Wt_out, T, 1024, 1024, e, smem); }
  if (PH == 7) { EpiUpConv e{p.act, p.rsq1, p.conv_w, p.conv_b, (LAS float*)((LAS unsigned char*)smem + 131088)}; gemm_phase(p.hb, p.Wt_up, 68 * 256, 5632, 1024, e, smem, RowMapConv()); }
  if (PH == 8) { EpiDown e{p.out, p.hb, p.rsq2, p.bar + XCD_BAR_WORDS, p.final_g, (LAS float*)((LAS unsigned char*)smem + 131088), gridDim.x >= 256}; gemm_phase(p.act, p.Wt_down, T, 1024, 2816, e, smem); }
  if (PH == 9) { if (gridDim.x < 256) phase_final(p); }
}

#if MK_FUSED
#define PROBE_MARK(k) do { if (PROBE_K == (k)) t_mark = __builtin_amdgcn_s_memrealtime(); } while (0)
__global__ void __launch_bounds__(NTHR) fwd_megakernel(Params p) {
  extern __shared__ __attribute__((aligned(16))) char smem[];
  volatile LAS unsigned* st = (volatile LAS unsigned*)((LAS unsigned char*)smem + 131072);
  if (threadIdx.x == 0) { st[0] = 0u; st[1] = 0u; st[2] = 0u; st[3] = 0u; }
  __syncthreads();
  const XcdBarrier xb = xcd_barrier_post(p.bar, st);
  unsigned long long t_start = 0, t_mark = 0;
  if (PROBE_K >= 0) { t_start = __builtin_amdgcn_s_memrealtime(); t_mark = t_start; }
  run_phase<0>(p, smem); PROBE_MARK(21); run_phase<100>(p, smem); PROBE_MARK(20);
  cg::this_grid().sync(); PROBE_MARK(0);
  run_phase<1>(p, smem); xcd_barrier(xb); PROBE_MARK(1);
  run_phase<2>(p, smem); PROBE_MARK(23); run_phase<102>(p, smem); xcd_barrier(xb); PROBE_MARK(2);
  run_phase<3>(p, smem); PROBE_MARK(40); xcd_barrier(xb); PROBE_MARK(3);
  run_phase<4>(p, smem); PROBE_MARK(22); run_phase<104>(p, smem); xcd_barrier(xb); PROBE_MARK(4);
  run_phase<5>(p, smem); xcd_barrier(xb); PROBE_MARK(5);
  run_phase<6>(p, smem); xcd_barrier(xb); PROBE_MARK(6);
  run_phase<7>(p, smem); PROBE_MARK(41); xcd_barrier(xb); PROBE_MARK(7);
  run_phase<8>(p, smem);
  if (gridDim.x < 256) { xcd_barrier(xb); run_phase<9>(p, smem); }
  if (PROBE_K >= 30 && PROBE_K < 40) t_mark = *(volatile LAS unsigned long long*)((LAS unsigned char*)smem + 131080);
  if (PROBE_K >= 0) {
    const unsigned long long t_end = __builtin_amdgcn_s_memrealtime();
    const unsigned long long until = t_end + 4ull * (t_mark - t_start);
    while (__builtin_amdgcn_s_memrealtime() < until) __builtin_amdgcn_s_sleep(8);
  }
}
#else
template <int PH>
__global__ void __launch_bounds__(NTHR) phase_kernel(Params p) {
  extern __shared__ __attribute__((aligned(16))) char smem[];
  run_phase<PH>(p, smem);
}
template <int PH>
static void launch_phase(const Params& p, int grid, hipStream_t stream) {
  (void)hipFuncSetAttribute((const void*)phase_kernel<PH>, hipFuncAttributeMaxDynamicSharedMemorySize, LDS_BYTES);
  hipLaunchKernelGGL(phase_kernel<PH>, dim3(grid), dim3(NTHR), LDS_BYTES, stream, p);
}
#endif

extern "C" void kernel_launch(void* const* d_in, const int* in_sizes, int n_in, void* d_out, int out_size, void* d_ws,
                              size_t ws_size, hipStream_t stream) {
  Params p{};
  p.x = (const float*)d_in[0]; p.in_norm_g = (const float*)d_in[1]; p.w_in = (const float*)d_in[2]; p.hg_lb = (const float*)d_in[3];
  p.hg_norm_g = (const float*)d_in[4]; p.a_re = (const float*)d_in[5]; p.a_im = (const float*)d_in[6]; p.log_dt = (const float*)d_in[7];
  p.b_re = (const float*)d_in[8]; p.b_im = (const float*)d_in[9]; p.c_re = (const float*)d_in[10]; p.c_im = (const float*)d_in[11];
  p.s5_d = (const float*)d_in[12]; p.w_glu = (const float*)d_in[13]; p.b_glu = (const float*)d_in[14]; p.w_out = (const float*)d_in[15];
  p.ffn_norm_g = (const float*)d_in[16]; p.w_up = (const float*)d_in[17]; p.conv_w = (const float*)d_in[18]; p.conv_b = (const float*)d_in[19];
  p.w_down = (const float*)d_in[20]; p.final_g = (const float*)d_in[21];
  p.out = (float*)d_out;
  char* ws = (char*)d_ws;
  size_t off = 0;
  auto take = [&](size_t bytes) { char* r = ws + off; off += (bytes + 255) & ~(size_t)255; return r; };
  p.Wt_in = (bf16_t*)take((size_t)2560 * 1024 * 2);
  p.Wt_glu = (bf16_t*)take((size_t)512 * 512 * 2);
  p.Wt_out = (bf16_t*)take((size_t)1024 * 1024 * 2);
  p.Wt_up = (bf16_t*)take((size_t)5632 * 1024 * 2);
  p.Wt_down = (bf16_t*)take((size_t)1024 * 2816 * 2);
  p.Ktab = (bf16_t*)take((size_t)32 * 16 * 256 * 2);
  p.Etab = (bf16_t*)take((size_t)32 * 256 * 128 * 2);
  p.Ftab = (bf16_t*)take((size_t)32 * 128 * 256 * 2);
  p.Pw = (float2*)take((size_t)32 * 17 * 64 * 8);
  p.Bbar = (float2*)take((size_t)32 * 64 * 16 * 8);
  p.rsq1 = (float*)take((size_t)T * 16 * 4);
  p.rsq2 = (float*)take((size_t)T * 16 * 4);
  p.decay = (float*)take((size_t)1024 * 128 * 4);
  p.bar = (unsigned*)take((size_t)(XCD_BAR_WORDS + 64 * 64) * 4);
  const size_t dyn0 = off;
  p.xn = (bf16_t*)take((size_t)T * 1024 * 2);
  p.sstart = p.xn; p.hb = p.xn;
  const size_t r2 = off;
  p.proj = (bf16_t*)take((size_t)T * 2048 * 2);
  p.ubuf = (bf16_t*)take((size_t)T * 512 * 2);
  p.logf = (_Float16*)take((size_t)T * 512 * 4);
  p.mix = (bf16_t*)take((size_t)T * 1024 * 2);
  p.ybuf = (bf16_t*)take((size_t)T * 512 * 2);
  p.Xend = (float*)take((size_t)1024 * 32 * 128 * 4);
  p.Xs = (bf16_t*)take((size_t)1024 * 32 * 128 * 2);
  const size_t endA = off;
  p.dstate = (bf16_t*)d_out;
  off = r2;
  p.act = (bf16_t*)take((size_t)T * 2816 * 2);
  const size_t endB = off;
  (void)dyn0;
  if (endA > ws_size || endB > ws_size) fprintf(stderr, "workspace too small: need %zu / %zu have %zu\n", endA, endB, ws_size);

  static int grid_blocks = 0;
#if MK_FUSED
  if (!grid_blocks) {
    int dev = 0, cus = 0, per_cu = 0;
    (void)hipGetDevice(&dev);
    (void)hipDeviceGetAttribute(&cus, hipDeviceAttributeMultiprocessorCount, dev);
    (void)hipFuncSetAttribute((const void*)fwd_megakernel, hipFuncAttributeMaxDynamicSharedMemorySize, LDS_BYTES);
    (void)hipOccupancyMaxActiveBlocksPerMultiprocessor(&per_cu, fwd_megakernel, NTHR, LDS_BYTES);
    if (per_cu > 1) per_cu = 1;
    grid_blocks = cus * per_cu;
  }
  (void)hipMemsetAsync(p.bar, 0, (size_t)(XCD_BAR_WORDS + 64 * 64) * 4, stream);
  void* args[] = {&p};
  hipError_t e = hipLaunchCooperativeKernel((void*)fwd_megakernel, dim3(grid_blocks), dim3(NTHR), args, LDS_BYTES, stream);
  if (e != hipSuccess) fprintf(stderr, "cooperative launch failed: %s (grid %d)\n", hipGetErrorString(e), grid_blocks);
#else
  if (!grid_blocks) {
    int dev = 0, cus = 0;
    (void)hipGetDevice(&dev);
    (void)hipDeviceGetAttribute(&cus, hipDeviceAttributeMultiprocessorCount, dev);
    grid_blocks = cus;
  }
  launch_phase<0>(p, grid_blocks, stream);
  launch_phase<100>(p, grid_blocks, stream);
  launch_phase<1>(p, grid_blocks, stream);
  launch_phase<2>(p, grid_blocks, stream);
  launch_phase<102>(p, grid_blocks, stream);
  launch_phase<3>(p, grid_blocks, stream);
  launch_phase<4>(p, grid_blocks, stream);
  launch_phase<104>(p, grid_blocks, stream);
  launch_phase<5>(p, grid_blocks, stream);
  launch_phase<6>(p, grid_blocks, stream);
  launch_phase<7>(p, grid_blocks, stream);
  launch_phase<8>(p, grid_blocks, stream);
  launch_phase<9>(p, grid_blocks, stream);
#endif
}
```

```cpp
#include <hip/hip_runtime.h>
#include <hip/hip_cooperative_groups.h>
#include <stdint.h>
#include <cstdio>
namespace cg = cooperative_groups;

#ifndef PROBE_K
#define PROBE_K -1
#endif
#ifndef MK_FUSED
#define MK_FUSED 1
#endif

typedef unsigned short bf16_t;
typedef short bf16x8 __attribute__((ext_vector_type(8)));
typedef float f32x4 __attribute__((ext_vector_type(4)));

constexpr int T = 16384;
constexpr int NTHR = 512;
constexpr int LDS_BYTES = 128 * 1024 + 16 + 6144;

struct Params {
  const float *x, *in_norm_g, *w_in, *hg_lb, *hg_norm_g, *a_re, *a_im, *log_dt, *b_re, *b_im, *c_re, *c_im, *s5_d,
      *w_glu, *b_glu, *w_out, *ffn_norm_g, *w_up, *conv_w, *conv_b, *w_down, *final_g;
  float* out;
  bf16_t *Wt_in, *Wt_glu, *Wt_out, *Wt_up, *Wt_down, *xn, *proj, *sstart, *Xs, *mix, *ybuf, *ubuf, *hb, *hid, *act, *Ktab, *Etab, *Ftab;
  _Float16* logf; bf16_t* dstate;
  float *decay, *Xend, *rsq1, *rsq2;
  float2 *Pw, *Bbar;
  unsigned* bar;
};

__device__ __forceinline__ int otid() { int t = threadIdx.x; asm volatile("" : "+v"(t)); return t; }
typedef float f32x2_t __attribute__((ext_vector_type(2)));
typedef __bf16 bf16x2_t __attribute__((ext_vector_type(2)));
__device__ __forceinline__ unsigned pack2(float a, float b) { f32x2_t v = {a, b}; bf16x2_t h = __builtin_convertvector(v, bf16x2_t); return __builtin_bit_cast(unsigned, h); }
__device__ __forceinline__ bf16_t f2bf(float f) { return (bf16_t)(pack2(f, f) & 0xffffu); }
__device__ __forceinline__ float bf2f(bf16_t h) { return __uint_as_float(((unsigned)h) << 16); }
__device__ __forceinline__ float lo2f(unsigned w) { return __uint_as_float(w << 16); }
__device__ __forceinline__ float hi2f(unsigned w) { return __uint_as_float(w & 0xffff0000u); }
__device__ __forceinline__ float sigm(float x) { return __builtin_amdgcn_rcpf(1.f + __expf(-x)); }
__device__ __forceinline__ float gelu_tanh(float y) {
  float u = 0.7978845608028654f * (y + 0.044715f * y * y * y);
  return y * sigm(2.f * u);
}

typedef unsigned u32x2 __attribute__((ext_vector_type(2)));
typedef unsigned u32x4_t __attribute__((ext_vector_type(4)));
__device__ __forceinline__ void st_nt8(void* p, unsigned a, unsigned b) { u32x2 v; v.x = a; v.y = b; *(u32x2*)p = v; }
__device__ __forceinline__ void st_nt8(void* p, uint2 w) { st_nt8(p, w.x, w.y); }
__device__ __forceinline__ void st_nt16(void* p, f32x4 v) { __builtin_nontemporal_store(v, (f32x4*)p); }
__device__ __forceinline__ void st_nt16(void* p, uint4 w) { *(uint4*)p = w; }
__device__ __forceinline__ float4 ld_nt16f(const void* p) { const f32x4 t = __builtin_nontemporal_load((const f32x4*)p); return make_float4(t[0], t[1], t[2], t[3]); }
__device__ __forceinline__ uint4 ld_nt16(const void* p) { const u32x4_t t = __builtin_nontemporal_load((const u32x4_t*)p); return make_uint4(t.x, t.y, t.z, t.w); }
__device__ __forceinline__ uint2 ld_nt8(const void* p) { const u32x2 t = __builtin_nontemporal_load((const u32x2*)p); return make_uint2(t.x, t.y); }
__device__ __forceinline__ unsigned ld_nt4(const void* p) { return __builtin_nontemporal_load((const unsigned*)p); }

__device__ double exp_d(double x) {
  double k = rint(x * 1.4426950408889634);
  double r = fma(-k, 0.6931471805599453, x);
  r = fma(-k, 2.3190468138462996e-17, r);
  double p = 1.0;
#pragma unroll
  for (int i = 16; i >= 1; --i) p = fma(r * p, 1.0 / (double)i, 1.0);
  return ldexp(p, (int)k);
}
__device__ void sincos_d(double x, double& s, double& c) {
  double q = rint(x * 0.6366197723675814);
  double r = fma(-q, 1.5707963267948966, x);
  r = fma(-q, 6.123233995736766e-17, r);
  int iq = ((int)q) & 3;
  double r2 = r * r;
  double sp = 1.0, cp = 1.0;
#pragma unroll
  for (int i = 9; i >= 1; --i) sp = fma(-r2 * sp, 1.0 / (double)((2 * i) * (2 * i + 1)), 1.0);
  sp *= r;
#pragma unroll
  for (int i = 10; i >= 1; --i) cp = fma(-r2 * cp, 1.0 / (double)((2 * i - 1) * (2 * i)), 1.0);
  if (iq == 0) { s = sp; c = cp; }
  else if (iq == 1) { s = cp; c = -sp; }
  else if (iq == 2) { s = -sp; c = -cp; }
  else { s = -cp; c = sp; }
}

__device__ __forceinline__ int perm32_row(int n) { const int j = n & 31; return (n & ~31) + 16 * ((j >> 2) & 1) + 4 * (j >> 3) + (j & 3); }
__device__ __forceinline__ int up_dst_row(int n) { const int isv = n >= 2816, nn = isv ? n - 2816 : n; return ((nn >> 7) << 8) + isv * 128 + (nn & 127); }

__device__ void transpose_big(const float* __restrict__ src, bf16_t* __restrict__ dst, int K, int N, int tk, int tn,
                              const float* __restrict__ rowscale, bool perm, float* tile, bool permB = false) {
  const int tid = otid();
  const int k0 = tk * 64, n0 = tn * 256;
  float4 v[8];
#pragma unroll
  for (int i = 0; i < 8; ++i) { const int r = (tid >> 6) + 8 * i, c4 = (tid & 63) * 4; v[i] = ld_nt16f(src + (size_t)(k0 + r) * N + n0 + c4); }
#pragma unroll
  for (int i = 0; i < 8; ++i) {
    const int r = (tid >> 6) + 8 * i, c4 = (tid & 63) * 4;
    const float sc = rowscale ? rowscale[k0 + r] : 1.f;
    tile[r * 257 + c4 + 0] = v[i].x * sc; tile[r * 257 + c4 + 1] = v[i].y * sc; tile[r * 257 + c4 + 2] = v[i].z * sc; tile[r * 257 + c4 + 3] = v[i].w * sc;
  }
  __syncthreads();
  const int n = tid >> 1, kh = (tid & 1) * 32;
  int drow = perm ? up_dst_row(n0 + n) : (n0 + n);
  if (permB) drow = perm32_row(drow);
#pragma unroll
  for (int q = 0; q < 4; ++q) {
    uint4 o;
    o.x = pack2(tile[(kh + 8 * q + 0) * 257 + n], tile[(kh + 8 * q + 1) * 257 + n]);
    o.y = pack2(tile[(kh + 8 * q + 2) * 257 + n], tile[(kh + 8 * q + 3) * 257 + n]);
    o.z = pack2(tile[(kh + 8 * q + 4) * 257 + n], tile[(kh + 8 * q + 5) * 257 + n]);
    o.w = pack2(tile[(kh + 8 * q + 6) * 257 + n], tile[(kh + 8 * q + 7) * 257 + n]);
    *(uint4*)(dst + (size_t)drow * K + k0 + kh + 8 * q) = o;
  }
  __syncthreads();
}

__device__ void transpose_any(const Params& p, int t, float* tile) {
  if (t < 160) transpose_big(p.w_in, p.Wt_in, 1024, 2560, t / 10, t % 10, nullptr, false, tile, true);
  else if (t < 176) { int u = t - 160; transpose_big(p.w_glu, p.Wt_glu, 512, 512, u / 2, u % 2, nullptr, false, tile, true); }
  else if (t < 240) { int u = t - 176; transpose_big(p.w_out, p.Wt_out, 1024, 1024, u / 4, u % 4, nullptr, false, tile, true); }
  else if (t < 592) { int u = t - 240; transpose_big(p.w_up, p.Wt_up, 1024, 5632, u / 22, u % 22, p.ffn_norm_g, true, tile); }
  else { int u = t - 592; transpose_big(p.w_down, p.Wt_down, 2816, 1024, u / 4, u % 4, nullptr, false, tile); }
}

__device__ void s5_tables_block(const Params& p, int bi, char* smem) {
  float* Cr = (float*)smem; float* Ci = Cr + 1024; float* Br = Ci + 1024; float* Bi = Br + 1024;
  float2* Pj = (float2*)(Bi + 1024);
  float2* PZ = Pj + 64;
  const int tid = otid();
  const int g = bi & 31, jb = bi >> 5;
  for (int i = tid; i < 1024; i += NTHR) { Cr[i] = p.c_re[g * 1024 + i]; Ci[i] = p.c_im[g * 1024 + i]; Br[i] = p.b_re[g * 1024 + i]; Bi[i] = p.b_im[g * 1024 + i]; }
  for (int jj = 0; jj < 3; ++jj) {
    const int j = jb + 8 * jj;
    if (j > 16) break;
    __syncthreads();
    if (tid < 64) {
      const int n = tid;
      const double dt = exp_d((double)p.log_dt[g]);
      const double ar = (double)p.a_re[g * 64 + n], ai = (double)p.a_im[g * 64 + n];
      double sj, cj, s1, c1;
      const double mj = exp_d((double)j * dt * ar); sincos_d((double)j * dt * ai, sj, cj);
      const double m1 = exp_d(dt * ar); sincos_d(dt * ai, s1, c1);
      const double pr = mj * cj, pi = mj * sj;
      const double nr = m1 * c1 - 1.0, ni = m1 * s1, den = ar * ar + ai * ai;
      const double zr = (nr * ar + ni * ai) / den, zi = (ni * ar - nr * ai) / den;
      Pj[n] = make_float2((float)pr, (float)pi);
      PZ[n] = make_float2((float)(pr * zr - pi * zi), (float)(pr * zi + pi * zr));
      if (j == 16) p.Pw[g * 64 + n] = make_float2((float)pr, (float)pi);
    }
    __syncthreads();
    if (j >= 1) {
      const int t = j - 1;
#pragma unroll
      for (int i = 0; i < 4; ++i) {
        const int idx = tid + 512 * i, pp = idx >> 7, np = idx & 127, n = np & 63, part = np >> 6;
        const float2 pw = Pj[n];
        const float cr = Cr[pp * 64 + n], ci = Ci[pp * 64 + n];
        const float v = part ? -(cr * pw.y + ci * pw.x) : (cr * pw.x - ci * pw.y);
        p.Etab[(size_t)(g * 256 + t * 16 + pp) * 128 + np] = f2bf(v);
      }
    }
    if (j <= 15) {
      const int sidx = 15 - j;
#pragma unroll
      for (int i = 0; i < 4; ++i) {
        const int idx = tid + 512 * i, np = idx >> 4, pq = idx & 15, n = np & 63, part = np >> 6;
        const float2 m = PZ[n];
        const float br = Br[n * 16 + pq], bi2 = Bi[n * 16 + pq];
        const float v = part ? (m.x * bi2 + m.y * br) : (m.x * br - m.y * bi2);
        p.Ftab[(size_t)(g * 128 + np) * 256 + sidx * 16 + pq] = f2bf(v);
      }
      if (tid < 256) {
        const int pp = tid >> 4, pq = tid & 15;
        float acc = 0.f;
#pragma unroll 8
        for (int n = 0; n < 64; ++n) {
          const float2 m = PZ[n];
          const float br = Br[n * 16 + pq], bi2 = Bi[n * 16 + pq];
          const float cr = Cr[pp * 64 + n], ci = Ci[pp * 64 + n];
          const float mr = m.x * br - m.y * bi2, mi = m.x * bi2 + m.y * br;
          acc += cr * mr - ci * mi;
        }
        p.Ktab[(size_t)((g * 16 + j) * 16 + pp) * 16 + pq] = f2bf(acc);
      }
    }
  }
  __syncthreads();
}

__device__ void phase_prep(const Params& p, char* smem) {
  float* tile = (float*)smem;
  const int tid = otid(), lane = tid & 63, wid = tid >> 6;
  const int gtid = blockIdx.x * NTHR + tid, gthr = gridDim.x * NTHR;
  for (int idx = gtid; idx < T; idx += gthr) { p.rsq1[idx] = 0.f; p.rsq2[idx] = 0.f; }
  const int ntr = (gridDim.x == 256) ? 160 : 768;
  for (int t = blockIdx.x; t < ntr; t += gridDim.x) transpose_any(p, t, tile);
  for (int t = blockIdx.x; t < 256; t += gridDim.x) s5_tables_block(p, t, smem);
}
__device__ void phase_prep_xn(const Params& p) {
  const int tid = otid(), lane = tid & 63, wid = tid >> 6;
  for (int row0 = (blockIdx.x * 8 + wid) * 8; row0 < T; row0 += gridDim.x * 64) {
    float4 v[8][4]; float ss[8];
#pragma unroll
    for (int r = 0; r < 8; ++r) {
      const float4* xr = (const float4*)(p.x + (size_t)(row0 + r) * 1024);
#pragma unroll
      for (int i = 0; i < 4; ++i) { const f32x4 t = __builtin_nontemporal_load((const f32x4*)xr + lane + 64 * i); v[r][i] = make_float4(t[0], t[1], t[2], t[3]); }
    }
#pragma unroll
    for (int r = 0; r < 8; ++r) {
      float a = 0.f;
#pragma unroll
      for (int i = 0; i < 4; ++i) a += v[r][i].x * v[r][i].x + v[r][i].y * v[r][i].y + v[r][i].z * v[r][i].z + v[r][i].w * v[r][i].w;
#pragma unroll
      for (int o = 32; o >= 1; o >>= 1) a += __shfl_xor(a, o);
      ss[r] = rsqrtf(a * (1.f / 1024.f) + 1e-6f);
    }
#pragma unroll
    for (int i = 0; i < 4; ++i) {
      const float4 g = ((const float4*)p.in_norm_g)[lane + 64 * i];
#pragma unroll
      for (int r = 0; r < 8; ++r) {
        uint2 o; o.x = pack2(v[r][i].x * ss[r] * g.x, v[r][i].y * ss[r] * g.y); o.y = pack2(v[r][i].z * ss[r] * g.z, v[r][i].w * ss[r] * g.w);
        *(uint2*)(p.xn + (size_t)(row0 + r) * 1024 + (lane + 64 * i) * 4) = o;
      }
    }
  }
}

struct TileMap {
  int nM, nN, nwg;
  __device__ void init(int M, int N) { nM = M / 256; nN = N / 256; nwg = nM * nN; }
  __device__ void get(int L, int& pm, int& pn) const {
    int wgid = L;
    { const int q = nwg / 8, r = nwg % 8, xcd = wgid % 8, off = wgid / 8; wgid = (xcd < r ? xcd * (q + 1) : r * (q + 1) + (xcd - r) * q) + off; }
    const int nig = 8 * nN, gid = wgid / nig, fm = gid * 8, gsz = (nM - fm) < 8 ? (nM - fm) : 8;
    pm = fm + ((wgid % nig) % gsz); pn = (wgid % nig) / gsz;
  }
};

#define LAS __attribute__((address_space(3)))
constexpr int G_BK = 64, G_HALF = 128, G_HTB = G_HALF * G_BK * 2;
__device__ __forceinline__ int lds_byte(int r, int c) {
  const int st = (r >> 4) * 2 + (c >> 5), rr = r & 15, cc = c & 31, ob = rr * 64 + cc * 2;
  return st * 1024 + (ob ^ (((ob >> 9) & 1) << 5));
}
__device__ __forceinline__ void stage_rc(int b, int& R, int& C) {
  const int st = b / 1024, sb = b % 1024, swz = sb ^ (((sb >> 9) & 1) << 5);
  R = (st >> 1) * 16 + swz / 64; C = (st & 1) * 32 + (swz % 64) / 2;
}

struct RowMapLinear { static constexpr bool PERMA = false, GMAJ = false; __device__ __forceinline__ long operator()(int pm) const { return (long)pm * 256; } };
struct RowMapGroupMajor { static constexpr bool PERMA = false, GMAJ = true; __device__ __forceinline__ long operator()(int pm) const { return (long)pm * 256; } };
struct RowMapConv { static constexpr bool PERMA = true, GMAJ = false; __device__ __forceinline__ long operator()(int pm) const { return (long)(pm / 17) * 4096 + 254 * (pm % 17) - 2; } };

template <class Epi, class RowMap = RowMapLinear>
__device__ __forceinline__ void gemm_phase(const bf16_t* __restrict__ A, const bf16_t* __restrict__ Bt, int M, int N, int K,
                                           const Epi& E, char* smem, const RowMap rmap = RowMap()) {
  LAS unsigned char* lds = (LAS unsigned char*)smem;
  const int tid = otid(), wid = __builtin_amdgcn_readfirstlane(tid >> 6), lane = tid & 63, wr = wid >> 2, wc = wid & 3, fr = lane & 15, fq = lane >> 4;
  const int nt = K / G_BK;
  TileMap tm; tm.init(M, N);
  if ((int)blockIdx.x >= tm.nwg) return;
  unsigned voffA[2], voffB[2];
#pragma unroll
  for (int i = 0; i < 2; ++i) {
    int R, C; stage_rc(tid * 16 + i * 8192, R, C);
    voffB[i] = (unsigned)(R * K + C) * 2u;
    const int Ra = RowMap::PERMA ? ((R & ~63) + 4 * (R & 15) + ((R >> 4) & 3)) : R;
    voffA[i] = RowMap::GMAJ ? (unsigned)((((C >> 4) * M + Ra) * 16 + (C & 15)) * 2) : (unsigned)(Ra * K + C) * 2u;
  }
  const size_t kstep = (size_t)(G_BK * 2);
  const size_t kstepA = RowMap::GMAJ ? (size_t)4 * M * 32 : kstep;
  const size_t hstepA = RowMap::GMAJ ? (size_t)G_HALF * 32 : (size_t)G_HALF * K * 2;
  const size_t hstep = (size_t)G_HALF * K * 2;
  const size_t tstep = 2 * hstep;
  const unsigned ldsw = (unsigned)wid * 1024u;
  const int aoff = lds_byte(wr * 64 + fr, fq * 8), boff = lds_byte(wc * 32 + fr, fq * 8);
#define PG8_SA(b, h) (((b) * 2 + (h)) * G_HTB)
#define PG8_SB(b, h) ((4 + (b) * 2 + (h)) * G_HTB)
#define PG8_STAGE(bufoff, gbase, voff) do { _Pragma("unroll") for (int _i = 0; _i < 2; ++_i) \
    __builtin_amdgcn_global_load_lds((const unsigned*)((const char*)(gbase) + (voff)[_i]), (LAS unsigned*)(lds + (bufoff) + ldsw + _i * 8192), 16, 0, 0); } while (0)
#define PG8_LDA(dst, b, h) do { _Pragma("unroll") for (int m = 0; m < 4; ++m) _Pragma("unroll") for (int k = 0; k < 2; ++k) dst[m][k] = *(const LAS bf16x8*)(lds + PG8_SA(b, h) + aoff + m * 2048 + k * 1024); } while (0)
#define PG8_LDB(dst, b, h) do { _Pragma("unroll") for (int n = 0; n < 2; ++n) _Pragma("unroll") for (int k = 0; k < 2; ++k) dst[n][k] = *(const LAS bf16x8*)(lds + PG8_SB(b, h) + boff + n * 2048 + k * 1024); } while (0)
#define PG8_MMA(ai, bj, At_, Bt_) do { __builtin_amdgcn_s_setprio(1); _Pragma("unroll") for (int m = 0; m < 4; ++m) _Pragma("unroll") for (int n = 0; n < 2; ++n) _Pragma("unroll") for (int k = 0; k < 2; ++k) \
    acc[ai][bj][m][n] = __builtin_amdgcn_mfma_f32_16x16x32_bf16(Bt_[n][k], At_[m][k], acc[ai][bj][m][n], 0, 0, 0); __builtin_amdgcn_s_setprio(0); } while (0)
#define PG8_WAIT_V(n) asm volatile("s_waitcnt vmcnt(" #n ")" ::: "memory")
#define PG8_WAIT_L(n) asm volatile("s_waitcnt lgkmcnt(" #n ")" ::: "memory")
#define PG8_BAR __builtin_amdgcn_s_barrier()
#define PG8_SCHED __builtin_amdgcn_sched_barrier(0)
  int pm, pn, npm = 0, npn = 0, ui = 0;
  tm.get((int)blockIdx.x, pm, pn);
  f32x4 acc[2][2][4][2];
#pragma unroll
  for (int a = 0; a < 2; ++a)
#pragma unroll
    for (int b = 0; b < 2; ++b)
#pragma unroll
      for (int m = 0; m < 4; ++m)
#pragma unroll
        for (int n = 0; n < 2; ++n) acc[a][b][m][n] = (f32x4){0.f, 0.f, 0.f, 0.f};
  bf16x8 At[4][2], B0[2][2], B1[2][2];
  const size_t rstep = RowMap::GMAJ ? (size_t)32 : (size_t)K * 2;
  const char* cA = (const char*)A + rmap(pm) * (long)rstep; const char* cB = (const char*)Bt + (size_t)pn * tstep;
  PG8_WAIT_V(0); __syncthreads();
  PG8_STAGE(PG8_SB(0, 0), cB, voffB); PG8_STAGE(PG8_SA(0, 0), cA, voffA); PG8_STAGE(PG8_SB(0, 1), cB + hstep, voffB); PG8_STAGE(PG8_SA(0, 1), cA + hstepA, voffA);
  if (wr == 1) PG8_BAR;
  PG8_WAIT_V(4); PG8_BAR;
  PG8_STAGE(PG8_SB(1, 0), cB + kstep, voffB); PG8_STAGE(PG8_SA(1, 0), cA + kstepA, voffA); PG8_STAGE(PG8_SB(1, 1), cB + hstep + kstep, voffB);
  PG8_WAIT_V(6); PG8_BAR;
  for (;;) {
    const int Ln = (ui + 1) * (int)gridDim.x + (int)blockIdx.x;
    const bool has_next = Ln < tm.nwg;
    if (has_next) tm.get(Ln, npm, npn);
    const char* nA = has_next ? (const char*)A + rmap(npm) * (long)rstep : cA; const char* nB = has_next ? (const char*)Bt + (size_t)npn * tstep : cB;
    for (int t = 0; t < nt; t += 2) {
      const bool last = (t == nt - 2);
      const char* a1 = cA + (size_t)(t + 1) * kstepA;
      const char* a2 = last ? nA : cA + (size_t)(t + 2) * kstepA; const char* b2 = last ? nB : cB + (size_t)(t + 2) * kstep;
      const char* a3 = a2 + kstepA; const char* b3 = b2 + kstep;
      PG8_LDB(B0, 0, 0); PG8_SCHED; PG8_LDA(At, 0, 0); PG8_STAGE(PG8_SA(1, 1), a1 + hstepA, voffA);
      PG8_WAIT_L(8); PG8_BAR; PG8_WAIT_L(0); PG8_MMA(0, 0, At, B0); PG8_BAR; PG8_SCHED;
      PG8_LDB(B1, 0, 1); PG8_STAGE(PG8_SB(0, 0), b2, voffB);
      PG8_BAR; PG8_WAIT_L(0); PG8_MMA(0, 1, At, B1); PG8_BAR;
      PG8_LDA(At, 0, 1); PG8_STAGE(PG8_SA(0, 0), a2, voffA);
      PG8_BAR; PG8_WAIT_L(0); PG8_MMA(1, 0, At, B0); PG8_BAR; PG8_SCHED;
      PG8_STAGE(PG8_SB(0, 1), b2 + hstep, voffB);
      PG8_WAIT_V(6); PG8_BAR; PG8_MMA(1, 1, At, B1); PG8_BAR;
      PG8_LDB(B0, 1, 0); PG8_SCHED; PG8_LDA(At, 1, 0); PG8_STAGE(PG8_SA(0, 1), a2 + hstepA, voffA);
      PG8_WAIT_L(8); PG8_BAR; PG8_WAIT_L(0); PG8_MMA(0, 0, At, B0); PG8_BAR; PG8_SCHED;
      PG8_LDB(B1, 1, 1); PG8_STAGE(PG8_SB(1, 0), b3, voffB);
      PG8_BAR; PG8_WAIT_L(0); PG8_MMA(0, 1, At, B1); PG8_BAR;
      PG8_LDA(At, 1, 1); PG8_STAGE(PG8_SA(1, 0), a3, voffA);
      PG8_BAR; PG8_WAIT_L(0); PG8_MMA(1, 0, At, B0); PG8_BAR; PG8_SCHED;
      PG8_STAGE(PG8_SB(1, 1), b3 + hstep, voffB);
      PG8_WAIT_V(6); PG8_BAR; PG8_MMA(1, 1, At, B1); PG8_BAR;
    }
    E(acc, pm, pn, wr, wc, fr, fq);
    if (!has_next) break;
#pragma unroll
    for (int a = 0; a < 2; ++a)
#pragma unroll
      for (int b = 0; b < 2; ++b)
#pragma unroll
        for (int m = 0; m < 4; ++m)
#pragma unroll
          for (int n = 0; n < 2; ++n) acc[a][b][m][n] = (f32x4){0.f, 0.f, 0.f, 0.f};
    pm = npm; pn = npn; cA = nA; cB = nB; ++ui;
  }
  PG8_WAIT_V(0);
  if (wr == 0) PG8_BAR;
  PG8_BAR;
#undef PG8_SA
#undef PG8_SB
#undef PG8_STAGE
#undef PG8_LDA
#undef PG8_LDB
#undef PG8_MMA
#undef PG8_WAIT_V
#undef PG8_WAIT_L
#undef PG8_BAR
#undef PG8_SCHED
}

#define PROBE_STAMP_ONCE(k, base) do { if (PROBE_K == (k) && threadIdx.x == 0) { volatile LAS unsigned long long* _s = (volatile LAS unsigned long long*)((LAS unsigned char*)(base) - 8); \
    if (*_s == 0ull) *_s = __builtin_amdgcn_s_memrealtime(); } } while (0)
struct EpiProj {
  bf16_t* proj; bf16_t* ubuf; _Float16* lgf; const float* hg_lb;
  __device__ __forceinline__ void operator()(const f32x4 (&acc)[2][2][4][2], int pm, int pn, int wr, int wc, int fr, int fq) const {
    const int sec = pn >> 1;
    if (sec == 1) {
#pragma unroll
      for (int b = 0; b < 2; ++b) {
        const int c8 = 256 * pn + 128 * b + 32 * wc + 8 * fq;
        float lb[8];
#pragma unroll
        for (int n = 0; n < 2; ++n) {
          const float4 h0 = *(const float4*)(hg_lb + (c8 - 512) + 4 * n), h1 = *(const float4*)(hg_lb + c8 + 4 * n);
          lb[4 * n + 0] = __builtin_amdgcn_rcpf(1.f + __expf(h1.x - h0.x)); lb[4 * n + 1] = __builtin_amdgcn_rcpf(1.f + __expf(h1.y - h0.y));
          lb[4 * n + 2] = __builtin_amdgcn_rcpf(1.f + __expf(h1.z - h0.z)); lb[4 * n + 3] = __builtin_amdgcn_rcpf(1.f + __expf(h1.w - h0.w));
        }
#pragma unroll
        for (int a = 0; a < 2; ++a)
#pragma unroll
          for (int m = 0; m < 4; ++m) {
            const int row = 256 * pm + 128 * a + 64 * wr + 16 * m + fr;
            typedef _Float16 f16x8 __attribute__((ext_vector_type(8)));
            f16x8 lh; float kk[8];
#pragma unroll
            for (int n = 0; n < 2; ++n)
#pragma unroll
              for (int r = 0; r < 4; ++r) {
                const float l = lb[4 * n + r], x = acc[a][b][m][n][r];
                const float sg = __builtin_amdgcn_rcpf(1.f + __expf(-x));
                lh[4 * n + r] = (_Float16)__logf(l + (1.f - l) * sg);
                kk[4 * n + r] = (1.f - l) * __builtin_amdgcn_rcpf(1.f + __expf(x));
              }
            *(f16x8*)(lgf + (size_t)row * 512 + (c8 - 512)) = lh;
            st_nt16(proj + (size_t)row * 2048 + c8, make_uint4(pack2(kk[0], kk[1]), pack2(kk[2], kk[3]), pack2(kk[4], kk[5]), pack2(kk[6], kk[7])));
          }
      }
    } else {
#pragma unroll
      for (int a = 0; a < 2; ++a)
#pragma unroll
        for (int m = 0; m < 4; ++m) {
          const int row = 256 * pm + 128 * a + 64 * wr + 16 * m + fr;
#pragma unroll
          for (int b = 0; b < 2; ++b) {
            const int c8 = 256 * pn + 128 * b + 32 * wc + 8 * fq;
            const f32x4 v0 = acc[a][b][m][0], v1 = acc[a][b][m][1];
            const uint4 o = make_uint4(pack2(v0[0], v0[1]), pack2(v0[2], v0[3]), pack2(v1[0], v1[1]), pack2(v1[2], v1[3]));
            if (sec == 4) st_nt16(ubuf + ((size_t)((c8 - 2048) >> 4) * T + row) * 16 + (c8 & 15), o);
            else st_nt16(proj + (size_t)row * 2048 + c8, o);
          }
        }
    }
  }
};

struct EpiGlu {
  const bf16_t* ybuf; const float* b_glu; bf16_t* mix;
  __device__ __forceinline__ void operator()(const f32x4 (&acc)[2][2][4][2], int pm, int pn, int wr, int wc, int fr, int fq) const {
#pragma unroll
    for (int a = 0; a < 2; ++a)
#pragma unroll
      for (int m = 0; m < 4; ++m) {
        const int row = 256 * pm + 128 * a + 64 * wr + 16 * m + fr;
#pragma unroll
        for (int b = 0; b < 2; ++b) {
          const int c8 = 256 * pn + 128 * b + 32 * wc + 8 * fq;
          const f32x4 v0 = acc[a][b][m][0], v1 = acc[a][b][m][1];
          const float4 b0 = *(const float4*)(b_glu + c8), b1 = *(const float4*)(b_glu + c8 + 4);
          const uint4 yw = ld_nt16(ybuf + ((size_t)(c8 >> 4) * T + row) * 16 + (c8 & 15));
          const float o0 = lo2f(yw.x) * sigm(v0[0] + b0.x), o1 = hi2f(yw.x) * sigm(v0[1] + b0.y), o2 = lo2f(yw.y) * sigm(v0[2] + b0.z), o3 = hi2f(yw.y) * sigm(v0[3] + b0.w);
          const float o4 = lo2f(yw.z) * sigm(v1[0] + b1.x), o5 = hi2f(yw.z) * sigm(v1[1] + b1.y), o6 = lo2f(yw.w) * sigm(v1[2] + b1.z), o7 = hi2f(yw.w) * sigm(v1[3] + b1.w);
          st_nt16(mix + (size_t)row * 1024 + 512 + c8, make_uint4(pack2(o0, o1), pack2(o2, o3), pack2(o4, o5), pack2(o6, o7)));
        }
      }
  }
};


struct EpiOut {
  const float* x; bf16_t* hb; float* rsq;
  __device__ __forceinline__ void operator()(const f32x4 (&acc)[2][2][4][2], int pm, int pn, int wr, int wc, int fr, int fq) const {
#pragma unroll
    for (int a = 0; a < 2; ++a)
#pragma unroll
      for (int m = 0; m < 4; ++m) {
        const int row = 256 * pm + 128 * a + 64 * wr + 16 * m + fr;
        float ss = 0.f;
#pragma unroll
        for (int b = 0; b < 2; ++b) {
          const int c8 = 256 * pn + 128 * b + 32 * wc + 8 * fq;
          const f32x4 v0 = acc[a][b][m][0], v1 = acc[a][b][m][1];
          const float4 x0 = ld_nt16f(x + (size_t)row * 1024 + c8), x1 = ld_nt16f(x + (size_t)row * 1024 + c8 + 4);
          const float h0 = x0.x + v0[0], h1 = x0.y + v0[1], h2 = x0.z + v0[2], h3 = x0.w + v0[3];
          const float h4 = x1.x + v1[0], h5 = x1.y + v1[1], h6 = x1.z + v1[2], h7 = x1.w + v1[3];
          st_nt16(hb + (size_t)row * 1024 + c8, make_uint4(pack2(h0, h1), pack2(h2, h3), pack2(h4, h5), pack2(h6, h7)));
          ss += (h0 * h0 + h1 * h1) + (h2 * h2 + h3 * h3) + (h4 * h4 + h5 * h5) + (h6 * h6 + h7 * h7);
        }
        ss += __shfl_xor(ss, 16); ss += __shfl_xor(ss, 32);
        if (fq == 0) unsafeAtomicAdd(rsq + row, ss);
      }
  }
};

template <int CTRL> __device__ __forceinline__ float dpp_upd(float old, float src) {
  return __int_as_float(__builtin_amdgcn_update_dpp(__float_as_int(old), __float_as_int(src), CTRL, 0xf, 0xf, false));
}
struct EpiUpConv {
  bf16_t* act; const float* rsq; const float* conv_w; const float* conv_b; LAS float* xb;
  __device__ __forceinline__ void operator()(f32x4 (&acc)[2][2][4][2], int pm, int pn, int wr, int wc, int fr, int fq) const {
    PROBE_STAMP_ONCE(31, xb);
    const int seq = pm / 17, it = pm - seq * 17, l0 = 254 * it - 2;
#pragma unroll
    for (int a = 0; a < 2; ++a)
#pragma unroll
      for (int m = 0; m < 4; ++m) {
        const int l = l0 + 128 * a + 64 * wr + 4 * fr + m;
        int tok = seq * 4096 + l; tok = tok < 0 ? 0 : (tok > T - 1 ? T - 1 : tok);
        float rstd = rsqrtf(rsq[tok] * (1.f / 1024.f) + 1e-6f);
#pragma unroll
        for (int b = 0; b < 2; ++b)
#pragma unroll
          for (int n = 0; n < 2; ++n) {
            f32x4 v = acc[a][b][m][n] * rstd;
            if (a == 0 && m < 2 && l < 0) v = (f32x4){0.f, 0.f, 0.f, 0.f};
            acc[a][b][m][n] = v;
          }
      }
    if (fr == 15) {
#pragma unroll
      for (int a = 0; a < 2; ++a) {
        const int bd = 2 * a + wr;
        if (bd < 3) {
#pragma unroll
          for (int q = 0; q < 2; ++q)
#pragma unroll
            for (int b = 0; b < 2; ++b)
#pragma unroll
              for (int n = 0; n < 2; ++n) *(LAS f32x4*)(xb + ((bd * 2 + q) * 2 + b) * 128 + 32 * wc + 16 * n + 4 * fq) = acc[a][b][2 + q][n];
        }
      }
    }
    asm volatile("s_waitcnt lgkmcnt(0)" ::: "memory");
    __builtin_amdgcn_s_barrier(); asm volatile("" ::: "memory");
    __builtin_amdgcn_s_barrier(); asm volatile("" ::: "memory");
#pragma unroll
    for (int n = 0; n < 2; ++n) {
      const int c = pn * 128 + 32 * wc + 16 * n + 4 * fq;
      const f32x4 wg0 = *(const f32x4*)(conv_w + c), wg1 = *(const f32x4*)(conv_w + 5632 + c), wg2 = *(const f32x4*)(conv_w + 2 * 5632 + c);
      const f32x4 wv0 = *(const f32x4*)(conv_w + 2816 + c), wv1 = *(const f32x4*)(conv_w + 5632 + 2816 + c), wv2 = *(const f32x4*)(conv_w + 2 * 5632 + 2816 + c);
      const f32x4 bg = *(const f32x4*)(conv_b + c), bv = *(const f32x4*)(conv_b + 2816 + c);
#pragma unroll
      for (int a = 0; a < 2; ++a) {
        const int bdp = 2 * a + wr - 1;
        f32x4 g2b = (f32x4){0.f, 0.f, 0.f, 0.f}, g1b = g2b, v2b = g2b, v1b = g2b;
        if (bdp >= 0 && fr == 0) {
          g2b = *(const LAS f32x4*)(xb + ((bdp * 2 + 0) * 2 + 0) * 128 + 32 * wc + 16 * n + 4 * fq);
          v2b = *(const LAS f32x4*)(xb + ((bdp * 2 + 0) * 2 + 1) * 128 + 32 * wc + 16 * n + 4 * fq);
          g1b = *(const LAS f32x4*)(xb + ((bdp * 2 + 1) * 2 + 0) * 128 + 32 * wc + 16 * n + 4 * fq);
          v1b = *(const LAS f32x4*)(xb + ((bdp * 2 + 1) * 2 + 1) * 128 + 32 * wc + 16 * n + 4 * fq);
        }
        f32x4 pg3, pg2, pv3, pv2;
#pragma unroll
        for (int r = 0; r < 4; ++r) {
          pg3[r] = dpp_upd<0x111>(g1b[r], acc[a][0][3][n][r]); pg2[r] = dpp_upd<0x111>(g2b[r], acc[a][0][2][n][r]);
          pv3[r] = dpp_upd<0x111>(v1b[r], acc[a][1][3][n][r]); pv2[r] = dpp_upd<0x111>(v2b[r], acc[a][1][2][n][r]);
        }
#pragma unroll
        for (int m = 0; m < 4; ++m) {
          const f32x4 cg = acc[a][0][m][n], cv = acc[a][1][m][n];
          const f32x4 s1g = m == 0 ? pg3 : acc[a][0][m == 0 ? 0 : m - 1][n], s2g = m == 0 ? pg2 : (m == 1 ? pg3 : acc[a][0][m < 2 ? 0 : m - 2][n]);
          const f32x4 s1v = m == 0 ? pv3 : acc[a][1][m == 0 ? 0 : m - 1][n], s2v = m == 0 ? pv2 : (m == 1 ? pv3 : acc[a][1][m < 2 ? 0 : m - 2][n]);
          const f32x4 G = bg + wg0 * s2g + wg1 * s1g + wg2 * cg;
          const f32x4 V = bv + wv0 * s2v + wv1 * s1v + wv2 * cv;
          const int rr = 128 * a + 64 * wr + 4 * fr + m, l = l0 + rr;
          if (rr >= 2 && l < 4096) {
            uint2 ow; ow.x = pack2(G[0] * sigm(G[0]) * V[0], G[1] * sigm(G[1]) * V[1]); ow.y = pack2(G[2] * sigm(G[2]) * V[2], G[3] * sigm(G[3]) * V[3]);
            st_nt8(act + (size_t)(seq * 4096 + l) * 2816 + c, ow);
          }
        }
      }
    }
    PROBE_STAMP_ONCE(32, xb);
  }
};

struct EpiDown {
  float* out; const bf16_t* hb; float* rsq; unsigned* cnt; const float* g; LAS float* red; bool fused;
  __device__ __forceinline__ void operator()(f32x4 (&acc)[2][2][4][2], int pm, int pn, int wr, int wc, int fr, int fq) const {
    PROBE_STAMP_ONCE(30, red);
#pragma unroll
    for (int a = 0; a < 2; ++a)
#pragma unroll
      for (int m = 0; m < 4; ++m) {
        const int row = 256 * pm + 128 * a + 64 * wr + 16 * m + fr;
        float ss = 0.f;
#pragma unroll
        for (int b = 0; b < 2; ++b)
#pragma unroll
          for (int n = 0; n < 2; ++n) {
            const int col = 256 * pn + 128 * b + 32 * wc + 16 * n + 4 * fq;
            const uint2 hw = ld_nt8(hb + (size_t)row * 1024 + col);
            f32x4 v = acc[a][b][m][n];
            v[0] += lo2f(hw.x); v[1] += hi2f(hw.x); v[2] += lo2f(hw.y); v[3] += hi2f(hw.y);
            acc[a][b][m][n] = v;
            ss += v[0] * v[0] + v[1] * v[1] + v[2] * v[2] + v[3] * v[3];
          }
        ss += __shfl_xor(ss, 16); ss += __shfl_xor(ss, 32);
        if (fused) { if (fq == 0) red[(128 * a + 64 * wr + 16 * m + fr) * 4 + wc] = ss; }
        else if (fq == 0) unsafeAtomicAdd(rsq + row, ss);
      }
    if (!fused) {
#pragma unroll
      for (int a = 0; a < 2; ++a)
#pragma unroll
        for (int m = 0; m < 4; ++m) {
          const int row = 256 * pm + 128 * a + 64 * wr + 16 * m + fr;
#pragma unroll
          for (int b = 0; b < 2; ++b)
#pragma unroll
            for (int n = 0; n < 2; ++n) {
              const int col = 256 * pn + 128 * b + 32 * wc + 16 * n + 4 * fq;
              const f32x4 v = acc[a][b][m][n];
              *(float4*)(out + (size_t)row * 1024 + col) = make_float4(v[0], v[1], v[2], v[3]);
            }
        }
      return;
    }
    asm volatile("s_waitcnt lgkmcnt(0)" ::: "memory");
    __builtin_amdgcn_s_barrier(); asm volatile("" ::: "memory");
    __builtin_amdgcn_s_barrier(); asm volatile("" ::: "memory");
    const int wid = wr * 4 + wc, lane = fq * 16 + fr;
    unsigned* c = cnt + pm * 64;
    if (wid < 4) {
      const int r = wid * 64 + lane;
      const f32x4 q = *(const LAS f32x4*)(red + r * 4);
      const float old = unsafeAtomicAdd(rsq + 256 * pm + r, (q[0] + q[1]) + (q[2] + q[3]));
      asm volatile("s_waitcnt vmcnt(0)" :: "v"(old) : "memory");
      if (lane == 0) __hip_atomic_fetch_add(c, 1u, __ATOMIC_RELAXED, __HIP_MEMORY_SCOPE_AGENT);
    }
    {
      unsigned spins = 0;
      while ((unsigned)__builtin_amdgcn_readfirstlane((int)__hip_atomic_load(c, __ATOMIC_RELAXED, __HIP_MEMORY_SCOPE_AGENT)) < 16u) {
        __builtin_amdgcn_s_sleep(2);
        if (++spins > (1u << 22)) break;
      }
    }
#pragma unroll
    for (int a = 0; a < 2; ++a)
#pragma unroll
      for (int m = 0; m < 4; ++m) {
        const int row = 256 * pm + 128 * a + 64 * wr + 16 * m + fr;
        const float rstd = rsqrtf(__hip_atomic_load(rsq + row, __ATOMIC_RELAXED, __HIP_MEMORY_SCOPE_AGENT) * (1.f / 1024.f) + 1e-6f);
#pragma unroll
        for (int b = 0; b < 2; ++b)
#pragma unroll
          for (int n = 0; n < 2; ++n) {
            const int col = 256 * pn + 128 * b + 32 * wc + 16 * n + 4 * fq;
            const float4 gv = *(const float4*)(g + col);
            const f32x4 v = acc[a][b][m][n];
            st_nt16(out + (size_t)row * 1024 + col, (f32x4){v[0] * rstd * gv.x, v[1] * rstd * gv.y, v[2] * rstd * gv.z, v[3] * rstd * gv.w});
          }
      }
  }
};

typedef _Float16 f16x2_t __attribute__((ext_vector_type(2)));
__device__ void hg_a_item(const Params& p, int item, char* smem) {
  bf16_t* kT = (bf16_t*)smem;
  bf16_t* vT = kT + 128 * 72;
  float* tot = (float*)(vT + 128 * 72);
  _Float16* Lf = (_Float16*)(smem + 40960); bf16_t* Kr = (bf16_t*)(Lf + 8192); bf16_t* Vr = Kr + 8192;
  const int tid = otid(), lane = tid & 63, wid = tid >> 6, fr = lane & 15, fq = lane >> 4;
  const int b = item >> 8, h = (item >> 6) & 3, n = item & 63;
  const int t0 = b * 4096 + n * 64;
  const int kp = tid & 63, seg = tid >> 6;
  {
    uint4 rw[6];
#pragma unroll
    for (int i = 0; i < 2; ++i) {
      const int c = tid + 512 * i, row = c >> 4, cc = c & 15;
      rw[i] = ld_nt16(p.logf + (size_t)(t0 + row) * 512 + h * 128 + cc * 8);
      rw[2 + i] = ld_nt16(p.proj + (size_t)(t0 + row) * 2048 + 512 + h * 128 + cc * 8);
      rw[4 + i] = ld_nt16(p.proj + (size_t)(t0 + row) * 2048 + 1024 + h * 128 + cc * 8);
    }
#pragma unroll
    for (int i = 0; i < 2; ++i) {
      const int c = tid + 512 * i, row = c >> 4, cc = c & 15;
      *(uint4*)(Lf + row * 128 + cc * 8) = rw[i]; *(uint4*)(Kr + row * 128 + cc * 8) = rw[2 + i]; *(uint4*)(Vr + row * 128 + cc * 8) = rw[4 + i];
    }
  }
  __syncthreads();
  float b0[8], b1[8];
  {
    float a0 = 0.f, a1 = 0.f;
#pragma unroll
    for (int i = 0; i < 8; ++i) {
      const f16x2_t l2 = *(const f16x2_t*)(Lf + (seg * 8 + i) * 128 + 2 * kp);
      a0 += (float)l2[0]; a1 += (float)l2[1]; b0[i] = a0; b1[i] = a1;
    }
    *(float2*)(tot + seg * 128 + 2 * kp) = make_float2(a0, a1);
  }
  __syncthreads();
  float pre0 = 0.f, pre1 = 0.f, all0 = 0.f, all1 = 0.f;
#pragma unroll
  for (int s8 = 0; s8 < 8; ++s8) { const float2 tv = *(const float2*)(tot + s8 * 128 + 2 * kp); if (s8 < seg) { pre0 += tv.x; pre1 += tv.y; } all0 += tv.x; all1 += tv.y; }
  {
    float k0[8], k1[8]; unsigned v0[4], v1[4];
#pragma unroll
    for (int i = 0; i < 8; ++i) {
      const unsigned kw = *(const unsigned*)(Kr + (seg * 8 + i) * 128 + 2 * kp), vw = *(const unsigned*)(Vr + (seg * 8 + i) * 128 + 2 * kp);
      k0[i] = lo2f(kw) * __expf(all0 - (b0[i] + pre0)); k1[i] = hi2f(kw) * __expf(all1 - (b1[i] + pre1));
      if (i & 1) { v0[i >> 1] |= vw << 16; v1[i >> 1] |= vw & 0xffff0000u; } else { v0[i >> 1] = vw & 0xffffu; v1[i >> 1] = vw >> 16; }
    }
    *(uint4*)(kT + (2 * kp) * 72 + seg * 8) = make_uint4(pack2(k0[0], k0[1]), pack2(k0[2], k0[3]), pack2(k0[4], k0[5]), pack2(k0[6], k0[7]));
    *(uint4*)(kT + (2 * kp + 1) * 72 + seg * 8) = make_uint4(pack2(k1[0], k1[1]), pack2(k1[2], k1[3]), pack2(k1[4], k1[5]), pack2(k1[6], k1[7]));
    *(uint4*)(vT + (2 * kp) * 72 + seg * 8) = make_uint4(v0[0], v0[1], v0[2], v0[3]);
    *(uint4*)(vT + (2 * kp + 1) * 72 + seg * 8) = make_uint4(v1[0], v1[1], v1[2], v1[3]);
    if (seg == 0) *(float2*)(p.decay + (size_t)item * 128 + 2 * kp) = make_float2(__expf(all0), __expf(all1));
  }
  __syncthreads();
  bf16x8 af[2];
#pragma unroll
  for (int ks = 0; ks < 2; ++ks) af[ks] = *(const bf16x8*)(kT + (16 * wid + fr) * 72 + 32 * ks + 8 * fq);
#pragma unroll
  for (int j = 0; j < 8; ++j) {
    f32x4 acc = (f32x4){0.f, 0.f, 0.f, 0.f};
#pragma unroll
    for (int ks = 0; ks < 2; ++ks) {
      bf16x8 bfr = *(const bf16x8*)(vT + (16 * j + fr) * 72 + 32 * ks + 8 * fq);
      acc = __builtin_amdgcn_mfma_f32_16x16x32_bf16(af[ks], bfr, acc, 0, 0, 0);
    }
    st_nt8(p.dstate + (size_t)item * 16384 + (16 * j + fr) * 128 + 16 * wid + 4 * fq, pack2(acc[0], acc[1]), pack2(acc[2], acc[3]));
  }
  __syncthreads();
}

__device__ void hg_c_item(const Params& p, int item, char* smem) {
  bf16_t* qd = (bf16_t*)smem;
  bf16_t* kd = qd + 64 * 136;
  bf16_t* vT = kd + 64 * 136;
  float* tot = (float*)(vT + 128 * 72);
  float* ssq = tot + 1024;
  _Float16* Lf = (_Float16*)(ssq + 128); bf16_t* Qr = (bf16_t*)(Lf + 8192); bf16_t* Kr = Qr + 8192; bf16_t* Vr = Kr + 8192;
  bf16_t* att = (bf16_t*)Lf;
  const int tid = otid(), lane = tid & 63, wid = tid >> 6, fr = lane & 15, fq = lane >> 4;
  const int b = item >> 8, h = (item >> 6) & 3, n = item & 63;
  const int t0 = b * 4096 + n * 64;
  const int kp = tid & 63, seg = tid >> 6;
  const int rt = wid & 3, hh = wid >> 2;
  const int token = t0 + 16 * rt + fr;
  uint2 gw[4]; float4 g4[4];
  {
    uint4 rw[8];
#pragma unroll
    for (int i = 0; i < 2; ++i) {
      const int c = tid + 512 * i, row = c >> 4, cc = c & 15;
      rw[i] = ld_nt16(p.logf + (size_t)(t0 + row) * 512 + h * 128 + cc * 8);
      rw[2 + i] = ld_nt16(p.proj + (size_t)(t0 + row) * 2048 + h * 128 + cc * 8);
      rw[4 + i] = ld_nt16(p.proj + (size_t)(t0 + row) * 2048 + 512 + h * 128 + cc * 8);
      rw[6 + i] = ld_nt16(p.proj + (size_t)(t0 + row) * 2048 + 1024 + h * 128 + cc * 8);
    }
#pragma unroll
    for (int j = 0; j < 4; ++j) {
      const int col = h * 128 + 16 * (4 * hh + j) + 4 * fq;
      gw[j] = ld_nt8(p.proj + (size_t)token * 2048 + 1536 + col);
      g4[j] = *(const float4*)(p.hg_norm_g + col);
    }
#pragma unroll
    for (int i = 0; i < 2; ++i) {
      const int c = tid + 512 * i, row = c >> 4, cc = c & 15;
      *(uint4*)(Lf + row * 128 + cc * 8) = rw[i]; *(uint4*)(Qr + row * 128 + cc * 8) = rw[2 + i]; *(uint4*)(Kr + row * 128 + cc * 8) = rw[4 + i]; *(uint4*)(Vr + row * 128 + cc * 8) = rw[6 + i];
    }
  }
  __syncthreads();
  float b0[8], b1[8];
  {
    float a0 = 0.f, a1 = 0.f;
#pragma unroll
    for (int i = 0; i < 8; ++i) {
      const f16x2_t l2 = *(const f16x2_t*)(Lf + (seg * 8 + i) * 128 + 2 * kp);
      a0 += (float)l2[0]; a1 += (float)l2[1]; b0[i] = a0; b1[i] = a1;
    }
    *(float2*)(tot + seg * 128 + 2 * kp) = make_float2(a0, a1);
  }
  __syncthreads();
  const bf16_t* sp = p.sstart + (size_t)item * 16384;
  bf16x8 sf[4][4];
#pragma unroll
  for (int ks = 0; ks < 4; ++ks)
#pragma unroll
    for (int j = 0; j < 4; ++j) sf[ks][j] = *(const bf16x8*)(sp + (16 * (4 * hh + j) + fr) * 128 + 32 * ks + 8 * fq);
  float pre0 = 0.f, pre1 = 0.f;
#pragma unroll
  for (int s8 = 0; s8 < 8; ++s8) { const float2 tv = *(const float2*)(tot + s8 * 128 + 2 * kp); if (s8 < seg) { pre0 += tv.x; pre1 += tv.y; } }
  {
    unsigned v0[4], v1[4];
#pragma unroll
    for (int i = 0; i < 8; ++i) {
      const int r = seg * 8 + i;
      const unsigned qw = *(const unsigned*)(Qr + r * 128 + 2 * kp), kw = *(const unsigned*)(Kr + r * 128 + 2 * kp), vw = *(const unsigned*)(Vr + r * 128 + 2 * kp);
      const float bb0 = b0[i] + pre0, bb1 = b1[i] + pre1;
      *(unsigned*)(qd + r * 136 + 2 * kp) = pack2(lo2f(qw) * __expf(bb0), hi2f(qw) * __expf(bb1));
      *(unsigned*)(kd + r * 136 + 2 * kp) = pack2(lo2f(kw) * __expf(-bb0), hi2f(kw) * __expf(-bb1));
      if (i & 1) { v0[i >> 1] |= vw << 16; v1[i >> 1] |= vw & 0xffff0000u; } else { v0[i >> 1] = vw & 0xffffu; v1[i >> 1] = vw >> 16; }
    }
    *(uint4*)(vT + (2 * kp) * 72 + seg * 8) = make_uint4(v0[0], v0[1], v0[2], v0[3]);
    *(uint4*)(vT + (2 * kp + 1) * 72 + seg * 8) = make_uint4(v1[0], v1[1], v1[2], v1[3]);
  }
  __syncthreads();
#pragma unroll
  for (int st2 = 0; st2 < 2; ++st2) {
    const int st = 2 * hh + st2;
    f32x4 acc = (f32x4){0.f, 0.f, 0.f, 0.f};
#pragma unroll
    for (int ks = 0; ks < 4; ++ks) {
      bf16x8 a = *(const bf16x8*)(kd + (16 * st + fr) * 136 + 32 * ks + 8 * fq);
      bf16x8 bq = *(const bf16x8*)(qd + (16 * rt + fr) * 136 + 32 * ks + 8 * fq);
      acc = __builtin_amdgcn_mfma_f32_16x16x32_bf16(a, bq, acc, 0, 0, 0);
    }
    const int c = 16 * rt + fr, s0 = 16 * st + 4 * fq;
    float v0 = (s0 + 0 <= c) ? acc[0] : 0.f, v1 = (s0 + 1 <= c) ? acc[1] : 0.f, v2 = (s0 + 2 <= c) ? acc[2] : 0.f, v3 = (s0 + 3 <= c) ? acc[3] : 0.f;
    uint2 o; o.x = pack2(v0, v1); o.y = pack2(v2, v3);
    *(uint2*)(att + c * 72 + s0) = o;
  }
  __syncthreads();
  f32x4 o[4];
#pragma unroll
  for (int j = 0; j < 4; ++j) o[j] = (f32x4){0.f, 0.f, 0.f, 0.f};
#pragma unroll
  for (int ks = 0; ks < 2; ++ks) {
    bf16x8 bq = *(const bf16x8*)(att + (16 * rt + fr) * 72 + 32 * ks + 8 * fq);
#pragma unroll
    for (int j = 0; j < 4; ++j) {
      bf16x8 a = *(const bf16x8*)(vT + (16 * (4 * hh + j) + fr) * 72 + 32 * ks + 8 * fq);
      o[j] = __builtin_amdgcn_mfma_f32_16x16x32_bf16(a, bq, o[j], 0, 0, 0);
    }
  }
#pragma unroll
  for (int ks = 0; ks < 4; ++ks) {
    bf16x8 bq = *(const bf16x8*)(qd + (16 * rt + fr) * 136 + 32 * ks + 8 * fq);
#pragma unroll
    for (int j = 0; j < 4; ++j) o[j] = __builtin_amdgcn_mfma_f32_16x16x32_bf16(sf[ks][j], bq, o[j], 0, 0, 0);
  }
  float ss = 0.f;
#pragma unroll
  for (int j = 0; j < 4; ++j) ss += o[j][0] * o[j][0] + o[j][1] * o[j][1] + o[j][2] * o[j][2] + o[j][3] * o[j][3];
  ss += __shfl_xor(ss, 16); ss += __shfl_xor(ss, 32);
  if (fq == 0) ssq[hh * 64 + 16 * rt + fr] = ss;
  __syncthreads();
  const float tss = ssq[16 * rt + fr] + ssq[64 + 16 * rt + fr];
  const float rstd = rsqrtf(tss * (1.f / 128.f) + 1e-6f);
#pragma unroll
  for (int j = 0; j < 4; ++j) {
    const int col = h * 128 + 16 * (4 * hh + j) + 4 * fq;
    float z0 = lo2f(gw[j].x), z1 = hi2f(gw[j].x), z2 = lo2f(gw[j].y), z3 = hi2f(gw[j].y);
    float r0 = o[j][0] * rstd * g4[j].x * z0 * sigm(z0), r1 = o[j][1] * rstd * g4[j].y * z1 * sigm(z1);
    float r2 = o[j][2] * rstd * g4[j].z * z2 * sigm(z2), r3 = o[j][3] * rstd * g4[j].w * z3 * sigm(z3);
    uint2 ow; ow.x = pack2(r0, r1); ow.y = pack2(r2, r3);
    st_nt8(p.mix + (size_t)token * 1024 + col, ow);
  }
  __syncthreads();
}

__device__ void s5_a_block(const Params& p, int g, int to, char* smem) {
  const int tid = otid(), lane = tid & 63, wid = tid >> 6, fr = lane & 15, fq = lane >> 4;
  const int tt = to * 8 + wid;
  bf16x8 U[8];
#pragma unroll
  for (int ks = 0; ks < 8; ++ks) {
    const int tok = tt * 256 + 16 * fr + 2 * ks + (fq >> 1);
    U[ks] = *(const bf16x8*)(p.ubuf + ((size_t)g * T + tok) * 16 + 8 * (fq & 1));
  }
  {
    const uint4* src = (const uint4*)(p.Ftab + (size_t)g * 128 * 256);
    uint4 v[8];
#pragma unroll
    for (int i = 0; i < 8; ++i) v[i] = src[tid + 512 * i];
#pragma unroll
    for (int i = 0; i < 8; ++i) { const int c = tid + 512 * i; *(uint4*)(smem + (c >> 5) * 528 + (c & 31) * 16) = v[i]; }
  }
  __syncthreads();
#pragma unroll
  for (int rt = 0; rt < 8; ++rt) {
    f32x4 acc = (f32x4){0.f, 0.f, 0.f, 0.f};
#pragma unroll
    for (int ks = 0; ks < 8; ++ks) {
      bf16x8 a = *(const bf16x8*)(smem + (16 * rt + fr) * 528 + 64 * ks + 16 * fq);
      acc = __builtin_amdgcn_mfma_f32_16x16x32_bf16(a, U[ks], acc, 0, 0, 0);
    }
    *(f32x4*)(p.Xend + ((size_t)(tt * 16 + fr) * 32 + g) * 128 + 16 * rt + 4 * fq) = acc;
  }
  __syncthreads();
}

__device__ void s5_c_block(const Params& p, int g, int to, char* smem) {
  const int tid = otid(), lane = tid & 63, wid = tid >> 6, fr = lane & 15, fq = lane >> 4;
  const int tt = to * 8 + wid;
  bf16x8 U[8], Kf[16], Xf[4];
#pragma unroll
  for (int ks = 0; ks < 8; ++ks) {
    const int tok = tt * 256 + 16 * fr + 2 * ks + (fq >> 1);
    U[ks] = *(const bf16x8*)(p.ubuf + ((size_t)g * T + tok) * 16 + 8 * (fq & 1));
  }
#pragma unroll
  for (int d = 0; d < 16; ++d) {
    const int tau = d - (fq >> 1);
    bf16x8 z = (bf16x8){0, 0, 0, 0, 0, 0, 0, 0};
    if (tau >= 0) z = *(const bf16x8*)(p.Ktab + (size_t)((g * 16 + tau) * 16 + fr) * 16 + 8 * (fq & 1));
    Kf[d] = z;
  }
#pragma unroll
  for (int ks = 0; ks < 4; ++ks) Xf[ks] = *(const bf16x8*)(p.Xs + ((size_t)(tt * 16 + fr) * 32 + g) * 128 + 32 * ks + 8 * fq);
  const int c0 = g * 16 + 4 * fq;
  const float4 dsk = *(const float4*)(p.s5_d + c0);
  uint2 uw[16];
#pragma unroll
  for (int t = 0; t < 16; ++t) uw[t] = *(const uint2*)(p.ubuf + ((size_t)g * T + tt * 256 + 16 * fr + t) * 16 + 4 * fq);
  {
    const uint4* src = (const uint4*)(p.Etab + (size_t)g * 256 * 128);
    uint4 v[8];
#pragma unroll
    for (int i = 0; i < 8; ++i) v[i] = src[tid + 512 * i];
#pragma unroll
    for (int i = 0; i < 8; ++i) { const int c = tid + 512 * i; *(uint4*)(smem + (c >> 4) * 272 + (c & 15) * 16) = v[i]; }
  }
  __syncthreads();
#pragma unroll
  for (int t = 0; t < 16; ++t) {
    f32x4 acc = (f32x4){0.f, 0.f, 0.f, 0.f};
#pragma unroll
    for (int ks = 0; ks <= t / 2; ++ks) acc = __builtin_amdgcn_mfma_f32_16x16x32_bf16(Kf[t - 2 * ks], U[ks], acc, 0, 0, 0);
#pragma unroll
    for (int ks = 0; ks < 4; ++ks) {
      bf16x8 a = *(const bf16x8*)(smem + (t * 16 + fr) * 272 + 64 * ks + 16 * fq);
      acc = __builtin_amdgcn_mfma_f32_16x16x32_bf16(a, Xf[ks], acc, 0, 0, 0);
    }
    const int token = tt * 256 + 16 * fr + t;
    float y0 = acc[0] + dsk.x * lo2f(uw[t].x), y1 = acc[1] + dsk.y * hi2f(uw[t].x), y2 = acc[2] + dsk.z * lo2f(uw[t].y), y3 = acc[3] + dsk.w * hi2f(uw[t].y);
    uint2 ow; ow.x = pack2(gelu_tanh(y0), gelu_tanh(y1)); ow.y = pack2(gelu_tanh(y2), gelu_tanh(y3));
    st_nt8(p.ybuf + ((size_t)g * T + token) * 16 + 4 * fq, ow);
  }
  __syncthreads();
}

#define XB_TMO      128
#define XB_XCNT(j)  (256  + 64 * (j))
#define XB_XSUB(j)  (1280 + 64 * (j))
#define XB_XGEN(j)  (2304 + 64 * (j))
#define XB_TOP      3328
#define XB_TOPGEN   3392
#define XCD_BAR_WORDS 3456
#define XB_SPIN_CAP (1u << 20)
__device__ __forceinline__ unsigned xb_ld(unsigned* p) { return __hip_atomic_load(p, __ATOMIC_RELAXED, __HIP_MEMORY_SCOPE_AGENT); }
__device__ __forceinline__ unsigned xb_add(unsigned* p, unsigned v) { return __hip_atomic_fetch_add(p, v, __ATOMIC_RELAXED, __HIP_MEMORY_SCOPE_AGENT); }
__device__ __forceinline__ unsigned xb_xcc_id() { return (unsigned)__builtin_amdgcn_s_getreg((3 << 11) | 20) & 0xFu; }
#define XB_SPIN(cond, bar) do { unsigned _sp = 0; while (cond) { __builtin_amdgcn_s_sleep(1); \
    if ((++_sp & 255u) == 0u) { if (xb_ld(&(bar)[XB_TMO])) break; if (_sp > XB_SPIN_CAP) { atomicAdd(&(bar)[XB_TMO], 1u); break; } } } } while (0)
struct XcdBarrier { unsigned* bar; unsigned x; volatile LAS unsigned* st; };
__device__ __forceinline__ XcdBarrier xcd_barrier_post(unsigned* bar, volatile LAS unsigned* st) {
  XcdBarrier b; b.bar = bar; b.x = xb_xcc_id(); b.st = st;
  if (threadIdx.x == 0) (void)xb_add(&bar[XB_XCNT(b.x)], 1u);
  return b;
}
__device__ __forceinline__ void xcd_barrier_complete(unsigned* bar, unsigned x, unsigned& nloc, unsigned& nx) {
  const unsigned G = gridDim.x * gridDim.y * gridDim.z;
  unsigned sum, cnt, mine, sp = 0u;
  for (;;) {
    sum = 0u; cnt = 0u; mine = 0u;
#pragma unroll
    for (unsigned j = 0; j < 16; ++j) { const unsigned c = xb_ld(&bar[XB_XCNT(j)]); sum += c; cnt += (c > 0u) ? 1u : 0u; mine = (j == x) ? c : mine; }
    if (sum == G) break;
    __builtin_amdgcn_s_sleep(1);
    if ((++sp & 255u) == 0u) { if (xb_ld(&bar[XB_TMO])) break; if (sp > XB_SPIN_CAP) { atomicAdd(&bar[XB_TMO], 1u); break; } }
  }
  nloc = mine > 0u ? mine : 1u; nx = cnt > 0u ? cnt : 1u;
}
__device__ __forceinline__ void xcd_barrier(const XcdBarrier& b) {
  asm volatile("s_waitcnt vmcnt(0)" ::: "memory");
  __syncthreads();
  if (threadIdx.x == 0) {
    unsigned* bar = b.bar;
    __builtin_amdgcn_s_waitcnt(0);
    unsigned nloc = b.st[0], nx = b.st[1];
    if (nloc == 0u) { xcd_barrier_complete(bar, b.x, nloc, nx); b.st[0] = nloc; b.st[1] = nx; }
    const unsigned old = xb_add(&bar[XB_XSUB(b.x)], 1u);
    const unsigned gen = old / nloc;
    if (old + 1u == (gen + 1u) * nloc) {
      __builtin_amdgcn_fence(__ATOMIC_RELEASE, "agent");
      asm volatile("s_waitcnt vmcnt(0)" ::: "memory");
      const unsigned og = xb_add(&bar[XB_TOP], 1u);
      const unsigned tg = og / nx;
      if (og + 1u == (tg + 1u) * nx) xb_add(&bar[XB_TOPGEN], 1u);
      else XB_SPIN(xb_ld(&bar[XB_TOPGEN]) == tg, bar);
      __builtin_amdgcn_fence(__ATOMIC_ACQUIRE, "agent");
      xb_add(&bar[XB_XGEN(b.x)], 1u);
      asm volatile("s_waitcnt vmcnt(0)" ::: "memory");
    } else {
      XB_SPIN(xb_ld(&bar[XB_XGEN(b.x)]) == gen, bar);
      __builtin_amdgcn_fence(__ATOMIC_ACQUIRE, "agent");
      asm volatile("s_waitcnt vmcnt(0)" ::: "memory");
    }
  }
  __syncthreads();
}

__device__ void phase_mix_a(const Params& p, char* smem, int part) {
  if (part == 0) { for (int it = blockIdx.x; it < 1024; it += gridDim.x) hg_a_item(p, it, smem); }
  else { for (int u = blockIdx.x; u < 256; u += gridDim.x) s5_a_block(p, u & 31, u >> 5, smem); }
}

__device__ void phase_scan(const Params& p) {
  int tid = otid();
  if (tid < 128) {
    for (int it = blockIdx.x * 128 + tid; it < 32768; it += gridDim.x * 128) {
      const int seg = it & 3, ch = it >> 2;
      const int bt = ch >> 11, g = (ch >> 6) & 31, n = ch & 63;
      const float2 a = p.Pw[g * 64 + n];
      const size_t base = ((size_t)(bt * 256 + seg * 64) * 32 + g) * 128 + n;
      const float* __restrict__ xe = p.Xend + base;
      bf16_t* __restrict__ xs = p.Xs + base;
      float xr = 0.f, xi = 0.f;
#pragma unroll 1
      for (int h = 0; h < 2; ++h) {
        float er[32], ei[32];
#pragma unroll
        for (int j = 0; j < 32; ++j) { er[j] = xe[(size_t)(h * 32 + j) * 4096]; ei[j] = xe[(size_t)(h * 32 + j) * 4096 + 64]; }
#pragma unroll
        for (int j = 0; j < 32; ++j) { const float nr = a.x * xr - a.y * xi + er[j], ni = a.x * xi + a.y * xr + ei[j]; xr = nr; xi = ni; }
      }
      float Ar = a.x, Ai = a.y;
#pragma unroll
      for (int q = 0; q < 6; ++q) { const float t = Ar * Ar - Ai * Ai; Ai = 2.f * Ar * Ai; Ar = t; }
      const int lb = (tid & 63) & ~3;
      const float e0r = __shfl(xr, lb), e0i = __shfl(xi, lb), e1r = __shfl(xr, lb + 1), e1i = __shfl(xi, lb + 1), e2r = __shfl(xr, lb + 2), e2i = __shfl(xi, lb + 2);
      const float s2r = Ar * e0r - Ai * e0i + e1r, s2i = Ar * e0i + Ai * e0r + e1i;
      const float s3r = Ar * s2r - Ai * s2i + e2r, s3i = Ar * s2i + Ai * s2r + e2i;
      xr = seg == 0 ? 0.f : (seg == 1 ? e0r : (seg == 2 ? s2r : s3r));
      xi = seg == 0 ? 0.f : (seg == 1 ? e0i : (seg == 2 ? s2i : s3i));
#pragma unroll 1
      for (int h = 0; h < 2; ++h) {
        float er[32], ei[32];
#pragma unroll
        for (int j = 0; j < 32; ++j) { er[j] = xe[(size_t)(h * 32 + j) * 4096]; ei[j] = xe[(size_t)(h * 32 + j) * 4096 + 64]; }
#pragma unroll
        for (int j = 0; j < 32; ++j) {
          xs[(size_t)(h * 32 + j) * 4096] = f2bf(xr); xs[(size_t)(h * 32 + j) * 4096 + 64] = f2bf(xi);
          const float nr = a.x * xr - a.y * xi + er[j], ni = a.x * xi + a.y * xr + ei[j]; xr = nr; xi = ni;
        }
      }
    }
  }
  const int gtid = blockIdx.x * NTHR + tid, gthr = gridDim.x * NTHR;
  for (int e2 = gtid; e2 < 16 * 8192; e2 += gthr) {
    const int bh = e2 >> 13, e = (e2 & 8191) * 2, k = e & 127;
    const bf16_t* __restrict__ dsp = p.dstate + (size_t)bh * 64 * 16384 + e;
    const float* __restrict__ dcp = p.decay + (size_t)bh * 64 * 128 + k;
    bf16_t* __restrict__ sp = p.sstart + (size_t)bh * 64 * 16384 + e;
    float sx = 0.f, sy = 0.f;
#pragma unroll 1
    for (int n0 = 0; n0 < 64; n0 += 32) {
      unsigned ds[32]; float2 dc[32];
#pragma unroll
      for (int j = 0; j < 32; ++j) { ds[j] = ld_nt4(dsp + (size_t)(n0 + j) * 16384); dc[j] = *(const float2*)(dcp + (n0 + j) * 128); }
#pragma unroll
      for (int j = 0; j < 32; ++j) {
        *(unsigned*)(sp + (size_t)(n0 + j) * 16384) = pack2(sx, sy);
        sx = dc[j].x * sx + lo2f(ds[j]); sy = dc[j].y * sy + hi2f(ds[j]);
      }
    }
  }
}

__device__ void phase_mix_c(const Params& p, char* smem, int part) {
  if (part == 0) {
    if (gridDim.x == 256) {
      const int b = blockIdx.x, first = b < 128 ? b * 3 : 384 + (b - 128) * 5, cnt = b < 128 ? 3 : 5;
      for (int j = 0; j < cnt; ++j) hg_c_item(p, first + j, smem);
    } else { for (int it = blockIdx.x; it < 1024; it += gridDim.x) hg_c_item(p, it, smem); }
  }
  else { for (int u = blockIdx.x; u < 256; u += gridDim.x) s5_c_block(p, u & 31, u >> 5, smem); }
}

__device__ void phase_final(const Params& p) {
  int tid_ = otid();
  const int lane = tid_ & 63, wid = tid_ >> 6;
  for (int row0 = (blockIdx.x * 8 + wid) * 4; row0 < T; row0 += gridDim.x * 32) {
    float4 v[4][4]; float rs[4];
#pragma unroll
    for (int r = 0; r < 4; ++r) {
      const float4* op = (const float4*)(p.out + (size_t)(row0 + r) * 1024);
#pragma unroll
      for (int i = 0; i < 4; ++i) v[r][i] = op[lane + 64 * i];
      rs[r] = rsqrtf(p.rsq2[row0 + r] * (1.f / 1024.f) + 1e-6f);
    }
#pragma unroll
    for (int i = 0; i < 4; ++i) {
      const float4 g = ((const float4*)p.final_g)[lane + 64 * i];
#pragma unroll
      for (int r = 0; r < 4; ++r) {
        float4 w = v[r][i];
        w.x *= rs[r] * g.x; w.y *= rs[r] * g.y; w.z *= rs[r] * g.z; w.w *= rs[r] * g.w;
        ((float4*)(p.out + (size_t)(row0 + r) * 1024))[lane + 64 * i] = w;
      }
    }
  }
}

template <int PH>
__device__ __forceinline__ void run_phase(const Params& p, char* smem) {
  if (PH == 0) phase_prep(p, smem);
  if (PH == 100) phase_prep_xn(p);
  if (PH == 1) {
    EpiProj e{p.proj, p.ubuf, p.logf, p.hg_lb}; gemm_phase(p.xn, p.Wt_in, T, 2560, 1024, e, smem);
    if (gridDim.x == 256 && blockIdx.x >= 128)
      for (int t = 160 + ((int)blockIdx.x - 128); t < 768; t += 128) transpose_any(p, t, (float*)smem);
  }
  if (PH == 2) phase_mix_a(p, smem, 0);
  if (PH == 102) phase_mix_a(p, smem, 1);
  if (PH == 3) phase_scan(p);
  if (PH == 4) phase_mix_c(p, smem, 1);
  if (PH == 104) { }
  if (PH == 5) { EpiGlu e{p.ybuf, p.b_glu, p.mix}; gemm_phase(p.ybuf, p.Wt_glu, T, 512, 512, e, smem, RowMapGroupMajor()); phase_mix_c(p, smem, 0); }
  if (PH == 6) { EpiOut e{p.x, p.hb, p.rsq1}; gemm_phase(p.mix, p.Wt_out, T, 1024, 1024, e, smem); }
  if (PH == 7) { EpiUpConv e{p.act, p.rsq1, p.conv_w, p.conv_b, (LAS float*)((LAS unsigned char*)smem + 131088)}; gemm_phase(p.hb, p.Wt_up, 68 * 256, 5632, 1024, e, smem, RowMapConv()); }
  if (PH == 8) { EpiDown e{p.out, p.hb, p.rsq2, p.bar + XCD_BAR_WORDS, p.final_g, (LAS float*)((LAS unsigned char*)smem + 131088), gridDim.x >= 256}; gemm_phase(p.act, p.Wt_down, T, 1024, 2816, e, smem); }
  if (PH == 9) { if (gridDim.x < 256) phase_final(p); }
}

#if MK_FUSED
#define PROBE_MARK(k) do { if (PROBE_K == (k)) t_mark = __builtin_amdgcn_s_memrealtime(); } while (0)
__global__ void __launch_bounds__(NTHR) fwd_megakernel(Params p) {
  extern __shared__ __attribute__((aligned(16))) char smem[];
  volatile LAS unsigned* st = (volatile LAS unsigned*)((LAS unsigned char*)smem + 131072);
  if (threadIdx.x == 0) { st[0] = 0u; st[1] = 0u; st[2] = 0u; st[3] = 0u; }
  __syncthreads();
  unsigned long long t_start = 0, t_mark = 0;
  if (PROBE_K >= 0) { t_start = __builtin_amdgcn_s_memrealtime(); t_mark = t_start; }
  if (blockIdx.x == 0) for (int i = threadIdx.x; i < XCD_BAR_WORDS + 64 * 64; i += NTHR) p.bar[i] = 0u;
  run_phase<0>(p, smem); PROBE_MARK(21); run_phase<100>(p, smem); PROBE_MARK(20);
  cg::this_grid().sync(); PROBE_MARK(0);
  const XcdBarrier xb = xcd_barrier_post(p.bar, st);
  run_phase<1>(p, smem); xcd_barrier(xb); PROBE_MARK(1);
  run_phase<2>(p, smem); PROBE_MARK(23); run_phase<102>(p, smem); xcd_barrier(xb); PROBE_MARK(2);
  run_phase<3>(p, smem); PROBE_MARK(40); xcd_barrier(xb); PROBE_MARK(3);
  run_phase<4>(p, smem); PROBE_MARK(22); run_phase<104>(p, smem); xcd_barrier(xb); PROBE_MARK(4);
  run_phase<5>(p, smem); xcd_barrier(xb); PROBE_MARK(5);
  run_phase<6>(p, smem); xcd_barrier(xb); PROBE_MARK(6);
  run_phase<7>(p, smem); PROBE_MARK(41); xcd_barrier(xb); PROBE_MARK(7);
  run_phase<8>(p, smem);
  if (gridDim.x < 256) { xcd_barrier(xb); run_phase<9>(p, smem); }
  if (PROBE_K >= 30 && PROBE_K < 40) t_mark = *(volatile LAS unsigned long long*)((LAS unsigned char*)smem + 131080);
  if (PROBE_K >= 0) {
    const unsigned long long t_end = __builtin_amdgcn_s_memrealtime();
    const unsigned long long until = t_end + 4ull * (t_mark - t_start);
    while (__builtin_amdgcn_s_memrealtime() < until) __builtin_amdgcn_s_sleep(8);
  }
}
#else
template <int PH>
__global__ void __launch_bounds__(NTHR) phase_kernel(Params p) {
  extern __shared__ __attribute__((aligned(16))) char smem[];
  run_phase<PH>(p, smem);
}
template <int PH>
static void launch_phase(const Params& p, int grid, hipStream_t stream) {
  (void)hipFuncSetAttribute((const void*)phase_kernel<PH>, hipFuncAttributeMaxDynamicSharedMemorySize, LDS_BYTES);
  hipLaunchKernelGGL(phase_kernel<PH>, dim3(grid), dim3(NTHR), LDS_BYTES, stream, p);
}
#endif

extern "C" void kernel_launch(void* const* d_in, const int* in_sizes, int n_in, void* d_out, int out_size, void* d_ws,
                              size_t ws_size, hipStream_t stream) {
  Params p{};
  p.x = (const float*)d_in[0]; p.in_norm_g = (const float*)d_in[1]; p.w_in = (const float*)d_in[2]; p.hg_lb = (const float*)d_in[3];
  p.hg_norm_g = (const float*)d_in[4]; p.a_re = (const float*)d_in[5]; p.a_im = (const float*)d_in[6]; p.log_dt = (const float*)d_in[7];
  p.b_re = (const float*)d_in[8]; p.b_im = (const float*)d_in[9]; p.c_re = (const float*)d_in[10]; p.c_im = (const float*)d_in[11];
  p.s5_d = (const float*)d_in[12]; p.w_glu = (const float*)d_in[13]; p.b_glu = (const float*)d_in[14]; p.w_out = (const float*)d_in[15];
  p.ffn_norm_g = (const float*)d_in[16]; p.w_up = (const float*)d_in[17]; p.conv_w = (const float*)d_in[18]; p.conv_b = (const float*)d_in[19];
  p.w_down = (const float*)d_in[20]; p.final_g = (const float*)d_in[21];
  p.out = (float*)d_out;
  char* ws = (char*)d_ws;
  size_t off = 0;
  auto take = [&](size_t bytes) { char* r = ws + off; off += (bytes + 255) & ~(size_t)255; return r; };
  p.Wt_in = (bf16_t*)take((size_t)2560 * 1024 * 2);
  p.Wt_glu = (bf16_t*)take((size_t)512 * 512 * 2);
  p.Wt_out = (bf16_t*)take((size_t)1024 * 1024 * 2);
  p.Wt_up = (bf16_t*)take((size_t)5632 * 1024 * 2);
  p.Wt_down = (bf16_t*)take((size_t)1024 * 2816 * 2);
  p.Ktab = (bf16_t*)take((size_t)32 * 16 * 256 * 2);
  p.Etab = (bf16_t*)take((size_t)32 * 256 * 128 * 2);
  p.Ftab = (bf16_t*)take((size_t)32 * 128 * 256 * 2);
  p.Pw = (float2*)take((size_t)32 * 17 * 64 * 8);
  p.Bbar = (float2*)take((size_t)32 * 64 * 16 * 8);
  p.rsq1 = (float*)take((size_t)T * 16 * 4);
  p.rsq2 = (float*)take((size_t)T * 16 * 4);
  p.decay = (float*)take((size_t)1024 * 128 * 4);
  p.bar = (unsigned*)take((size_t)(XCD_BAR_WORDS + 64 * 64) * 4);
  const size_t dyn0 = off;
  p.xn = (bf16_t*)take((size_t)T * 1024 * 2);
  p.sstart = p.xn; p.hb = p.xn;
  const size_t r2 = off;
  p.proj = (bf16_t*)take((size_t)T * 2048 * 2);
  p.ubuf = (bf16_t*)take((size_t)T * 512 * 2);
  p.logf = (_Float16*)take((size_t)T * 512 * 4);
  p.mix = (bf16_t*)take((size_t)T * 1024 * 2);
  p.ybuf = (bf16_t*)take((size_t)T * 512 * 2);
  p.Xend = (float*)take((size_t)1024 * 32 * 128 * 4);
  p.Xs = (bf16_t*)take((size_t)1024 * 32 * 128 * 2);
  const size_t endA = off;
  p.dstate = (bf16_t*)d_out;
  off = r2;
  p.act = (bf16_t*)take((size_t)T * 2816 * 2);
  const size_t endB = off;
  (void)dyn0;
  if (endA > ws_size || endB > ws_size) fprintf(stderr, "workspace too small: need %zu / %zu have %zu\n", endA, endB, ws_size);

  static int grid_blocks = 0;
#if MK_FUSED
  if (!grid_blocks) {
    int dev = 0, cus = 0, per_cu = 0;
    (void)hipGetDevice(&dev);
    (void)hipDeviceGetAttribute(&cus, hipDeviceAttributeMultiprocessorCount, dev);
    (void)hipFuncSetAttribute((const void*)fwd_megakernel, hipFuncAttributeMaxDynamicSharedMemorySize, LDS_BYTES);
    (void)hipOccupancyMaxActiveBlocksPerMultiprocessor(&per_cu, fwd_megakernel, NTHR, LDS_BYTES);
    if (per_cu > 1) per_cu = 1;
    grid_blocks = cus * per_cu;
  }
  void* args[] = {&p};
  hipError_t e = hipLaunchCooperativeKernel((void*)fwd_megakernel, dim3(grid_blocks), dim3(NTHR), args, LDS_BYTES, stream);
  if (e != hipSuccess) fprintf(stderr, "cooperative launch failed: %s (grid %d)\n", hipGetErrorString(e), grid_blocks);
#else
  if (!grid_blocks) {
    int dev = 0, cus = 0;
    (void)hipGetDevice(&dev);
    (void)hipDeviceGetAttribute(&cus, hipDeviceAttributeMultiprocessorCount, dev);
    grid_blocks = cus;
  }
  launch_phase<0>(p, grid_blocks, stream);
  launch_phase<100>(p, grid_blocks, stream);
  launch_phase<1>(p, grid_blocks, stream);
  launch_phase<2>(p, grid_blocks, stream);
  launch_phase<102>(p, grid_blocks, stream);
  launch_phase<3>(p, grid_blocks, stream);
  launch_phase<4>(p, grid_blocks, stream);
  launch_phase<104>(p, grid_blocks, stream);
  launch_phase<5>(p, grid_blocks, stream);
  launch_phase<6>(p, grid_blocks, stream);
  launch_phase<7>(p, grid_blocks, stream);
  launch_phase<8>(p, grid_blocks, stream);
  launch_phase<9>(p, grid_blocks, stream);
#endif
}
```

```cpp
#include <hip/hip_runtime.h>
#include <hip/hip_cooperative_groups.h>
#include <stdint.h>
#include <cstdio>
namespace cg = cooperative_groups;

#ifndef PROBE_K
#define PROBE_K -1
#endif
#ifndef MK_FUSED
#define MK_FUSED 1
#endif

typedef unsigned short bf16_t;
typedef short bf16x8 __attribute__((ext_vector_type(8)));
typedef float f32x4 __attribute__((ext_vector_type(4)));

constexpr int T = 16384;
constexpr int NTHR = 512;
constexpr int LDS_BYTES = 128 * 1024 + 16 + 6144;

struct Params {
  const float *x, *in_norm_g, *w_in, *hg_lb, *hg_norm_g, *a_re, *a_im, *log_dt, *b_re, *b_im, *c_re, *c_im, *s5_d,
      *w_glu, *b_glu, *w_out, *ffn_norm_g, *w_up, *conv_w, *conv_b, *w_down, *final_g;
  float* out;
  bf16_t *Wt_in, *Wt_glu, *Wt_out, *Wt_up, *Wt_down, *xn, *proj, *sstart, *Xs, *mix, *ybuf, *ubuf, *hb, *hid, *act, *Ktab, *Etab, *Ftab;
  _Float16* logf; bf16_t* dstate;
  float *decay, *Xend, *rsq1, *rsq2;
  float2 *Pw, *Bbar;
  unsigned* bar;
};

__device__ __forceinline__ int otid() { int t = threadIdx.x; asm volatile("" : "+v"(t)); return t; }
typedef float f32x2_t __attribute__((ext_vector_type(2)));
typedef __bf16 bf16x2_t __attribute__((ext_vector_type(2)));
__device__ __forceinline__ unsigned pack2(float a, float b) { f32x2_t v = {a, b}; bf16x2_t h = __builtin_convertvector(v, bf16x2_t); return __builtin_bit_cast(unsigned, h); }
__device__ __forceinline__ bf16_t f2bf(float f) { return (bf16_t)(pack2(f, f) & 0xffffu); }
__device__ __forceinline__ float bf2f(bf16_t h) { return __uint_as_float(((unsigned)h) << 16); }
__device__ __forceinline__ float lo2f(unsigned w) { return __uint_as_float(w << 16); }
__device__ __forceinline__ float hi2f(unsigned w) { return __uint_as_float(w & 0xffff0000u); }
__device__ __forceinline__ float sigm(float x) { return __builtin_amdgcn_rcpf(1.f + __expf(-x)); }
__device__ __forceinline__ float gelu_tanh(float y) {
  float u = 0.7978845608028654f * (y + 0.044715f * y * y * y);
  return y * sigm(2.f * u);
}

typedef unsigned u32x2 __attribute__((ext_vector_type(2)));
typedef unsigned u32x4_t __attribute__((ext_vector_type(4)));
__device__ __forceinline__ void st_nt8(void* p, unsigned a, unsigned b) { u32x2 v; v.x = a; v.y = b; *(u32x2*)p = v; }
__device__ __forceinline__ void st_nt8(void* p, uint2 w) { st_nt8(p, w.x, w.y); }
__device__ __forceinline__ void st_nt16(void* p, f32x4 v) { __builtin_nontemporal_store(v, (f32x4*)p); }
__device__ __forceinline__ void st_nt16(void* p, uint4 w) { *(uint4*)p = w; }
__device__ __forceinline__ float4 ld_nt16f(const void* p) { const f32x4 t = __builtin_nontemporal_load((const f32x4*)p); return make_float4(t[0], t[1], t[2], t[3]); }
__device__ __forceinline__ uint4 ld_nt16(const void* p) { const u32x4_t t = __builtin_nontemporal_load((const u32x4_t*)p); return make_uint4(t.x, t.y, t.z, t.w); }
__device__ __forceinline__ uint2 ld_nt8(const void* p) { const u32x2 t = __builtin_nontemporal_load((const u32x2*)p); return make_uint2(t.x, t.y); }
__device__ __forceinline__ unsigned ld_nt4(const void* p) { return __builtin_nontemporal_load((const unsigned*)p); }

__device__ double exp_d(double x) {
  double k = rint(x * 1.4426950408889634);
  double r = fma(-k, 0.6931471805599453, x);
  r = fma(-k, 2.3190468138462996e-17, r);
  double p = 1.0;
#pragma unroll
  for (int i = 16; i >= 1; --i) p = fma(r * p, 1.0 / (double)i, 1.0);
  return ldexp(p, (int)k);
}
__device__ void sincos_d(double x, double& s, double& c) {
  double q = rint(x * 0.6366197723675814);
  double r = fma(-q, 1.5707963267948966, x);
  r = fma(-q, 6.123233995736766e-17, r);
  int iq = ((int)q) & 3;
  double r2 = r * r;
  double sp = 1.0, cp = 1.0;
#pragma unroll
  for (int i = 9; i >= 1; --i) sp = fma(-r2 * sp, 1.0 / (double)((2 * i) * (2 * i + 1)), 1.0);
  sp *= r;
#pragma unroll
  for (int i = 10; i >= 1; --i) cp = fma(-r2 * cp, 1.0 / (double)((2 * i - 1) * (2 * i)), 1.0);
  if (iq == 0) { s = sp; c = cp; }
  else if (iq == 1) { s = cp; c = -sp; }
  else if (iq == 2) { s = -sp; c = -cp; }
  else { s = -cp; c = sp; }
}

__device__ __forceinline__ int perm32_row(int n) { const int j = n & 31; return (n & ~31) + 16 * ((j >> 2) & 1) + 4 * (j >> 3) + (j & 3); }
__device__ __forceinline__ int up_dst_row(int n) { const int isv = n >= 2816, nn = isv ? n - 2816 : n; return ((nn >> 7) << 8) + isv * 128 + (nn & 127); }

__device__ void transpose_big(const float* __restrict__ src, bf16_t* __restrict__ dst, int K, int N, int tk, int tn,
                              const float* __restrict__ rowscale, bool perm, float* tile, bool permB = false) {
  const int tid = otid();
  const int k0 = tk * 64, n0 = tn * 256;
  float4 v[8];
#pragma unroll
  for (int i = 0; i < 8; ++i) { const int r = (tid >> 6) + 8 * i, c4 = (tid & 63) * 4; v[i] = ld_nt16f(src + (size_t)(k0 + r) * N + n0 + c4); }
#pragma unroll
  for (int i = 0; i < 8; ++i) {
    const int r = (tid >> 6) + 8 * i, c4 = (tid & 63) * 4;
    const float sc = rowscale ? rowscale[k0 + r] : 1.f;
    tile[r * 257 + c4 + 0] = v[i].x * sc; tile[r * 257 + c4 + 1] = v[i].y * sc; tile[r * 257 + c4 + 2] = v[i].z * sc; tile[r * 257 + c4 + 3] = v[i].w * sc;
  }
  __syncthreads();
  const int n = tid >> 1, kh = (tid & 1) * 32;
  int drow = perm ? up_dst_row(n0 + n) : (n0 + n);
  if (permB) drow = perm32_row(drow);
#pragma unroll
  for (int q = 0; q < 4; ++q) {
    uint4 o;
    o.x = pack2(tile[(kh + 8 * q + 0) * 257 + n], tile[(kh + 8 * q + 1) * 257 + n]);
    o.y = pack2(tile[(kh + 8 * q + 2) * 257 + n], tile[(kh + 8 * q + 3) * 257 + n]);
    o.z = pack2(tile[(kh + 8 * q + 4) * 257 + n], tile[(kh + 8 * q + 5) * 257 + n]);
    o.w = pack2(tile[(kh + 8 * q + 6) * 257 + n], tile[(kh + 8 * q + 7) * 257 + n]);
    *(uint4*)(dst + (size_t)drow * K + k0 + kh + 8 * q) = o;
  }
  __syncthreads();
}

__device__ void transpose_any(const Params& p, int t, float* tile) {
  if (t < 160) transpose_big(p.w_in, p.Wt_in, 1024, 2560, t / 10, t % 10, nullptr, false, tile, true);
  else if (t < 176) { int u = t - 160; transpose_big(p.w_glu, p.Wt_glu, 512, 512, u / 2, u % 2, nullptr, false, tile, true); }
  else if (t < 240) { int u = t - 176; transpose_big(p.w_out, p.Wt_out, 1024, 1024, u / 4, u % 4, nullptr, false, tile, true); }
  else if (t < 592) { int u = t - 240; transpose_big(p.w_up, p.Wt_up, 1024, 5632, u / 22, u % 22, p.ffn_norm_g, true, tile); }
  else { int u = t - 592; transpose_big(p.w_down, p.Wt_down, 2816, 1024, u / 4, u % 4, nullptr, false, tile); }
}

__device__ void s5_tables_block(const Params& p, int bi, char* smem) {
  float* Cr = (float*)smem; float* Ci = Cr + 1024; float* Br = Ci + 1024; float* Bi = Br + 1024;
  float2* Pj = (float2*)(Bi + 1024);
  float2* PZ = Pj + 64;
  const int tid = otid();
  const int g = bi & 31, jb = bi >> 5;
  for (int i = tid; i < 1024; i += NTHR) { Cr[i] = p.c_re[g * 1024 + i]; Ci[i] = p.c_im[g * 1024 + i]; Br[i] = p.b_re[g * 1024 + i]; Bi[i] = p.b_im[g * 1024 + i]; }
  for (int jj = 0; jj < 3; ++jj) {
    const int j = jb + 8 * jj;
    if (j > 16) break;
    __syncthreads();
    if (tid < 64) {
      const int n = tid;
      const double dt = exp_d((double)p.log_dt[g]);
      const double ar = (double)p.a_re[g * 64 + n], ai = (double)p.a_im[g * 64 + n];
      double sj, cj, s1, c1;
      const double mj = exp_d((double)j * dt * ar); sincos_d((double)j * dt * ai, sj, cj);
      const double m1 = exp_d(dt * ar); sincos_d(dt * ai, s1, c1);
      const double pr = mj * cj, pi = mj * sj;
      const double nr = m1 * c1 - 1.0, ni = m1 * s1, den = ar * ar + ai * ai;
      const double zr = (nr * ar + ni * ai) / den, zi = (ni * ar - nr * ai) / den;
      Pj[n] = make_float2((float)pr, (float)pi);
      PZ[n] = make_float2((float)(pr * zr - pi * zi), (float)(pr * zi + pi * zr));
      if (j == 16) p.Pw[g * 64 + n] = make_float2((float)pr, (float)pi);
    }
    __syncthreads();
    if (j >= 1) {
      const int t = j - 1;
#pragma unroll
      for (int i = 0; i < 4; ++i) {
        const int idx = tid + 512 * i, pp = idx >> 7, np = idx & 127, n = np & 63, part = np >> 6;
        const float2 pw = Pj[n];
        const float cr = Cr[pp * 64 + n], ci = Ci[pp * 64 + n];
        const float v = part ? -(cr * pw.y + ci * pw.x) : (cr * pw.x - ci * pw.y);
        p.Etab[(size_t)(g * 256 + t * 16 + pp) * 128 + np] = f2bf(v);
      }
    }
    if (j <= 15) {
      const int sidx = 15 - j;
#pragma unroll
      for (int i = 0; i < 4; ++i) {
        const int idx = tid + 512 * i, np = idx >> 4, pq = idx & 15, n = np & 63, part = np >> 6;
        const float2 m = PZ[n];
        const float br = Br[n * 16 + pq], bi2 = Bi[n * 16 + pq];
        const float v = part ? (m.x * bi2 + m.y * br) : (m.x * br - m.y * bi2);
        p.Ftab[(size_t)(g * 128 + np) * 256 + sidx * 16 + pq] = f2bf(v);
      }
      if (tid < 256) {
        const int pp = tid >> 4, pq = tid & 15;
        float acc = 0.f;
#pragma unroll 8
        for (int n = 0; n < 64; ++n) {
          const float2 m = PZ[n];
          const float br = Br[n * 16 + pq], bi2 = Bi[n * 16 + pq];
          const float cr = Cr[pp * 64 + n], ci = Ci[pp * 64 + n];
          const float mr = m.x * br - m.y * bi2, mi = m.x * bi2 + m.y * br;
          acc += cr * mr - ci * mi;
        }
        p.Ktab[(size_t)((g * 16 + j) * 16 + pp) * 16 + pq] = f2bf(acc);
      }
    }
  }
  __syncthreads();
}

__device__ void phase_prep(const Params& p, char* smem) {
  float* tile = (float*)smem;
  const int tid = otid(), lane = tid & 63, wid = tid >> 6;
  const int gtid = blockIdx.x * NTHR + tid, gthr = gridDim.x * NTHR;
  for (int idx = gtid; idx < T; idx += gthr) { p.rsq1[idx] = 0.f; p.rsq2[idx] = 0.f; }
  const int ntr = (gridDim.x == 256) ? 160 : 768;
  for (int t = blockIdx.x; t < ntr; t += gridDim.x) transpose_any(p, t, tile);
  for (int t = blockIdx.x; t < 256; t += gridDim.x) s5_tables_block(p, t, smem);
}
__device__ void phase_prep_xn(const Params& p) {
  const int tid = otid(), lane = tid & 63, wid = tid >> 6;
  for (int row0 = (blockIdx.x * 8 + wid) * 8; row0 < T; row0 += gridDim.x * 64) {
    float4 v[8][4]; float ss[8];
#pragma unroll
    for (int r = 0; r < 8; ++r) {
      const float4* xr = (const float4*)(p.x + (size_t)(row0 + r) * 1024);
#pragma unroll
      for (int i = 0; i < 4; ++i) { const f32x4 t = __builtin_nontemporal_load((const f32x4*)xr + lane + 64 * i); v[r][i] = make_float4(t[0], t[1], t[2], t[3]); }
    }
#pragma unroll
    for (int r = 0; r < 8; ++r) {
      float a = 0.f;
#pragma unroll
      for (int i = 0; i < 4; ++i) a += v[r][i].x * v[r][i].x + v[r][i].y * v[r][i].y + v[r][i].z * v[r][i].z + v[r][i].w * v[r][i].w;
#pragma unroll
      for (int o = 32; o >= 1; o >>= 1) a += __shfl_xor(a, o);
      ss[r] = rsqrtf(a * (1.f / 1024.f) + 1e-6f);
    }
#pragma unroll
    for (int i = 0; i < 4; ++i) {
      const float4 g = ((const float4*)p.in_norm_g)[lane + 64 * i];
#pragma unroll
      for (int r = 0; r < 8; ++r) {
        uint2 o; o.x = pack2(v[r][i].x * ss[r] * g.x, v[r][i].y * ss[r] * g.y); o.y = pack2(v[r][i].z * ss[r] * g.z, v[r][i].w * ss[r] * g.w);
        *(uint2*)(p.xn + (size_t)(row0 + r) * 1024 + (lane + 64 * i) * 4) = o;
      }
    }
  }
}

struct TileMap {
  int nM, nN, nwg;
  __device__ void init(int M, int N) { nM = M / 256; nN = N / 256; nwg = nM * nN; }
  __device__ void get(int L, int& pm, int& pn) const {
    int wgid = L;
    { const int q = nwg / 8, r = nwg % 8, xcd = wgid % 8, off = wgid / 8; wgid = (xcd < r ? xcd * (q + 1) : r * (q + 1) + (xcd - r) * q) + off; }
    const int nig = 4 * nN, gid = wgid / nig, fm = gid * 4, gsz = (nM - fm) < 4 ? (nM - fm) : 4;
    pm = fm + ((wgid % nig) % gsz); pn = (wgid % nig) / gsz;
  }
};

#define LAS __attribute__((address_space(3)))
constexpr int G_BK = 64, G_HALF = 128, G_HTB = G_HALF * G_BK * 2;
__device__ __forceinline__ int lds_byte(int r, int c) {
  const int st = (r >> 4) * 2 + (c >> 5), rr = r & 15, cc = c & 31, ob = rr * 64 + cc * 2;
  return st * 1024 + (ob ^ (((ob >> 9) & 1) << 5));
}
__device__ __forceinline__ void stage_rc(int b, int& R, int& C) {
  const int st = b / 1024, sb = b % 1024, swz = sb ^ (((sb >> 9) & 1) << 5);
  R = (st >> 1) * 16 + swz / 64; C = (st & 1) * 32 + (swz % 64) / 2;
}

struct RowMapLinear { static constexpr bool PERMA = false, GMAJ = false; __device__ __forceinline__ long operator()(int pm) const { return (long)pm * 256; } };
struct RowMapGroupMajor { static constexpr bool PERMA = false, GMAJ = true; __device__ __forceinline__ long operator()(int pm) const { return (long)pm * 256; } };
struct RowMapConv { static constexpr bool PERMA = true, GMAJ = false; __device__ __forceinline__ long operator()(int pm) const { return (long)(pm / 17) * 4096 + 254 * (pm % 17) - 2; } };

template <class Epi, class RowMap = RowMapLinear>
__device__ __forceinline__ void gemm_phase(const bf16_t* __restrict__ A, const bf16_t* __restrict__ Bt, int M, int N, int K,
                                           const Epi& E, char* smem, const RowMap rmap = RowMap()) {
  LAS unsigned char* lds = (LAS unsigned char*)smem;
  const int tid = otid(), wid = __builtin_amdgcn_readfirstlane(tid >> 6), lane = tid & 63, wr = wid >> 2, wc = wid & 3, fr = lane & 15, fq = lane >> 4;
  const int nt = K / G_BK;
  TileMap tm; tm.init(M, N);
  if ((int)blockIdx.x >= tm.nwg) return;
  unsigned voffA[2], voffB[2];
#pragma unroll
  for (int i = 0; i < 2; ++i) {
    int R, C; stage_rc(tid * 16 + i * 8192, R, C);
    voffB[i] = (unsigned)(R * K + C) * 2u;
    const int Ra = RowMap::PERMA ? ((R & ~63) + 4 * (R & 15) + ((R >> 4) & 3)) : R;
    voffA[i] = RowMap::GMAJ ? (unsigned)((((C >> 4) * M + Ra) * 16 + (C & 15)) * 2) : (unsigned)(Ra * K + C) * 2u;
  }
  const size_t kstep = (size_t)(G_BK * 2);
  const size_t kstepA = RowMap::GMAJ ? (size_t)4 * M * 32 : kstep;
  const size_t hstepA = RowMap::GMAJ ? (size_t)G_HALF * 32 : (size_t)G_HALF * K * 2;
  const size_t hstep = (size_t)G_HALF * K * 2;
  const size_t tstep = 2 * hstep;
  const unsigned ldsw = (unsigned)wid * 1024u;
  const int aoff = lds_byte(wr * 64 + fr, fq * 8), boff = lds_byte(wc * 32 + fr, fq * 8);
#define PG8_SA(b, h) (((b) * 2 + (h)) * G_HTB)
#define PG8_SB(b, h) ((4 + (b) * 2 + (h)) * G_HTB)
#define PG8_STAGE(bufoff, gbase, voff) do { _Pragma("unroll") for (int _i = 0; _i < 2; ++_i) \
    __builtin_amdgcn_global_load_lds((const unsigned*)((const char*)(gbase) + (voff)[_i]), (LAS unsigned*)(lds + (bufoff) + ldsw + _i * 8192), 16, 0, 0); } while (0)
#define PG8_LDA(dst, b, h) do { _Pragma("unroll") for (int m = 0; m < 4; ++m) _Pragma("unroll") for (int k = 0; k < 2; ++k) dst[m][k] = *(const LAS bf16x8*)(lds + PG8_SA(b, h) + aoff + m * 2048 + k * 1024); } while (0)
#define PG8_LDB(dst, b, h) do { _Pragma("unroll") for (int n = 0; n < 2; ++n) _Pragma("unroll") for (int k = 0; k < 2; ++k) dst[n][k] = *(const LAS bf16x8*)(lds + PG8_SB(b, h) + boff + n * 2048 + k * 1024); } while (0)
#define PG8_MMA(ai, bj, At_, Bt_) do { __builtin_amdgcn_s_setprio(1); _Pragma("unroll") for (int m = 0; m < 4; ++m) _Pragma("unroll") for (int n = 0; n < 2; ++n) _Pragma("unroll") for (int k = 0; k < 2; ++k) \
    acc[ai][bj][m][n] = __builtin_amdgcn_mfma_f32_16x16x32_bf16(Bt_[n][k], At_[m][k], acc[ai][bj][m][n], 0, 0, 0); __builtin_amdgcn_s_setprio(0); } while (0)
#define PG8_WAIT_V(n) asm volatile("s_waitcnt vmcnt(" #n ")" ::: "memory")
#define PG8_WAIT_L(n) asm volatile("s_waitcnt lgkmcnt(" #n ")" ::: "memory")
#define PG8_BAR __builtin_amdgcn_s_barrier()
#define PG8_SCHED __builtin_amdgcn_sched_barrier(0)
  int pm, pn, npm = 0, npn = 0, ui = 0;
  tm.get((int)blockIdx.x, pm, pn);
  f32x4 acc[2][2][4][2];
#pragma unroll
  for (int a = 0; a < 2; ++a)
#pragma unroll
    for (int b = 0; b < 2; ++b)
#pragma unroll
      for (int m = 0; m < 4; ++m)
#pragma unroll
        for (int n = 0; n < 2; ++n) acc[a][b][m][n] = (f32x4){0.f, 0.f, 0.f, 0.f};
  bf16x8 At[4][2], B0[2][2], B1[2][2];
  const size_t rstep = RowMap::GMAJ ? (size_t)32 : (size_t)K * 2;
  const char* cA = (const char*)A + rmap(pm) * (long)rstep; const char* cB = (const char*)Bt + (size_t)pn * tstep;
  PG8_WAIT_V(0); __syncthreads();
  PG8_STAGE(PG8_SB(0, 0), cB, voffB); PG8_STAGE(PG8_SA(0, 0), cA, voffA); PG8_STAGE(PG8_SB(0, 1), cB + hstep, voffB); PG8_STAGE(PG8_SA(0, 1), cA + hstepA, voffA);
  if (wr == 1) PG8_BAR;
  PG8_WAIT_V(4); PG8_BAR;
  PG8_STAGE(PG8_SB(1, 0), cB + kstep, voffB); PG8_STAGE(PG8_SA(1, 0), cA + kstepA, voffA); PG8_STAGE(PG8_SB(1, 1), cB + hstep + kstep, voffB);
  PG8_WAIT_V(6); PG8_BAR;
  for (;;) {
    const int Ln = (ui + 1) * (int)gridDim.x + (int)blockIdx.x;
    const bool has_next = Ln < tm.nwg;
    if (has_next) tm.get(Ln, npm, npn);
    const char* nA = has_next ? (const char*)A + rmap(npm) * (long)rstep : cA; const char* nB = has_next ? (const char*)Bt + (size_t)npn * tstep : cB;
    for (int t = 0; t < nt; t += 2) {
      const bool last = (t == nt - 2);
      const char* a1 = cA + (size_t)(t + 1) * kstepA;
      const char* a2 = last ? nA : cA + (size_t)(t + 2) * kstepA; const char* b2 = last ? nB : cB + (size_t)(t + 2) * kstep;
      const char* a3 = a2 + kstepA; const char* b3 = b2 + kstep;
      PG8_LDB(B0, 0, 0); PG8_SCHED; PG8_LDA(At, 0, 0); PG8_STAGE(PG8_SA(1, 1), a1 + hstepA, voffA);
      PG8_WAIT_L(8); PG8_BAR; PG8_WAIT_L(0); PG8_MMA(0, 0, At, B0); PG8_BAR; PG8_SCHED;
      PG8_LDB(B1, 0, 1); PG8_STAGE(PG8_SB(0, 0), b2, voffB);
      PG8_BAR; PG8_WAIT_L(0); PG8_MMA(0, 1, At, B1); PG8_BAR;
      PG8_LDA(At, 0, 1); PG8_STAGE(PG8_SA(0, 0), a2, voffA);
      PG8_BAR; PG8_WAIT_L(0); PG8_MMA(1, 0, At, B0); PG8_BAR; PG8_SCHED;
      PG8_STAGE(PG8_SB(0, 1), b2 + hstep, voffB);
      PG8_WAIT_V(6); PG8_BAR; PG8_MMA(1, 1, At, B1); PG8_BAR;
      PG8_LDB(B0, 1, 0); PG8_SCHED; PG8_LDA(At, 1, 0); PG8_STAGE(PG8_SA(0, 1), a2 + hstepA, voffA);
      PG8_WAIT_L(8); PG8_BAR; PG8_WAIT_L(0); PG8_MMA(0, 0, At, B0); PG8_BAR; PG8_SCHED;
      PG8_LDB(B1, 1, 1); PG8_STAGE(PG8_SB(1, 0), b3, voffB);
      PG8_BAR; PG8_WAIT_L(0); PG8_MMA(0, 1, At, B1); PG8_BAR;
      PG8_LDA(At, 1, 1); PG8_STAGE(PG8_SA(1, 0), a3, voffA);
      PG8_BAR; PG8_WAIT_L(0); PG8_MMA(1, 0, At, B0); PG8_BAR; PG8_SCHED;
      PG8_STAGE(PG8_SB(1, 1), b3 + hstep, voffB);
      PG8_WAIT_V(6); PG8_BAR; PG8_MMA(1, 1, At, B1); PG8_BAR;
    }
    E(acc, pm, pn, wr, wc, fr, fq);
    if (!has_next) break;
#pragma unroll
    for (int a = 0; a < 2; ++a)
#pragma unroll
      for (int b = 0; b < 2; ++b)
#pragma unroll
        for (int m = 0; m < 4; ++m)
#pragma unroll
          for (int n = 0; n < 2; ++n) acc[a][b][m][n] = (f32x4){0.f, 0.f, 0.f, 0.f};
    pm = npm; pn = npn; cA = nA; cB = nB; ++ui;
  }
  PG8_WAIT_V(0);
  if (wr == 0) PG8_BAR;
  PG8_BAR;
#undef PG8_SA
#undef PG8_SB
#undef PG8_STAGE
#undef PG8_LDA
#undef PG8_LDB
#undef PG8_MMA
#undef PG8_WAIT_V
#undef PG8_WAIT_L
#undef PG8_BAR
#undef PG8_SCHED
}

#define PROBE_STAMP_ONCE(k, base) do { if (PROBE_K == (k) && threadIdx.x == 0) { volatile LAS unsigned long long* _s = (volatile LAS unsigned long long*)((LAS unsigned char*)(base) - 8); \
    if (*_s == 0ull) *_s = __builtin_amdgcn_s_memrealtime(); } } while (0)
struct EpiProj {
  bf16_t* proj; bf16_t* ubuf; _Float16* lgf; const float* hg_lb;
  __device__ __forceinline__ void operator()(const f32x4 (&acc)[2][2][4][2], int pm, int pn, int wr, int wc, int fr, int fq) const {
    const int sec = pn >> 1;
    if (sec == 1) {
#pragma unroll
      for (int b = 0; b < 2; ++b) {
        const int c8 = 256 * pn + 128 * b + 32 * wc + 8 * fq;
        float lb[8];
#pragma unroll
        for (int n = 0; n < 2; ++n) {
          const float4 h0 = *(const float4*)(hg_lb + (c8 - 512) + 4 * n), h1 = *(const float4*)(hg_lb + c8 + 4 * n);
          lb[4 * n + 0] = __builtin_amdgcn_rcpf(1.f + __expf(h1.x - h0.x)); lb[4 * n + 1] = __builtin_amdgcn_rcpf(1.f + __expf(h1.y - h0.y));
          lb[4 * n + 2] = __builtin_amdgcn_rcpf(1.f + __expf(h1.z - h0.z)); lb[4 * n + 3] = __builtin_amdgcn_rcpf(1.f + __expf(h1.w - h0.w));
        }
#pragma unroll
        for (int a = 0; a < 2; ++a)
#pragma unroll
          for (int m = 0; m < 4; ++m) {
            const int row = 256 * pm + 128 * a + 64 * wr + 16 * m + fr;
            typedef _Float16 f16x8 __attribute__((ext_vector_type(8)));
            f16x8 lh; float kk[8];
#pragma unroll
            for (int n = 0; n < 2; ++n)
#pragma unroll
              for (int r = 0; r < 4; ++r) {
                const float l = lb[4 * n + r], x = acc[a][b][m][n][r];
                const float sg = __builtin_amdgcn_rcpf(1.f + __expf(-x));
                lh[4 * n + r] = (_Float16)__logf(l + (1.f - l) * sg);
                kk[4 * n + r] = (1.f - l) * __builtin_amdgcn_rcpf(1.f + __expf(x));
              }
            *(f16x8*)(lgf + (size_t)row * 512 + (c8 - 512)) = lh;
            st_nt16(proj + (size_t)row * 2048 + c8, make_uint4(pack2(kk[0], kk[1]), pack2(kk[2], kk[3]), pack2(kk[4], kk[5]), pack2(kk[6], kk[7])));
          }
      }
    } else {
#pragma unroll
      for (int a = 0; a < 2; ++a)
#pragma unroll
        for (int m = 0; m < 4; ++m) {
          const int row = 256 * pm + 128 * a + 64 * wr + 16 * m + fr;
#pragma unroll
          for (int b = 0; b < 2; ++b) {
            const int c8 = 256 * pn + 128 * b + 32 * wc + 8 * fq;
            const f32x4 v0 = acc[a][b][m][0], v1 = acc[a][b][m][1];
            const uint4 o = make_uint4(pack2(v0[0], v0[1]), pack2(v0[2], v0[3]), pack2(v1[0], v1[1]), pack2(v1[2], v1[3]));
            if (sec == 4) st_nt16(ubuf + ((size_t)((c8 - 2048) >> 4) * T + row) * 16 + (c8 & 15), o);
            else st_nt16(proj + (size_t)row * 2048 + c8, o);
          }
        }
    }
  }
};

struct EpiGlu {
  const bf16_t* ybuf; const float* b_glu; bf16_t* mix;
  __device__ __forceinline__ void operator()(const f32x4 (&acc)[2][2][4][2], int pm, int pn, int wr, int wc, int fr, int fq) const {
#pragma unroll
    for (int a = 0; a < 2; ++a)
#pragma unroll
      for (int m = 0; m < 4; ++m) {
        const int row = 256 * pm + 128 * a + 64 * wr + 16 * m + fr;
#pragma unroll
        for (int b = 0; b < 2; ++b) {
          const int c8 = 256 * pn + 128 * b + 32 * wc + 8 * fq;
          const f32x4 v0 = acc[a][b][m][0], v1 = acc[a][b][m][1];
          const float4 b0 = *(const float4*)(b_glu + c8), b1 = *(const float4*)(b_glu + c8 + 4);
          const uint4 yw = ld_nt16(ybuf + ((size_t)(c8 >> 4) * T + row) * 16 + (c8 & 15));
          const float o0 = lo2f(yw.x) * sigm(v0[0] + b0.x), o1 = hi2f(yw.x) * sigm(v0[1] + b0.y), o2 = lo2f(yw.y) * sigm(v0[2] + b0.z), o3 = hi2f(yw.y) * sigm(v0[3] + b0.w);
          const float o4 = lo2f(yw.z) * sigm(v1[0] + b1.x), o5 = hi2f(yw.z) * sigm(v1[1] + b1.y), o6 = lo2f(yw.w) * sigm(v1[2] + b1.z), o7 = hi2f(yw.w) * sigm(v1[3] + b1.w);
          st_nt16(mix + (size_t)row * 1024 + 512 + c8, make_uint4(pack2(o0, o1), pack2(o2, o3), pack2(o4, o5), pack2(o6, o7)));
        }
      }
  }
};


struct EpiOut {
  const float* x; bf16_t* hb; float* rsq;
  __device__ __forceinline__ void operator()(const f32x4 (&acc)[2][2][4][2], int pm, int pn, int wr, int wc, int fr, int fq) const {
#pragma unroll
    for (int a = 0; a < 2; ++a)
#pragma unroll
      for (int m = 0; m < 4; ++m) {
        const int row = 256 * pm + 128 * a + 64 * wr + 16 * m + fr;
        float ss = 0.f;
#pragma unroll
        for (int b = 0; b < 2; ++b) {
          const int c8 = 256 * pn + 128 * b + 32 * wc + 8 * fq;
          const f32x4 v0 = acc[a][b][m][0], v1 = acc[a][b][m][1];
          const float4 x0 = ld_nt16f(x + (size_t)row * 1024 + c8), x1 = ld_nt16f(x + (size_t)row * 1024 + c8 + 4);
          const float h0 = x0.x + v0[0], h1 = x0.y + v0[1], h2 = x0.z + v0[2], h3 = x0.w + v0[3];
          const float h4 = x1.x + v1[0], h5 = x1.y + v1[1], h6 = x1.z + v1[2], h7 = x1.w + v1[3];
          st_nt16(hb + (size_t)row * 1024 + c8, make_uint4(pack2(h0, h1), pack2(h2, h3), pack2(h4, h5), pack2(h6, h7)));
          ss += (h0 * h0 + h1 * h1) + (h2 * h2 + h3 * h3) + (h4 * h4 + h5 * h5) + (h6 * h6 + h7 * h7);
        }
        ss += __shfl_xor(ss, 16); ss += __shfl_xor(ss, 32);
        if (fq == 0) unsafeAtomicAdd(rsq + row, ss);
      }
  }
};

template <int CTRL> __device__ __forceinline__ float dpp_upd(float old, float src) {
  return __int_as_float(__builtin_amdgcn_update_dpp(__float_as_int(old), __float_as_int(src), CTRL, 0xf, 0xf, false));
}
struct EpiUpConv {
  bf16_t* act; const float* rsq; const float* conv_w; const float* conv_b; LAS float* xb;
  __device__ __forceinline__ void operator()(f32x4 (&acc)[2][2][4][2], int pm, int pn, int wr, int wc, int fr, int fq) const {
    PROBE_STAMP_ONCE(31, xb);
    const int seq = pm / 17, it = pm - seq * 17, l0 = 254 * it - 2;
#pragma unroll
    for (int a = 0; a < 2; ++a)
#pragma unroll
      for (int m = 0; m < 4; ++m) {
        const int l = l0 + 128 * a + 64 * wr + 4 * fr + m;
        int tok = seq * 4096 + l; tok = tok < 0 ? 0 : (tok > T - 1 ? T - 1 : tok);
        float rstd = rsqrtf(rsq[tok] * (1.f / 1024.f) + 1e-6f);
#pragma unroll
        for (int b = 0; b < 2; ++b)
#pragma unroll
          for (int n = 0; n < 2; ++n) {
            f32x4 v = acc[a][b][m][n] * rstd;
            if (a == 0 && m < 2 && l < 0) v = (f32x4){0.f, 0.f, 0.f, 0.f};
            acc[a][b][m][n] = v;
          }
      }
    if (fr == 15) {
#pragma unroll
      for (int a = 0; a < 2; ++a) {
        const int bd = 2 * a + wr;
        if (bd < 3) {
#pragma unroll
          for (int q = 0; q < 2; ++q)
#pragma unroll
            for (int b = 0; b < 2; ++b)
#pragma unroll
              for (int n = 0; n < 2; ++n) *(LAS f32x4*)(xb + ((bd * 2 + q) * 2 + b) * 128 + 32 * wc + 16 * n + 4 * fq) = acc[a][b][2 + q][n];
        }
      }
    }
    asm volatile("s_waitcnt lgkmcnt(0)" ::: "memory");
    __builtin_amdgcn_s_barrier(); asm volatile("" ::: "memory");
    __builtin_amdgcn_s_barrier(); asm volatile("" ::: "memory");
#pragma unroll
    for (int n = 0; n < 2; ++n) {
      const int c = pn * 128 + 32 * wc + 16 * n + 4 * fq;
      const f32x4 wg0 = *(const f32x4*)(conv_w + c), wg1 = *(const f32x4*)(conv_w + 5632 + c), wg2 = *(const f32x4*)(conv_w + 2 * 5632 + c);
      const f32x4 wv0 = *(const f32x4*)(conv_w + 2816 + c), wv1 = *(const f32x4*)(conv_w + 5632 + 2816 + c), wv2 = *(const f32x4*)(conv_w + 2 * 5632 + 2816 + c);
      const f32x4 bg = *(const f32x4*)(conv_b + c), bv = *(const f32x4*)(conv_b + 2816 + c);
#pragma unroll
      for (int a = 0; a < 2; ++a) {
        const int bdp = 2 * a + wr - 1;
        f32x4 g2b = (f32x4){0.f, 0.f, 0.f, 0.f}, g1b = g2b, v2b = g2b, v1b = g2b;
        if (bdp >= 0 && fr == 0) {
          g2b = *(const LAS f32x4*)(xb + ((bdp * 2 + 0) * 2 + 0) * 128 + 32 * wc + 16 * n + 4 * fq);
          v2b = *(const LAS f32x4*)(xb + ((bdp * 2 + 0) * 2 + 1) * 128 + 32 * wc + 16 * n + 4 * fq);
          g1b = *(const LAS f32x4*)(xb + ((bdp * 2 + 1) * 2 + 0) * 128 + 32 * wc + 16 * n + 4 * fq);
          v1b = *(const LAS f32x4*)(xb + ((bdp * 2 + 1) * 2 + 1) * 128 + 32 * wc + 16 * n + 4 * fq);
        }
        f32x4 pg3, pg2, pv3, pv2;
#pragma unroll
        for (int r = 0; r < 4; ++r) {
          pg3[r] = dpp_upd<0x111>(g1b[r], acc[a][0][3][n][r]); pg2[r] = dpp_upd<0x111>(g2b[r], acc[a][0][2][n][r]);
          pv3[r] = dpp_upd<0x111>(v1b[r], acc[a][1][3][n][r]); pv2[r] = dpp_upd<0x111>(v2b[r], acc[a][1][2][n][r]);
        }
#pragma unroll
        for (int m = 0; m < 4; ++m) {
          const f32x4 cg = acc[a][0][m][n], cv = acc[a][1][m][n];
          const f32x4 s1g = m == 0 ? pg3 : acc[a][0][m == 0 ? 0 : m - 1][n], s2g = m == 0 ? pg2 : (m == 1 ? pg3 : acc[a][0][m < 2 ? 0 : m - 2][n]);
          const f32x4 s1v = m == 0 ? pv3 : acc[a][1][m == 0 ? 0 : m - 1][n], s2v = m == 0 ? pv2 : (m == 1 ? pv3 : acc[a][1][m < 2 ? 0 : m - 2][n]);
          const f32x4 G = bg + wg0 * s2g + wg1 * s1g + wg2 * cg;
          const f32x4 V = bv + wv0 * s2v + wv1 * s1v + wv2 * cv;
          const int rr = 128 * a + 64 * wr + 4 * fr + m, l = l0 + rr;
          if (rr >= 2 && l < 4096) {
            uint2 ow; ow.x = pack2(G[0] * sigm(G[0]) * V[0], G[1] * sigm(G[1]) * V[1]); ow.y = pack2(G[2] * sigm(G[2]) * V[2], G[3] * sigm(G[3]) * V[3]);
            st_nt8(act + (size_t)(seq * 4096 + l) * 2816 + c, ow);
          }
        }
      }
    }
    PROBE_STAMP_ONCE(32, xb);
  }
};

struct EpiDown {
  float* out; const bf16_t* hb; float* rsq; unsigned* cnt; const float* g; LAS float* red; bool fused;
  __device__ __forceinline__ void operator()(f32x4 (&acc)[2][2][4][2], int pm, int pn, int wr, int wc, int fr, int fq) const {
    PROBE_STAMP_ONCE(30, red);
#pragma unroll
    for (int a = 0; a < 2; ++a)
#pragma unroll
      for (int m = 0; m < 4; ++m) {
        const int row = 256 * pm + 128 * a + 64 * wr + 16 * m + fr;
        float ss = 0.f;
#pragma unroll
        for (int b = 0; b < 2; ++b)
#pragma unroll
          for (int n = 0; n < 2; ++n) {
            const int col = 256 * pn + 128 * b + 32 * wc + 16 * n + 4 * fq;
            const uint2 hw = ld_nt8(hb + (size_t)row * 1024 + col);
            f32x4 v = acc[a][b][m][n];
            v[0] += lo2f(hw.x); v[1] += hi2f(hw.x); v[2] += lo2f(hw.y); v[3] += hi2f(hw.y);
            acc[a][b][m][n] = v;
            ss += v[0] * v[0] + v[1] * v[1] + v[2] * v[2] + v[3] * v[3];
          }
        ss += __shfl_xor(ss, 16); ss += __shfl_xor(ss, 32);
        if (fused) { if (fq == 0) red[(128 * a + 64 * wr + 16 * m + fr) * 4 + wc] = ss; }
        else if (fq == 0) unsafeAtomicAdd(rsq + row, ss);
      }
    if (!fused) {
#pragma unroll
      for (int a = 0; a < 2; ++a)
#pragma unroll
        for (int m = 0; m < 4; ++m) {
          const int row = 256 * pm + 128 * a + 64 * wr + 16 * m + fr;
#pragma unroll
          for (int b = 0; b < 2; ++b)
#pragma unroll
            for (int n = 0; n < 2; ++n) {
              const int col = 256 * pn + 128 * b + 32 * wc + 16 * n + 4 * fq;
              const f32x4 v = acc[a][b][m][n];
              *(float4*)(out + (size_t)row * 1024 + col) = make_float4(v[0], v[1], v[2], v[3]);
            }
        }
      return;
    }
    asm volatile("s_waitcnt lgkmcnt(0)" ::: "memory");
    __builtin_amdgcn_s_barrier(); asm volatile("" ::: "memory");
    __builtin_amdgcn_s_barrier(); asm volatile("" ::: "memory");
    const int wid = wr * 4 + wc, lane = fq * 16 + fr;
    unsigned* c = cnt + pm * 64;
    if (wid < 4) {
      const int r = wid * 64 + lane;
      const f32x4 q = *(const LAS f32x4*)(red + r * 4);
      const float old = unsafeAtomicAdd(rsq + 256 * pm + r, (q[0] + q[1]) + (q[2] + q[3]));
      asm volatile("s_waitcnt vmcnt(0)" :: "v"(old) : "memory");
      if (lane == 0) __hip_atomic_fetch_add(c, 1u, __ATOMIC_RELAXED, __HIP_MEMORY_SCOPE_AGENT);
    }
    {
      unsigned spins = 0;
      while ((unsigned)__builtin_amdgcn_readfirstlane((int)__hip_atomic_load(c, __ATOMIC_RELAXED, __HIP_MEMORY_SCOPE_AGENT)) < 16u) {
        __builtin_amdgcn_s_sleep(2);
        if (++spins > (1u << 22)) break;
      }
    }
#pragma unroll
    for (int a = 0; a < 2; ++a)
#pragma unroll
      for (int m = 0; m < 4; ++m) {
        const int row = 256 * pm + 128 * a + 64 * wr + 16 * m + fr;
        const float rstd = rsqrtf(__hip_atomic_load(rsq + row, __ATOMIC_RELAXED, __HIP_MEMORY_SCOPE_AGENT) * (1.f / 1024.f) + 1e-6f);
#pragma unroll
        for (int b = 0; b < 2; ++b)
#pragma unroll
          for (int n = 0; n < 2; ++n) {
            const int col = 256 * pn + 128 * b + 32 * wc + 16 * n + 4 * fq;
            const float4 gv = *(const float4*)(g + col);
            const f32x4 v = acc[a][b][m][n];
            st_nt16(out + (size_t)row * 1024 + col, (f32x4){v[0] * rstd * gv.x, v[1] * rstd * gv.y, v[2] * rstd * gv.z, v[3] * rstd * gv.w});
          }
      }
  }
};

typedef _Float16 f16x2_t __attribute__((ext_vector_type(2)));
__device__ void hg_a_item(const Params& p, int item, char* smem) {
  bf16_t* kT = (bf16_t*)smem;
  bf16_t* vT = kT + 128 * 72;
  float* tot = (float*)(vT + 128 * 72);
  _Float16* Lf = (_Float16*)(smem + 40960); bf16_t* Kr = (bf16_t*)(Lf + 8192); bf16_t* Vr = Kr + 8192;
  const int tid = otid(), lane = tid & 63, wid = tid >> 6, fr = lane & 15, fq = lane >> 4;
  const int b = item >> 8, h = (item >> 6) & 3, n = item & 63;
  const int t0 = b * 4096 + n * 64;
  const int kp = tid & 63, seg = tid >> 6;
  {
    uint4 rw[6];
#pragma unroll
    for (int i = 0; i < 2; ++i) {
      const int c = tid + 512 * i, row = c >> 4, cc = c & 15;
      rw[i] = ld_nt16(p.logf + (size_t)(t0 + row) * 512 + h * 128 + cc * 8);
      rw[2 + i] = ld_nt16(p.proj + (size_t)(t0 + row) * 2048 + 512 + h * 128 + cc * 8);
      rw[4 + i] = ld_nt16(p.proj + (size_t)(t0 + row) * 2048 + 1024 + h * 128 + cc * 8);
    }
#pragma unroll
    for (int i = 0; i < 2; ++i) {
      const int c = tid + 512 * i, row = c >> 4, cc = c & 15;
      *(uint4*)(Lf + row * 128 + cc * 8) = rw[i]; *(uint4*)(Kr + row * 128 + cc * 8) = rw[2 + i]; *(uint4*)(Vr + row * 128 + cc * 8) = rw[4 + i];
    }
  }
  __syncthreads();
  float b0[8], b1[8];
  {
    float a0 = 0.f, a1 = 0.f;
#pragma unroll
    for (int i = 0; i < 8; ++i) {
      const f16x2_t l2 = *(const f16x2_t*)(Lf + (seg * 8 + i) * 128 + 2 * kp);
      a0 += (float)l2[0]; a1 += (float)l2[1]; b0[i] = a0; b1[i] = a1;
    }
    *(float2*)(tot + seg * 128 + 2 * kp) = make_float2(a0, a1);
  }
  __syncthreads();
  float pre0 = 0.f, pre1 = 0.f, all0 = 0.f, all1 = 0.f;
#pragma unroll
  for (int s8 = 0; s8 < 8; ++s8) { const float2 tv = *(const float2*)(tot + s8 * 128 + 2 * kp); if (s8 < seg) { pre0 += tv.x; pre1 += tv.y; } all0 += tv.x; all1 += tv.y; }
  {
    float k0[8], k1[8]; unsigned v0[4], v1[4];
#pragma unroll
    for (int i = 0; i < 8; ++i) {
      const unsigned kw = *(const unsigned*)(Kr + (seg * 8 + i) * 128 + 2 * kp), vw = *(const unsigned*)(Vr + (seg * 8 + i) * 128 + 2 * kp);
      k0[i] = lo2f(kw) * __expf(all0 - (b0[i] + pre0)); k1[i] = hi2f(kw) * __expf(all1 - (b1[i] + pre1));
      if (i & 1) { v0[i >> 1] |= vw << 16; v1[i >> 1] |= vw & 0xffff0000u; } else { v0[i >> 1] = vw & 0xffffu; v1[i >> 1] = vw >> 16; }
    }
    *(uint4*)(kT + (2 * kp) * 72 + seg * 8) = make_uint4(pack2(k0[0], k0[1]), pack2(k0[2], k0[3]), pack2(k0[4], k0[5]), pack2(k0[6], k0[7]));
    *(uint4*)(kT + (2 * kp + 1) * 72 + seg * 8) = make_uint4(pack2(k1[0], k1[1]), pack2(k1[2], k1[3]), pack2(k1[4], k1[5]), pack2(k1[6], k1[7]));
    *(uint4*)(vT + (2 * kp) * 72 + seg * 8) = make_uint4(v0[0], v0[1], v0[2], v0[3]);
    *(uint4*)(vT + (2 * kp + 1) * 72 + seg * 8) = make_uint4(v1[0], v1[1], v1[2], v1[3]);
    if (seg == 0) *(float2*)(p.decay + (size_t)item * 128 + 2 * kp) = make_float2(__expf(all0), __expf(all1));
  }
  __syncthreads();
  bf16x8 af[2];
#pragma unroll
  for (int ks = 0; ks < 2; ++ks) af[ks] = *(const bf16x8*)(kT + (16 * wid + fr) * 72 + 32 * ks + 8 * fq);
#pragma unroll
  for (int j = 0; j < 8; ++j) {
    f32x4 acc = (f32x4){0.f, 0.f, 0.f, 0.f};
#pragma unroll
    for (int ks = 0; ks < 2; ++ks) {
      bf16x8 bfr = *(const bf16x8*)(vT + (16 * j + fr) * 72 + 32 * ks + 8 * fq);
      acc = __builtin_amdgcn_mfma_f32_16x16x32_bf16(af[ks], bfr, acc, 0, 0, 0);
    }
    st_nt8(p.dstate + (size_t)item * 16384 + (16 * j + fr) * 128 + 16 * wid + 4 * fq, pack2(acc[0], acc[1]), pack2(acc[2], acc[3]));
  }
  __syncthreads();
}

__device__ void hg_c_item(const Params& p, int item, char* smem) {
  bf16_t* qd = (bf16_t*)smem;
  bf16_t* kd = qd + 64 * 136;
  bf16_t* vT = kd + 64 * 136;
  float* tot = (float*)(vT + 128 * 72);
  float* ssq = tot + 1024;
  _Float16* Lf = (_Float16*)(ssq + 128); bf16_t* Qr = (bf16_t*)(Lf + 8192); bf16_t* Kr = Qr + 8192; bf16_t* Vr = Kr + 8192;
  bf16_t* att = (bf16_t*)Lf;
  const int tid = otid(), lane = tid & 63, wid = tid >> 6, fr = lane & 15, fq = lane >> 4;
  const int b = item >> 8, h = (item >> 6) & 3, n = item & 63;
  const int t0 = b * 4096 + n * 64;
  const int kp = tid & 63, seg = tid >> 6;
  const int rt = wid & 3, hh = wid >> 2;
  const int token = t0 + 16 * rt + fr;
  uint2 gw[4]; float4 g4[4];
  {
    uint4 rw[8];
#pragma unroll
    for (int i = 0; i < 2; ++i) {
      const int c = tid + 512 * i, row = c >> 4, cc = c & 15;
      rw[i] = ld_nt16(p.logf + (size_t)(t0 + row) * 512 + h * 128 + cc * 8);
      rw[2 + i] = ld_nt16(p.proj + (size_t)(t0 + row) * 2048 + h * 128 + cc * 8);
      rw[4 + i] = ld_nt16(p.proj + (size_t)(t0 + row) * 2048 + 512 + h * 128 + cc * 8);
      rw[6 + i] = ld_nt16(p.proj + (size_t)(t0 + row) * 2048 + 1024 + h * 128 + cc * 8);
    }
#pragma unroll
    for (int j = 0; j < 4; ++j) {
      const int col = h * 128 + 16 * (4 * hh + j) + 4 * fq;
      gw[j] = ld_nt8(p.proj + (size_t)token * 2048 + 1536 + col);
      g4[j] = *(const float4*)(p.hg_norm_g + col);
    }
#pragma unroll
    for (int i = 0; i < 2; ++i) {
      const int c = tid + 512 * i, row = c >> 4, cc = c & 15;
      *(uint4*)(Lf + row * 128 + cc * 8) = rw[i]; *(uint4*)(Qr + row * 128 + cc * 8) = rw[2 + i]; *(uint4*)(Kr + row * 128 + cc * 8) = rw[4 + i]; *(uint4*)(Vr + row * 128 + cc * 8) = rw[6 + i];
    }
  }
  __syncthreads();
  float b0[8], b1[8];
  {
    float a0 = 0.f, a1 = 0.f;
#pragma unroll
    for (int i = 0; i < 8; ++i) {
      const f16x2_t l2 = *(const f16x2_t*)(Lf + (seg * 8 + i) * 128 + 2 * kp);
      a0 += (float)l2[0]; a1 += (float)l2[1]; b0[i] = a0; b1[i] = a1;
    }
    *(float2*)(tot + seg * 128 + 2 * kp) = make_float2(a0, a1);
  }
  __syncthreads();
  const bf16_t* sp = p.sstart + (size_t)item * 16384;
  bf16x8 sf[4][4];
#pragma unroll
  for (int ks = 0; ks < 4; ++ks)
#pragma unroll
    for (int j = 0; j < 4; ++j) sf[ks][j] = *(const bf16x8*)(sp + (16 * (4 * hh + j) + fr) * 128 + 32 * ks + 8 * fq);
  float pre0 = 0.f, pre1 = 0.f;
#pragma unroll
  for (int s8 = 0; s8 < 8; ++s8) { const float2 tv = *(const float2*)(tot + s8 * 128 + 2 * kp); if (s8 < seg) { pre0 += tv.x; pre1 += tv.y; } }
  {
    unsigned v0[4], v1[4];
#pragma unroll
    for (int i = 0; i < 8; ++i) {
      const int r = seg * 8 + i;
      const unsigned qw = *(const unsigned*)(Qr + r * 128 + 2 * kp), kw = *(const unsigned*)(Kr + r * 128 + 2 * kp), vw = *(const unsigned*)(Vr + r * 128 + 2 * kp);
      const float bb0 = b0[i] + pre0, bb1 = b1[i] + pre1;
      *(unsigned*)(qd + r * 136 + 2 * kp) = pack2(lo2f(qw) * __expf(bb0), hi2f(qw) * __expf(bb1));
      *(unsigned*)(kd + r * 136 + 2 * kp) = pack2(lo2f(kw) * __expf(-bb0), hi2f(kw) * __expf(-bb1));
      if (i & 1) { v0[i >> 1] |= vw << 16; v1[i >> 1] |= vw & 0xffff0000u; } else { v0[i >> 1] = vw & 0xffffu; v1[i >> 1] = vw >> 16; }
    }
    *(uint4*)(vT + (2 * kp) * 72 + seg * 8) = make_uint4(v0[0], v0[1], v0[2], v0[3]);
    *(uint4*)(vT + (2 * kp + 1) * 72 + seg * 8) = make_uint4(v1[0], v1[1], v1[2], v1[3]);
  }
  __syncthreads();
#pragma unroll
  for (int st2 = 0; st2 < 2; ++st2) {
    const int st = 2 * hh + st2;
    f32x4 acc = (f32x4){0.f, 0.f, 0.f, 0.f};
#pragma unroll
    for (int ks = 0; ks < 4; ++ks) {
      bf16x8 a = *(const bf16x8*)(kd + (16 * st + fr) * 136 + 32 * ks + 8 * fq);
      bf16x8 bq = *(const bf16x8*)(qd + (16 * rt + fr) * 136 + 32 * ks + 8 * fq);
      acc = __builtin_amdgcn_mfma_f32_16x16x32_bf16(a, bq, acc, 0, 0, 0);
    }
    const int c = 16 * rt + fr, s0 = 16 * st + 4 * fq;
    float v0 = (s0 + 0 <= c) ? acc[0] : 0.f, v1 = (s0 + 1 <= c) ? acc[1] : 0.f, v2 = (s0 + 2 <= c) ? acc[2] : 0.f, v3 = (s0 + 3 <= c) ? acc[3] : 0.f;
    uint2 o; o.x = pack2(v0, v1); o.y = pack2(v2, v3);
    *(uint2*)(att + c * 72 + s0) = o;
  }
  __syncthreads();
  f32x4 o[4];
#pragma unroll
  for (int j = 0; j < 4; ++j) o[j] = (f32x4){0.f, 0.f, 0.f, 0.f};
#pragma unroll
  for (int ks = 0; ks < 2; ++ks) {
    bf16x8 bq = *(const bf16x8*)(att + (16 * rt + fr) * 72 + 32 * ks + 8 * fq);
#pragma unroll
    for (int j = 0; j < 4; ++j) {
      bf16x8 a = *(const bf16x8*)(vT + (16 * (4 * hh + j) + fr) * 72 + 32 * ks + 8 * fq);
      o[j] = __builtin_amdgcn_mfma_f32_16x16x32_bf16(a, bq, o[j], 0, 0, 0);
    }
  }
#pragma unroll
  for (int ks = 0; ks < 4; ++ks) {
    bf16x8 bq = *(const bf16x8*)(qd + (16 * rt + fr) * 136 + 32 * ks + 8 * fq);
#pragma unroll
    for (int j = 0; j < 4; ++j) o[j] = __builtin_amdgcn_mfma_f32_16x16x32_bf16(sf[ks][j], bq, o[j], 0, 0, 0);
  }
  float ss = 0.f;
#pragma unroll
  for (int j = 0; j < 4; ++j) ss += o[j][0] * o[j][0] + o[j][1] * o[j][1] + o[j][2] * o[j][2] + o[j][3] * o[j][3];
  ss += __shfl_xor(ss, 16); ss += __shfl_xor(ss, 32);
  if (fq == 0) ssq[hh * 64 + 16 * rt + fr] = ss;
  __syncthreads();
  const float tss = ssq[16 * rt + fr] + ssq[64 + 16 * rt + fr];
  const float rstd = rsqrtf(tss * (1.f / 128.f) + 1e-6f);
#pragma unroll
  for (int j = 0; j < 4; ++j) {
    const int col = h * 128 + 16 * (4 * hh + j) + 4 * fq;
    float z0 = lo2f(gw[j].x), z1 = hi2f(gw[j].x), z2 = lo2f(gw[j].y), z3 = hi2f(gw[j].y);
    float r0 = o[j][0] * rstd * g4[j].x * z0 * sigm(z0), r1 = o[j][1] * rstd * g4[j].y * z1 * sigm(z1);
    float r2 = o[j][2] * rstd * g4[j].z * z2 * sigm(z2), r3 = o[j][3] * rstd * g4[j].w * z3 * sigm(z3);
    uint2 ow; ow.x = pack2(r0, r1); ow.y = pack2(r2, r3);
    st_nt8(p.mix + (size_t)token * 1024 + col, ow);
  }
  __syncthreads();
}

__device__ void s5_a_block(const Params& p, int g, int to, char* smem) {
  const int tid = otid(), lane = tid & 63, wid = tid >> 6, fr = lane & 15, fq = lane >> 4;
  const int tt = to * 8 + wid;
  bf16x8 U[8];
#pragma unroll
  for (int ks = 0; ks < 8; ++ks) {
    const int tok = tt * 256 + 16 * fr + 2 * ks + (fq >> 1);
    U[ks] = *(const bf16x8*)(p.ubuf + ((size_t)g * T + tok) * 16 + 8 * (fq & 1));
  }
  {
    const uint4* src = (const uint4*)(p.Ftab + (size_t)g * 128 * 256);
    uint4 v[8];
#pragma unroll
    for (int i = 0; i < 8; ++i) v[i] = src[tid + 512 * i];
#pragma unroll
    for (int i = 0; i < 8; ++i) { const int c = tid + 512 * i; *(uint4*)(smem + (c >> 5) * 528 + (c & 31) * 16) = v[i]; }
  }
  __syncthreads();
#pragma unroll
  for (int rt = 0; rt < 8; ++rt) {
    f32x4 acc = (f32x4){0.f, 0.f, 0.f, 0.f};
#pragma unroll
    for (int ks = 0; ks < 8; ++ks) {
      bf16x8 a = *(const bf16x8*)(smem + (16 * rt + fr) * 528 + 64 * ks + 16 * fq);
      acc = __builtin_amdgcn_mfma_f32_16x16x32_bf16(a, U[ks], acc, 0, 0, 0);
    }
    *(f32x4*)(p.Xend + ((size_t)(tt * 16 + fr) * 32 + g) * 128 + 16 * rt + 4 * fq) = acc;
  }
  __syncthreads();
}

__device__ void s5_c_block(const Params& p, int g, int to, char* smem) {
  const int tid = otid(), lane = tid & 63, wid = tid >> 6, fr = lane & 15, fq = lane >> 4;
  const int tt = to * 8 + wid;
  bf16x8 U[8], Kf[16], Xf[4];
#pragma unroll
  for (int ks = 0; ks < 8; ++ks) {
    const int tok = tt * 256 + 16 * fr + 2 * ks + (fq >> 1);
    U[ks] = *(const bf16x8*)(p.ubuf + ((size_t)g * T + tok) * 16 + 8 * (fq & 1));
  }
#pragma unroll
  for (int d = 0; d < 16; ++d) {
    const int tau = d - (fq >> 1);
    bf16x8 z = (bf16x8){0, 0, 0, 0, 0, 0, 0, 0};
    if (tau >= 0) z = *(const bf16x8*)(p.Ktab + (size_t)((g * 16 + tau) * 16 + fr) * 16 + 8 * (fq & 1));
    Kf[d] = z;
  }
#pragma unroll
  for (int ks = 0; ks < 4; ++ks) Xf[ks] = *(const bf16x8*)(p.Xs + ((size_t)(tt * 16 + fr) * 32 + g) * 128 + 32 * ks + 8 * fq);
  const int c0 = g * 16 + 4 * fq;
  const float4 dsk = *(const float4*)(p.s5_d + c0);
  uint2 uw[16];
#pragma unroll
  for (int t = 0; t < 16; ++t) uw[t] = *(const uint2*)(p.ubuf + ((size_t)g * T + tt * 256 + 16 * fr + t) * 16 + 4 * fq);
  {
    const uint4* src = (const uint4*)(p.Etab + (size_t)g * 256 * 128);
    uint4 v[8];
#pragma unroll
    for (int i = 0; i < 8; ++i) v[i] = src[tid + 512 * i];
#pragma unroll
    for (int i = 0; i < 8; ++i) { const int c = tid + 512 * i; *(uint4*)(smem + (c >> 4) * 272 + (c & 15) * 16) = v[i]; }
  }
  __syncthreads();
#pragma unroll
  for (int t = 0; t < 16; ++t) {
    f32x4 acc = (f32x4){0.f, 0.f, 0.f, 0.f};
#pragma unroll
    for (int ks = 0; ks <= t / 2; ++ks) acc = __builtin_amdgcn_mfma_f32_16x16x32_bf16(Kf[t - 2 * ks], U[ks], acc, 0, 0, 0);
#pragma unroll
    for (int ks = 0; ks < 4; ++ks) {
      bf16x8 a = *(const bf16x8*)(smem + (t * 16 + fr) * 272 + 64 * ks + 16 * fq);
      acc = __builtin_amdgcn_mfma_f32_16x16x32_bf16(a, Xf[ks], acc, 0, 0, 0);
    }
    const int token = tt * 256 + 16 * fr + t;
    float y0 = acc[0] + dsk.x * lo2f(uw[t].x), y1 = acc[1] + dsk.y * hi2f(uw[t].x), y2 = acc[2] + dsk.z * lo2f(uw[t].y), y3 = acc[3] + dsk.w * hi2f(uw[t].y);
    uint2 ow; ow.x = pack2(gelu_tanh(y0), gelu_tanh(y1)); ow.y = pack2(gelu_tanh(y2), gelu_tanh(y3));
    st_nt8(p.ybuf + ((size_t)g * T + token) * 16 + 4 * fq, ow);
  }
  __syncthreads();
}

#define XB_TMO      128
#define XB_XCNT(j)  (256  + 64 * (j))
#define XB_XSUB(j)  (1280 + 64 * (j))
#define XB_XGEN(j)  (2304 + 64 * (j))
#define XB_TOP      3328
#define XB_TOPGEN   3392
#define XCD_BAR_WORDS 3456
#define XB_SPIN_CAP (1u << 20)
__device__ __forceinline__ unsigned xb_ld(unsigned* p) { return __hip_atomic_load(p, __ATOMIC_RELAXED, __HIP_MEMORY_SCOPE_AGENT); }
__device__ __forceinline__ unsigned xb_add(unsigned* p, unsigned v) { return __hip_atomic_fetch_add(p, v, __ATOMIC_RELAXED, __HIP_MEMORY_SCOPE_AGENT); }
__device__ __forceinline__ unsigned xb_xcc_id() { return (unsigned)__builtin_amdgcn_s_getreg((3 << 11) | 20) & 0xFu; }
#define XB_SPIN(cond, bar) do { unsigned _sp = 0; while (cond) { __builtin_amdgcn_s_sleep(1); \
    if ((++_sp & 255u) == 0u) { if (xb_ld(&(bar)[XB_TMO])) break; if (_sp > XB_SPIN_CAP) { atomicAdd(&(bar)[XB_TMO], 1u); break; } } } } while (0)
struct XcdBarrier { unsigned* bar; unsigned x; volatile LAS unsigned* st; };
__device__ __forceinline__ XcdBarrier xcd_barrier_post(unsigned* bar, volatile LAS unsigned* st) {
  XcdBarrier b; b.bar = bar; b.x = xb_xcc_id(); b.st = st;
  if (threadIdx.x == 0) (void)xb_add(&bar[XB_XCNT(b.x)], 1u);
  return b;
}
__device__ __forceinline__ void xcd_barrier_complete(unsigned* bar, unsigned x, unsigned& nloc, unsigned& nx) {
  const unsigned G = gridDim.x * gridDim.y * gridDim.z;
  unsigned sum, cnt, mine, sp = 0u;
  for (;;) {
    sum = 0u; cnt = 0u; mine = 0u;
#pragma unroll
    for (unsigned j = 0; j < 16; ++j) { const unsigned c = xb_ld(&bar[XB_XCNT(j)]); sum += c; cnt += (c > 0u) ? 1u : 0u; mine = (j == x) ? c : mine; }
    if (sum == G) break;
    __builtin_amdgcn_s_sleep(1);
    if ((++sp & 255u) == 0u) { if (xb_ld(&bar[XB_TMO])) break; if (sp > XB_SPIN_CAP) { atomicAdd(&bar[XB_TMO], 1u); break; } }
  }
  nloc = mine > 0u ? mine : 1u; nx = cnt > 0u ? cnt : 1u;
}
__device__ __forceinline__ void xcd_barrier(const XcdBarrier& b) {
  asm volatile("s_waitcnt vmcnt(0)" ::: "memory");
  __syncthreads();
  if (threadIdx.x == 0) {
    unsigned* bar = b.bar;
    __builtin_amdgcn_s_waitcnt(0);
    unsigned nloc = b.st[0], nx = b.st[1];
    if (nloc == 0u) { xcd_barrier_complete(bar, b.x, nloc, nx); b.st[0] = nloc; b.st[1] = nx; }
    const unsigned old = xb_add(&bar[XB_XSUB(b.x)], 1u);
    const unsigned gen = old / nloc;
    if (old + 1u == (gen + 1u) * nloc) {
      __builtin_amdgcn_fence(__ATOMIC_RELEASE, "agent");
      asm volatile("s_waitcnt vmcnt(0)" ::: "memory");
      const unsigned og = xb_add(&bar[XB_TOP], 1u);
      const unsigned tg = og / nx;
      if (og + 1u == (tg + 1u) * nx) xb_add(&bar[XB_TOPGEN], 1u);
      else XB_SPIN(xb_ld(&bar[XB_TOPGEN]) == tg, bar);
      __builtin_amdgcn_fence(__ATOMIC_ACQUIRE, "agent");
      xb_add(&bar[XB_XGEN(b.x)], 1u);
      asm volatile("s_waitcnt vmcnt(0)" ::: "memory");
    } else {
      XB_SPIN(xb_ld(&bar[XB_XGEN(b.x)]) == gen, bar);
      __builtin_amdgcn_fence(__ATOMIC_ACQUIRE, "agent");
      asm volatile("s_waitcnt vmcnt(0)" ::: "memory");
    }
  }
  __syncthreads();
}

__device__ void phase_mix_a(const Params& p, char* smem, int part) {
  if (part == 0) { for (int it = blockIdx.x; it < 1024; it += gridDim.x) hg_a_item(p, it, smem); }
  else { for (int u = blockIdx.x; u < 256; u += gridDim.x) s5_a_block(p, u & 31, u >> 5, smem); }
}

__device__ void phase_scan(const Params& p) {
  int tid = otid();
  if (tid < 128) {
    for (int it = blockIdx.x * 128 + tid; it < 32768; it += gridDim.x * 128) {
      const int seg = it & 3, ch = it >> 2;
      const int bt = ch >> 11, g = (ch >> 6) & 31, n = ch & 63;
      const float2 a = p.Pw[g * 64 + n];
      const size_t base = ((size_t)(bt * 256 + seg * 64) * 32 + g) * 128 + n;
      const float* __restrict__ xe = p.Xend + base;
      bf16_t* __restrict__ xs = p.Xs + base;
      float xr = 0.f, xi = 0.f;
#pragma unroll 1
      for (int h = 0; h < 2; ++h) {
        float er[32], ei[32];
#pragma unroll
        for (int j = 0; j < 32; ++j) { er[j] = xe[(size_t)(h * 32 + j) * 4096]; ei[j] = xe[(size_t)(h * 32 + j) * 4096 + 64]; }
#pragma unroll
        for (int j = 0; j < 32; ++j) { const float nr = a.x * xr - a.y * xi + er[j], ni = a.x * xi + a.y * xr + ei[j]; xr = nr; xi = ni; }
      }
      float Ar = a.x, Ai = a.y;
#pragma unroll
      for (int q = 0; q < 6; ++q) { const float t = Ar * Ar - Ai * Ai; Ai = 2.f * Ar * Ai; Ar = t; }
      const int lb = (tid & 63) & ~3;
      const float e0r = __shfl(xr, lb), e0i = __shfl(xi, lb), e1r = __shfl(xr, lb + 1), e1i = __shfl(xi, lb + 1), e2r = __shfl(xr, lb + 2), e2i = __shfl(xi, lb + 2);
      const float s2r = Ar * e0r - Ai * e0i + e1r, s2i = Ar * e0i + Ai * e0r + e1i;
      const float s3r = Ar * s2r - Ai * s2i + e2r, s3i = Ar * s2i + Ai * s2r + e2i;
      xr = seg == 0 ? 0.f : (seg == 1 ? e0r : (seg == 2 ? s2r : s3r));
      xi = seg == 0 ? 0.f : (seg == 1 ? e0i : (seg == 2 ? s2i : s3i));
#pragma unroll 1
      for (int h = 0; h < 2; ++h) {
        float er[32], ei[32];
#pragma unroll
        for (int j = 0; j < 32; ++j) { er[j] = xe[(size_t)(h * 32 + j) * 4096]; ei[j] = xe[(size_t)(h * 32 + j) * 4096 + 64]; }
#pragma unroll
        for (int j = 0; j < 32; ++j) {
          xs[(size_t)(h * 32 + j) * 4096] = f2bf(xr); xs[(size_t)(h * 32 + j) * 4096 + 64] = f2bf(xi);
          const float nr = a.x * xr - a.y * xi + er[j], ni = a.x * xi + a.y * xr + ei[j]; xr = nr; xi = ni;
        }
      }
    }
  }
  const int gtid = blockIdx.x * NTHR + tid, gthr = gridDim.x * NTHR;
  for (int e2 = gtid; e2 < 16 * 8192; e2 += gthr) {
    const int bh = e2 >> 13, e = (e2 & 8191) * 2, k = e & 127;
    const bf16_t* __restrict__ dsp = p.dstate + (size_t)bh * 64 * 16384 + e;
    const float* __restrict__ dcp = p.decay + (size_t)bh * 64 * 128 + k;
    bf16_t* __restrict__ sp = p.sstart + (size_t)bh * 64 * 16384 + e;
    float sx = 0.f, sy = 0.f;
#pragma unroll 1
    for (int n0 = 0; n0 < 64; n0 += 32) {
      unsigned ds[32]; float2 dc[32];
#pragma unroll
      for (int j = 0; j < 32; ++j) { ds[j] = ld_nt4(dsp + (size_t)(n0 + j) * 16384); dc[j] = *(const float2*)(dcp + (n0 + j) * 128); }
#pragma unroll
      for (int j = 0; j < 32; ++j) {
        *(unsigned*)(sp + (size_t)(n0 + j) * 16384) = pack2(sx, sy);
        sx = dc[j].x * sx + lo2f(ds[j]); sy = dc[j].y * sy + hi2f(ds[j]);
      }
    }
  }
}

__device__ void phase_mix_c(const Params& p, char* smem, int part) {
  if (part == 0) {
    if (gridDim.x == 256) {
      const int b = blockIdx.x, first = b < 128 ? b * 3 : 384 + (b - 128) * 5, cnt = b < 128 ? 3 : 5;
      for (int j = 0; j < cnt; ++j) hg_c_item(p, first + j, smem);
    } else { for (int it = blockIdx.x; it < 1024; it += gridDim.x) hg_c_item(p, it, smem); }
  }
  else { for (int u = blockIdx.x; u < 256; u += gridDim.x) s5_c_block(p, u & 31, u >> 5, smem); }
}

__device__ void phase_final(const Params& p) {
  int tid_ = otid();
  const int lane = tid_ & 63, wid = tid_ >> 6;
  for (int row0 = (blockIdx.x * 8 + wid) * 4; row0 < T; row0 += gridDim.x * 32) {
    float4 v[4][4]; float rs[4];
#pragma unroll
    for (int r = 0; r < 4; ++r) {
      const float4* op = (const float4*)(p.out + (size_t)(row0 + r) * 1024);
#pragma unroll
      for (int i = 0; i < 4; ++i) v[r][i] = op[lane + 64 * i];
      rs[r] = rsqrtf(p.rsq2[row0 + r] * (1.f / 1024.f) + 1e-6f);
    }
#pragma unroll
    for (int i = 0; i < 4; ++i) {
      const float4 g = ((const float4*)p.final_g)[lane + 64 * i];
#pragma unroll
      for (int r = 0; r < 4; ++r) {
        float4 w = v[r][i];
        w.x *= rs[r] * g.x; w.y *= rs[r] * g.y; w.z *= rs[r] * g.z; w.w *= rs[r] * g.w;
        ((float4*)(p.out + (size_t)(row0 + r) * 1024))[lane + 64 * i] = w;
      }
    }
  }
}

template <int PH>
__device__ __forceinline__ void run_phase(const Params& p, char* smem) {
  if (PH == 0) phase_prep(p, smem);
  if (PH == 100) phase_prep_xn(p);
  if (PH == 1) {
    EpiProj e{p.proj, p.ubuf, p.logf, p.hg_lb}; gemm_phase(p.xn, p.Wt_in, T, 2560, 1024, e, smem);
    if (gridDim.x == 256 && blockIdx.x >= 128)
      for (int t = 160 + ((int)blockIdx.x - 128); t < 768; t += 128) transpose_any(p, t, (float*)smem);
  }
  if (PH == 2) phase_mix_a(p, smem, 0);
  if (PH == 102) phase_mix_a(p, smem, 1);
  if (PH == 3) phase_scan(p);
  if (PH == 4) phase_mix_c(p, smem, 1);
  if (PH == 104) { }
  if (PH == 5) { EpiGlu e{p.ybuf, p.b_glu, p.mix}; gemm_phase(p.ybuf, p.Wt_glu, T, 512, 512, e, smem, RowMapGroupMajor()); phase_mix_c(p, smem, 0); }
  if (PH == 6) { EpiOut e{p.x, p.hb, p.rsq1}; gemm_phase(p.mix, p.Wt_out, T, 1024, 1024, e, smem); }
  if (PH == 7) { EpiUpConv e{p.act, p.rsq1, p.conv_w, p.conv_b, (LAS float*)((LAS unsigned char*)smem + 131088)}; gemm_phase(p.hb, p.Wt_up, 68 * 256, 5632, 1024, e, smem, RowMapConv()); }
  if (PH == 8) { EpiDown e{p.out, p.hb, p.rsq2, p.bar + XCD_BAR_WORDS, p.final_g, (LAS float*)((LAS unsigned char*)smem + 131088), gridDim.x >= 256}; gemm_phase(p.act, p.Wt_down, T, 1024, 2816, e, smem); }
  if (PH == 9) { if (gridDim.x < 256) phase_final(p); }
}

#if MK_FUSED
#define PROBE_MARK(k) do { if (PROBE_K == (k)) t_mark = __builtin_amdgcn_s_memrealtime(); } while (0)
__global__ void __launch_bounds__(NTHR) fwd_megakernel(Params p) {
  extern __shared__ __attribute__((aligned(16))) char smem[];
  volatile LAS unsigned* st = (volatile LAS unsigned*)((LAS unsigned char*)smem + 131072);
  if (threadIdx.x == 0) { st[0] = 0u; st[1] = 0u; st[2] = 0u; st[3] = 0u; }
  __syncthreads();
  unsigned long long t_start = 0, t_mark = 0;
  if (PROBE_K >= 0) { t_start = __builtin_amdgcn_s_memrealtime(); t_mark = t_start; }
  if (blockIdx.x == 0) for (int i = threadIdx.x; i < XCD_BAR_WORDS + 64 * 64; i += NTHR) p.bar[i] = 0u;
  run_phase<0>(p, smem); PROBE_MARK(21); run_phase<100>(p, smem); PROBE_MARK(20);
  cg::this_grid().sync(); PROBE_MARK(0);
  const XcdBarrier xb = xcd_barrier_post(p.bar, st);
  run_phase<1>(p, smem); xcd_barrier(xb); PROBE_MARK(1);
  run_phase<2>(p, smem); PROBE_MARK(23); run_phase<102>(p, smem); xcd_barrier(xb); PROBE_MARK(2);
  run_phase<3>(p, smem); PROBE_MARK(40); xcd_barrier(xb); PROBE_MARK(3);
  run_phase<4>(p, smem); PROBE_MARK(22); run_phase<104>(p, smem); xcd_barrier(xb); PROBE_MARK(4);
  run_phase<5>(p, smem); xcd_barrier(xb); PROBE_MARK(5);
  run_phase<6>(p, smem); xcd_barrier(xb); PROBE_MARK(6);
  run_phase<7>(p, smem); PROBE_MARK(41); xcd_barrier(xb); PROBE_MARK(7);
  run_phase<8>(p, smem);
  if (gridDim.x < 256) { xcd_barrier(xb); run_phase<9>(p, smem); }
  if (PROBE_K >= 30 && PROBE_K < 40) t_mark = *(volatile LAS unsigned long long*)((LAS unsigned char*)smem + 131080);
  if (PROBE_K >= 0) {
    const unsigned long long t_end = __builtin_amdgcn_s_memrealtime();
    const unsigned long long until = t_end + 4ull * (t_mark - t_start);
    while (__builtin_amdgcn_s_memrealtime() < until) __builtin_amdgcn_s_sleep(8);
  }
}
#else
template <int PH>
__global__ void __launch_bounds__(NTHR) phase_kernel(Params p) {
  extern __shared__ __attribute__((aligned(16))) char smem[];
  run_phase<PH>(p, smem);
}
template <int PH>
static void launch_phase(const Params& p, int grid, hipStream_t stream) {
  (void)hipFuncSetAttribute((const void*)phase_kernel<PH>, hipFuncAttributeMaxDynamicSharedMemorySize, LDS_BYTES);
  hipLaunchKernelGGL(phase_kernel<PH>, dim3(grid), dim3(NTHR), LDS_BYTES, stream, p);
}
#endif

extern "C" void kernel_launch(void* const* d_in, const int* in_sizes, int n_in, void* d_out, int out_size, void* d_ws,
                              size_t ws_size, hipStream_t stream) {
  Params p{};
  p.x = (const float*)d_in[0]; p.in_norm_g = (const float*)d_in[1]; p.w_in = (const float*)d_in[2]; p.hg_lb = (const float*)d_in[3];
  p.hg_norm_g = (const float*)d_in[4]; p.a_re = (const float*)d_in[5]; p.a_im = (const float*)d_in[6]; p.log_dt = (const float*)d_in[7];
  p.b_re = (const float*)d_in[8]; p.b_im = (const float*)d_in[9]; p.c_re = (const float*)d_in[10]; p.c_im = (const float*)d_in[11];
  p.s5_d = (const float*)d_in[12]; p.w_glu = (const float*)d_in[13]; p.b_glu = (const float*)d_in[14]; p.w_out = (const float*)d_in[15];
  p.ffn_norm_g = (const float*)d_in[16]; p.w_up = (const float*)d_in[17]; p.conv_w = (const float*)d_in[18]; p.conv_b = (const float*)d_in[19];
  p.w_down = (const float*)d_in[20]; p.final_g = (const float*)d_in[21];
  p.out = (float*)d_out;
  char* ws = (char*)d_ws;
  size_t off = 0;
  auto take = [&](size_t bytes) { char* r = ws + off; off += (bytes + 255) & ~(size_t)255; return r; };
  p.Wt_in = (bf16_t*)take((size_t)2560 * 1024 * 2);
  p.Wt_glu = (bf16_t*)take((size_t)512 * 512 * 2);
  p.Wt_out = (bf16_t*)take((size_t)1024 * 1024 * 2);
  p.Wt_up = (bf16_t*)take((size_t)5632 * 1024 * 2);
  p.Wt_down = (bf16_t*)take((size_t)1024 * 2816 * 2);
  p.Ktab = (bf16_t*)take((size_t)32 * 16 * 256 * 2);
  p.Etab = (bf16_t*)take((size_t)32 * 256 * 128 * 2);
  p.Ftab = (bf16_t*)take((size_t)32 * 128 * 256 * 2);
  p.Pw = (float2*)take((size_t)32 * 17 * 64 * 8);
  p.Bbar = (float2*)take((size_t)32 * 64 * 16 * 8);
  p.rsq1 = (float*)take((size_t)T * 16 * 4);
  p.rsq2 = (float*)take((size_t)T * 16 * 4);
  p.decay = (float*)take((size_t)1024 * 128 * 4);
  p.bar = (unsigned*)take((size_t)(XCD_BAR_WORDS + 64 * 64) * 4);
  const size_t dyn0 = off;
  p.xn = (bf16_t*)take((size_t)T * 1024 * 2);
  p.sstart = p.xn; p.hb = p.xn;
  const size_t r2 = off;
  p.proj = (bf16_t*)take((size_t)T * 2048 * 2);
  p.ubuf = (bf16_t*)take((size_t)T * 512 * 2);
  p.logf = (_Float16*)take((size_t)T * 512 * 4);
  p.mix = (bf16_t*)take((size_t)T * 1024 * 2);
  p.ybuf = (bf16_t*)take((size_t)T * 512 * 2);
  p.Xend = (float*)take((size_t)1024 * 32 * 128 * 4);
  p.Xs = (bf16_t*)take((size_t)1024 * 32 * 128 * 2);
  const size_t endA = off;
  p.dstate = (bf16_t*)d_out;
  off = r2;
  p.act = (bf16_t*)take((size_t)T * 2816 * 2);
  const size_t endB = off;
  (void)dyn0;
  if (endA > ws_size || endB > ws_size) fprintf(stderr, "workspace too small: need %zu / %zu have %zu\n", endA, endB, ws_size);

  static int grid_blocks = 0;
#if MK_FUSED
  if (!grid_blocks) {
    int dev = 0, cus = 0, per_cu = 0;
    (void)hipGetDevice(&dev);
    (void)hipDeviceGetAttribute(&cus, hipDeviceAttributeMultiprocessorCount, dev);
    (void)hipFuncSetAttribute((const void*)fwd_megakernel, hipFuncAttributeMaxDynamicSharedMemorySize, LDS_BYTES);
    (void)hipOccupancyMaxActiveBlocksPerMultiprocessor(&per_cu, fwd_megakernel, NTHR, LDS_BYTES);
    if (per_cu > 1) per_cu = 1;
    grid_blocks = cus * per_cu;
  }
  void* args[] = {&p};
  hipError_t e = hipLaunchCooperativeKernel((void*)fwd_megakernel, dim3(grid_blocks), dim3(NTHR), args, LDS_BYTES, stream);
  if (e != hipSuccess) fprintf(stderr, "cooperative launch failed: %s (grid %d)\n", hipGetErrorString(e), grid_blocks);
#else
  if (!grid_blocks) {
    int dev = 0, cus = 0;
    (void)hipGetDevice(&dev);
    (void)hipDeviceGetAttribute(&cus, hipDeviceAttributeMultiprocessorCount, dev);
    grid_blocks = cus;
  }
  launch_phase<0>(p, grid_blocks, stream);
  launch_phase<100>(p, grid_blocks, stream);
  launch_phase<1>(p, grid_blocks, stream);
  launch_phase<2>(p, grid_blocks, stream);
  launch_phase<102>(p, grid_blocks, stream);
  launch_phase<3>(p, grid_blocks, stream);
  launch_phase<4>(p, grid_blocks, stream);
  launch_phase<104>(p, grid_blocks, stream);
  launch_phase<5>(p, grid_blocks, stream);
  launch_phase<6>(p, grid_blocks, stream);
  launch_phase<7>(p, grid_blocks, stream);
  launch_phase<8>(p, grid_blocks, stream);
  launch_phase<9>(p, grid_blocks, stream);
#endif
}
```
